# Optimizing an MI355X kernel written in HIP

```python
import jax, jax.numpy as jnp
from jax import lax
import numpy as np

D_MODEL = 4096
BATCH = 4
SEQ = 2048
DEPTH = 2

MIX_WIDTH = D_MODEL
BRANCH = MIX_WIDTH // 4

S5_GROUP = 16
S5_GROUPS = BRANCH // S5_GROUP
S5_STATE = 64
S5_DT_MIN = 1e-3
S5_DT_MAX = 1e-1

MLA_NOPE = 128
MLA_ROPE = 64
MLA_V = 128
MLA_HEADS = BRANCH // MLA_V
MLA_Q_RANK = D_MODEL * 3 // 16
MLA_KV_RANK = D_MODEL // 8
ROPE_THETA = 10000.0
Q_BLOCK = 128
NEG_INF = -1e30

GLA_HEADS = 4
GLA_DV = BRANCH // GLA_HEADS
GLA_DK = GLA_DV // 2
GLA_GATE_RANK = 16
GLA_TAU = 16.0
GLA_CHUNK = 64

LRU_BLOCKS = 8
LRU_BLOCK_W = BRANCH // LRU_BLOCKS
LRU_CONV = 4
LRU_C = 8.0

NORM_EPS = 1e-6

IN_SIZES = (BRANCH, BRANCH,
            MLA_Q_RANK, MLA_KV_RANK, MLA_ROPE, BRANCH,
            GLA_HEADS * GLA_DK, GLA_HEADS * GLA_DK, BRANCH,
            GLA_GATE_RANK, BRANCH,
            BRANCH, BRANCH)
IN_COLS = 7 * BRANCH + MLA_Q_RANK + MLA_KV_RANK + MLA_ROPE + 2 * GLA_HEADS * GLA_DK + GLA_GATE_RANK

kernel_name = "hybrid_s5_mla_gla_rglru_parallel_heads"


def rms_norm(x, g):
    x32 = x.astype(jnp.float32)
    y = x32 * lax.rsqrt(jnp.mean(x32 * x32, axis=-1, keepdims=True) + NORM_EPS)
    return (y * g.astype(jnp.float32)).astype(x.dtype)


def split_cols(z):
    idx = np.cumsum(IN_SIZES)[:-1].tolist()
    return jnp.split(z, idx, axis=-1)


def linear_scan(a, b):
    def combine(left, right):
        a_l, b_l = left
        a_r, b_r = right
        return a_l * a_r, a_r * b_l + b_r
    _, h = lax.associative_scan(combine, (a, b), axis=1)
    return h


def s5_mixer(u, lam_re, lam_im, b_re, b_im, c_re, c_im, d, log_dt, w_glu, b_glu):
    bsz, seq, _ = u.shape
    f32 = jnp.float32
    lam = lax.complex(lam_re.astype(f32), lam_im.astype(f32))
    dt = jnp.exp(log_dt.astype(f32))[:, None]
    lam_bar = jnp.exp(lam * dt)
    b_c = lax.complex(b_re.astype(f32), b_im.astype(f32))
    b_bar = ((lam_bar - 1.0) / lam)[..., None] * b_c
    c_c = lax.complex(c_re.astype(f32), c_im.astype(f32))
    ug = u.astype(f32).reshape(bsz, seq, S5_GROUPS, S5_GROUP)
    bu = jnp.einsum('blgh,gph->blgp', ug.astype(jnp.complex64), b_bar)
    state = linear_scan(jnp.broadcast_to(lam_bar, bu.shape), bu)
    y = jnp.einsum('blgp,ghp->blgh', state, c_c).real + d.astype(f32) * ug
    y = jax.nn.gelu(y.reshape(bsz, seq, BRANCH))
    y = y * jax.nn.sigmoid(y @ w_glu.astype(f32) + b_glu.astype(f32))
    return y.astype(u.dtype)


def rope(x, positions):
    half = MLA_ROPE // 2
    inv_freq = 1.0 / (ROPE_THETA ** (jnp.arange(half, dtype=jnp.float32) / half))
    ang = positions.astype(jnp.float32)[..., None] * inv_freq
    cos = jnp.cos(ang)[:, :, None, :]
    sin = jnp.sin(ang)[:, :, None, :]
    x32 = x.astype(jnp.float32)
    x1, x2 = x32[..., :half], x32[..., half:]
    return jnp.concatenate([x1 * cos - x2 * sin, x2 * cos + x1 * sin], axis=-1).astype(x.dtype)


def mla_mixer(c_q, c_kv, k_rope, positions, q_norm_g, kv_norm_g, w_uq, w_uk, w_uv):
    bsz, seq, _ = c_q.shape
    dqk = MLA_NOPE + MLA_ROPE
    q = (rms_norm(c_q, q_norm_g) @ w_uq).reshape(bsz, seq, MLA_HEADS, dqk)
    q = jnp.concatenate([q[..., :MLA_NOPE], rope(q[..., MLA_NOPE:], positions)], axis=-1)
    c = rms_norm(c_kv, kv_norm_g)
    k_nope = (c @ w_uk).reshape(bsz, seq, MLA_HEADS, MLA_NOPE)
    v = (c @ w_uv).reshape(bsz, seq, MLA_HEADS, MLA_V)
    k_r = rope(k_rope[:, :, None, :], positions)
    k = jnp.concatenate([k_nope, jnp.broadcast_to(k_r, (bsz, seq, MLA_HEADS, MLA_ROPE))], axis=-1)
    scale = dqk ** -0.5
    n_blk = seq // Q_BLOCK
    q_blocks = q.reshape(bsz, n_blk, Q_BLOCK, MLA_HEADS, dqk).transpose(1, 0, 2, 3, 4)
    key_idx = jnp.arange(seq)

    def attend(args):
        q_blk, blk = args
        s = jnp.einsum('bqhd,bkhd->bhqk', q_blk, k).astype(jnp.float32) * scale
        q_idx = blk * Q_BLOCK + jnp.arange(Q_BLOCK)
        s = jnp.where(key_idx[None, :] <= q_idx[:, None], s, NEG_INF)
        p = jax.nn.softmax(s, axis=-1).astype(v.dtype)
        return jnp.einsum('bhqk,bkhd->bqhd', p, v)

    o = lax.map(attend, (q_blocks, jnp.arange(n_blk)))
    return o.transpose(1, 0, 2, 3, 4).reshape(bsz, seq, MLA_HEADS * MLA_V)


def gla_mixer(q, k, v, g_lr, w_g2, b_g, out_g):
    bsz, seq, _ = q.shape
    n_ch = seq // GLA_CHUNK
    f32 = jnp.float32

    def chunks(t, dim):
        return t.astype(f32).reshape(bsz, n_ch, GLA_CHUNK, GLA_HEADS, dim).transpose(0, 3, 1, 2, 4)

    log_a = jax.nn.log_sigmoid(g_lr.astype(f32) @ w_g2.astype(f32) + b_g.astype(f32)) / GLA_TAU
    qc = chunks(q, GLA_DK) * GLA_DK ** -0.5
    kc = chunks(k, GLA_DK)
    vc = chunks(v, GLA_DV)
    cum = jnp.cumsum(chunks(log_a, GLA_DK), axis=3)
    q_dec = qc * jnp.exp(cum)
    k_inv = kc * jnp.exp(-cum)
    causal = jnp.tril(jnp.ones((GLA_CHUNK, GLA_CHUNK), dtype=bool))
    att = jnp.where(causal, jnp.einsum('bhncd,bhnsd->bhncs', q_dec, k_inv), 0.0)
    o = jnp.einsum('bhncs,bhnsv->bhncv', att, vc)
    total = cum[:, :, :, -1:, :]
    kv = jnp.einsum('bhncd,bhncv->bhndv', kc * jnp.exp(total - cum), vc)
    decay = jnp.exp(total[:, :, :, 0, :])

    def step(s, inp):
        dec, kv_n = inp
        return dec[..., None] * s + kv_n, s

    s0 = jnp.zeros((bsz, GLA_HEADS, GLA_DK, GLA_DV), f32)
    _, s_prev = lax.scan(step, s0, (jnp.moveaxis(decay, 2, 0), jnp.moveaxis(kv, 2, 0)))
    o = o + jnp.einsum('bhncd,bhndv->bhncv', q_dec, jnp.moveaxis(s_prev, 0, 2))
    o = o.transpose(0, 2, 3, 1, 4).reshape(bsz, seq, GLA_HEADS, GLA_DV)
    o = rms_norm(o, out_g.reshape(GLA_HEADS, GLA_DV))
    return o.reshape(bsz, seq, BRANCH).astype(q.dtype)


def rglru_mixer(x, conv_w, conv_b, w_a, b_a, w_x, b_x, lam):
    bsz, seq, _ = x.shape
    f32 = jnp.float32
    xc = lax.conv_general_dilated(
        x, conv_w.reshape(LRU_CONV, 1, BRANCH).astype(x.dtype), window_strides=(1,),
        padding=((LRU_CONV - 1, 0),), dimension_numbers=('NWC', 'WIO', 'NWC'),
        feature_group_count=BRANCH) + conv_b
    xb = xc.astype(f32).reshape(bsz, seq, LRU_BLOCKS, LRU_BLOCK_W)
    r = jax.nn.sigmoid(jnp.einsum('blhi,hij->blhj', xb, w_a.astype(f32))
                       + b_a.astype(f32).reshape(LRU_BLOCKS, LRU_BLOCK_W))
    i = jax.nn.sigmoid(jnp.einsum('blhi,hij->blhj', xb, w_x.astype(f32))
                       + b_x.astype(f32).reshape(LRU_BLOCKS, LRU_BLOCK_W))
    log_a = -LRU_C * r * jax.nn.softplus(-lam.astype(f32).reshape(LRU_BLOCKS, LRU_BLOCK_W))
    gated = jnp.sqrt(-jnp.expm1(2.0 * log_a)) * (i * xb)
    h = linear_scan(jnp.exp(log_a), gated)
    return h.reshape(bsz, seq, BRANCH).astype(x.dtype)


def setup_inputs(seed: int = 0) -> dict:
    key = jax.random.key(seed)
    ks = iter(jax.random.split(key, 48))
    f32 = jnp.float32
    L = DEPTH

    def nrm(shape, scale):
        return jax.random.normal(next(ks), shape, f32) * scale

    def gain(shape):
        return 1.0 + nrm(shape, 0.02)

    x = nrm((BATCH, SEQ, D_MODEL), 1.0)
    offset = jax.random.randint(next(ks), (BATCH, 1), 0, 4096, dtype=jnp.int32)
    positions = offset + jnp.arange(SEQ, dtype=jnp.int32)[None, :]
    norm_g = gain((L, D_MODEL))
    w_in = nrm((L, D_MODEL, IN_COLS), D_MODEL ** -0.5)
    n_idx = jnp.arange(S5_STATE, dtype=f32)
    s5_lambda_re = -0.5 + nrm((L, S5_GROUPS, S5_STATE), 0.01)
    s5_lambda_im = jnp.pi * n_idx + nrm((L, S5_GROUPS, S5_STATE), 0.01)
    s5_b_re = nrm((L, S5_GROUPS, S5_STATE, S5_GROUP), (2 * S5_GROUP) ** -0.5)
    s5_b_im = nrm((L, S5_GROUPS, S5_STATE, S5_GROUP), (2 * S5_GROUP) ** -0.5)
    s5_c_re = nrm((L, S5_GROUPS, S5_GROUP, S5_STATE), (2 * S5_STATE) ** -0.5)
    s5_c_im = nrm((L, S5_GROUPS, S5_GROUP, S5_STATE), (2 * S5_STATE) ** -0.5)
    s5_d = nrm((L, S5_GROUPS, S5_GROUP), 1.0)
    s5_log_dt = jax.random.uniform(next(ks), (L, S5_GROUPS), f32,
                                   float(np.log(S5_DT_MIN)), float(np.log(S5_DT_MAX)))
    s5_w_glu = nrm((L, BRANCH, BRANCH), BRANCH ** -0.5)
    s5_b_glu = nrm((L, BRANCH), 0.01)
    s5_out_g = gain((L, BRANCH))
    mla_q_norm_g = gain((L, MLA_Q_RANK))
    mla_kv_norm_g = gain((L, MLA_KV_RANK))
    mla_w_uq = nrm((L, MLA_Q_RANK, MLA_HEADS * (MLA_NOPE + MLA_ROPE)), MLA_Q_RANK ** -0.5)
    mla_w_uk = nrm((L, MLA_KV_RANK, MLA_HEADS * MLA_NOPE), MLA_KV_RANK ** -0.5)
    mla_w_uv = nrm((L, MLA_KV_RANK, MLA_HEADS * MLA_V), MLA_KV_RANK ** -0.5)
    mla_out_g = gain((L, BRANCH))
    gla_w_gate = nrm((L, GLA_GATE_RANK, GLA_HEADS * GLA_DK), GLA_GATE_RANK ** -0.5)
    gla_b_gate = nrm((L, GLA_HEADS * GLA_DK), 0.1)
    gla_out_g = gain((L, BRANCH))
    lru_conv_w = nrm((L, LRU_CONV, BRANCH), LRU_CONV ** -0.5)
    lru_conv_b = nrm((L, BRANCH), 0.01)
    lru_w_a = nrm((L, LRU_BLOCKS, LRU_BLOCK_W, LRU_BLOCK_W), LRU_BLOCK_W ** -0.5)
    lru_b_a = nrm((L, BRANCH), 0.01)
    lru_w_x = nrm((L, LRU_BLOCKS, LRU_BLOCK_W, LRU_BLOCK_W), LRU_BLOCK_W ** -0.5)
    lru_b_x = nrm((L, BRANCH), 0.01)
    a0 = jax.random.uniform(next(ks), (L, BRANCH), f32, 0.9, 0.999)
    p0 = a0 ** (1.0 / LRU_C)
    lru_lambda = jnp.log(p0) - jnp.log1p(-p0)
    lru_out_g = gain((L, BRANCH))
    w_out = nrm((L, MIX_WIDTH, D_MODEL), MIX_WIDTH ** -0.5)
    final_g = gain((D_MODEL,))
    return {"x": x, "positions": positions, "norm_g": norm_g, "w_in": w_in,
            "s5_lambda_re": s5_lambda_re, "s5_lambda_im": s5_lambda_im,
            "s5_b_re": s5_b_re, "s5_b_im": s5_b_im, "s5_c_re": s5_c_re, "s5_c_im": s5_c_im,
            "s5_d": s5_d, "s5_log_dt": s5_log_dt, "s5_w_glu": s5_w_glu, "s5_b_glu": s5_b_glu,
            "s5_out_g": s5_out_g, "mla_q_norm_g": mla_q_norm_g, "mla_kv_norm_g": mla_kv_norm_g,
            "mla_w_uq": mla_w_uq, "mla_w_uk": mla_w_uk, "mla_w_uv": mla_w_uv, "mla_out_g": mla_out_g,
            "gla_w_gate": gla_w_gate, "gla_b_gate": gla_b_gate, "gla_out_g": gla_out_g,
            "lru_conv_w": lru_conv_w, "lru_conv_b": lru_conv_b, "lru_w_a": lru_w_a, "lru_b_a": lru_b_a,
            "lru_w_x": lru_w_x, "lru_b_x": lru_b_x, "lru_lambda": lru_lambda, "lru_out_g": lru_out_g,
            "w_out": w_out, "final_g": final_g}


def reference(x, positions, norm_g, w_in, s5_lambda_re, s5_lambda_im, s5_b_re, s5_b_im,
              s5_c_re, s5_c_im, s5_d, s5_log_dt, s5_w_glu, s5_b_glu, s5_out_g,
              mla_q_norm_g, mla_kv_norm_g, mla_w_uq, mla_w_uk, mla_w_uv, mla_out_g,
              gla_w_gate, gla_b_gate, gla_out_g, lru_conv_w, lru_conv_b, lru_w_a, lru_b_a,
              lru_w_x, lru_b_x, lru_lambda, lru_out_g, w_out, final_g):
    for l in range(DEPTH):
        h = rms_norm(x, norm_g[l])
        z = h @ w_in[l]
        (s5_u, s5_gate, mla_cq, mla_ckv, mla_kr, mla_gate, gla_q, gla_k, gla_v,
         gla_glr, gla_gate, lru_u, lru_gate) = split_cols(z)
        y_s5 = rms_norm(s5_mixer(s5_u, s5_lambda_re[l], s5_lambda_im[l], s5_b_re[l], s5_b_im[l],
                                 s5_c_re[l], s5_c_im[l], s5_d[l], s5_log_dt[l], s5_w_glu[l],
                                 s5_b_glu[l]), s5_out_g[l]) * jax.nn.silu(s5_gate)
        y_mla = rms_norm(mla_mixer(mla_cq, mla_ckv, mla_kr, positions, mla_q_norm_g[l],
                                   mla_kv_norm_g[l], mla_w_uq[l], mla_w_uk[l], mla_w_uv[l]),
                         mla_out_g[l]) * jax.nn.silu(mla_gate)
        y_gla = gla_mixer(gla_q, gla_k, gla_v, gla_glr, gla_w_gate[l], gla_b_gate[l],
                          gla_out_g[l]) * jax.nn.silu(gla_gate)
        y_lru = rms_norm(rglru_mixer(lru_u, lru_conv_w[l], lru_conv_b[l], lru_w_a[l], lru_b_a[l],
                                     lru_w_x[l], lru_b_x[l], lru_lambda[l]),
                         lru_out_g[l]) * jax.nn.silu(lru_gate)
        y = jnp.concatenate([y_s5, y_mla, y_gla, y_lru], axis=-1)
        x = x + y @ w_out[l]
    return rms_norm(x, final_g)
```

```cpp
#include <hip/hip_runtime.h>
#include <cstdio>
#include <cstdint>

namespace pg8 {
#define PG8_LAS __attribute__((address_space(3)))
typedef unsigned short bf16_t;
typedef short bf16x8 __attribute__((ext_vector_type(8)));
typedef float f32x4 __attribute__((ext_vector_type(4)));
typedef unsigned u32x4 __attribute__((ext_vector_type(4)));
constexpr int BM = 256, BK = 64, HALF = 128, HTB = HALF * BK * 2, STAGE_BYTES = 8 * HTB, NXCD = 8, WGM = 8;

__host__ __device__ __forceinline__ int lds_byte(int r, int c) { const int st = (r >> 4) * 2 + (c >> 5), rr = r & 15, cc = c & 31, ob = rr * 64 + cc * 2; return st * 1024 + (ob ^ (((ob >> 9) & 1) << 5)); }
__host__ __device__ __forceinline__ void stage_rc(int b, int& R, int& C) { const int st = b / 1024, sb = b % 1024, swz = sb ^ (((sb >> 9) & 1) << 5); R = (st >> 1) * 16 + swz / 64; C = (st & 1) * 32 + (swz % 64) / 2; }
__host__ __device__ __forceinline__ int perm32(int rho) { const int n = rho >> 4, i = rho & 15; return 8 * (i >> 2) + 4 * n + (i & 3); }

struct Unit { int pm, pn; };
struct Gemm { const bf16_t* A; const bf16_t* Bt; int M, N, K; };

struct StaticOrder {
    int nM, nN, nwg, G, c;
    __host__ __device__ void init(int M, int N, int G_, int c_) { nM = M / BM; nN = N / BM; nwg = nM * nN; G = G_; c = c_; }
    __host__ __device__ bool next(int i, Unit& u) const {
        const long L = (long)i * G + c; if (L >= nwg) return false;
        int wgid = (int)L; { const int q = nwg / NXCD, r = nwg % NXCD, xcd = wgid % NXCD, off = wgid / NXCD; wgid = (xcd < r ? xcd * (q + 1) : r * (q + 1) + (xcd - r) * q) + off; }
        const int nig = WGM * nN, gid = wgid / nig, fm = gid * WGM, gsz = (nM - fm) < WGM ? (nM - fm) : WGM;
        u.pm = fm + ((wgid % nig) % gsz); u.pn = (wgid % nig) / gsz; return true;
    }
    __device__ __forceinline__ void a_ready(const Unit&) const {}
    __device__ __forceinline__ void done(const Unit&) const {}
};

struct EpiF32 {
    static constexpr bool PERM = false, AFTER_DRAIN = false;
    float* C; int ldc;
    __device__ __forceinline__ void operator()(const f32x4 (&acc)[2][2][4][2], const Unit& u, int wr, int wc, int fr, int fq) const {
        const int row0 = u.pm * BM + wr * 64 + fr, col0 = u.pn * BM + wc * 32 + 4 * fq;
#pragma unroll
        for (int ai = 0; ai < 2; ++ai)
#pragma unroll
            for (int m = 0; m < 4; ++m) { float* rowp = C + (size_t)(row0 + ai * HALF + m * 16) * ldc + col0;
#pragma unroll
                for (int bj = 0; bj < 2; ++bj)
#pragma unroll
                    for (int n = 0; n < 2; ++n) *(f32x4*)(rowp + bj * HALF + n * 16) = acc[ai][bj][m][n]; }
    }
};
struct EpiRes {
    static constexpr bool PERM = false, AFTER_DRAIN = false;
    const float* base; float* O; int ldc;
    __device__ __forceinline__ void operator()(const f32x4 (&acc)[2][2][4][2], const Unit& u, int wr, int wc, int fr, int fq) const {
        const int row0 = u.pm * BM + wr * 64 + fr, col0 = u.pn * BM + wc * 32 + 4 * fq;
#pragma unroll
        for (int ai = 0; ai < 2; ++ai)
#pragma unroll
            for (int m = 0; m < 4; ++m) { const size_t off = (size_t)(row0 + ai * HALF + m * 16) * ldc + col0;
#pragma unroll
                for (int bj = 0; bj < 2; ++bj)
#pragma unroll
                    for (int n = 0; n < 2; ++n) { const f32x4 b = *(const f32x4*)(base + off + bj * HALF + n * 16); *(f32x4*)(O + off + bj * HALF + n * 16) = b + acc[ai][bj][m][n]; } }
    }
};

template <class Epi, class Sched, bool ALIGN_EPI = false, bool SP2 = false>
__device__ __forceinline__ void gemm_phase(PG8_LAS unsigned char* lds, const Gemm g, const Sched& S, const Epi& E) {
    const int tid = threadIdx.x, wid = __builtin_amdgcn_readfirstlane(tid >> 6), lane = tid & 63, wr = wid >> 2, wc = wid & 3, fr = lane & 15, fq = lane >> 4;
    const int K = g.K, nt = K / BK;
    unsigned voffA[2], voffB[2];
#pragma unroll
    for (int i = 0; i < 2; ++i) { int R, C; stage_rc(tid * 16 + i * 8192, R, C); const int Rb = Epi::PERM ? ((R & ~31) + perm32(R & 31)) : R;
        voffA[i] = (unsigned)(R * K + C) * 2u; voffB[i] = (unsigned)(Rb * K + C) * 2u; }
    const size_t kstep = (size_t)(BK * 2);
    const size_t hstep = (size_t)HALF * K * 2;
    const size_t tstep = 2 * hstep;
    const unsigned ldsw = (unsigned)wid * 1024u;
    const int aoff = lds_byte(wr * 64 + fr, fq * 8), boff = lds_byte(wc * 32 + fr, fq * 8);
#define PG8_SA(b, h) (((b) * 2 + (h)) * HTB)
#define PG8_SB(b, h) ((4 + (b) * 2 + (h)) * HTB)
#define PG8_STAGE(bufoff, gbase, voff) do { _Pragma("unroll") for (int _i = 0; _i < 2; ++_i) \
        __builtin_amdgcn_global_load_lds((const unsigned*)((const char*)(gbase) + (voff)[_i]), (PG8_LAS unsigned*)(lds + (bufoff) + ldsw + _i * 8192), 16, 0, 0); } while (0)
#define PG8_LDA(dst, b, h) do { _Pragma("unroll") for (int m = 0; m < 4; ++m) _Pragma("unroll") for (int k = 0; k < 2; ++k) dst[m][k] = *(const PG8_LAS bf16x8*)(lds + PG8_SA(b, h) + aoff + m * 2048 + k * 1024); } while (0)
#define PG8_LDB(dst, b, h) do { _Pragma("unroll") for (int n = 0; n < 2; ++n) _Pragma("unroll") for (int k = 0; k < 2; ++k) dst[n][k] = *(const PG8_LAS bf16x8*)(lds + PG8_SB(b, h) + boff + n * 2048 + k * 1024); } while (0)
#define PG8_MMA(ai, bj, At, Bt) do { __builtin_amdgcn_s_setprio(1); _Pragma("unroll") for (int m = 0; m < 4; ++m) _Pragma("unroll") for (int n = 0; n < 2; ++n) _Pragma("unroll") for (int k = 0; k < 2; ++k) \
        acc[ai][bj][m][n] = __builtin_amdgcn_mfma_f32_16x16x32_bf16(Bt[n][k], At[m][k], acc[ai][bj][m][n], 0, 0, 0); __builtin_amdgcn_s_setprio(0); } while (0)
#define PG8_WAIT_V(n) asm volatile("s_waitcnt vmcnt(" #n ")" ::: "memory")
#define PG8_WAIT_L(n) asm volatile("s_waitcnt lgkmcnt(" #n ")" ::: "memory")
#define PG8_BAR __builtin_amdgcn_s_barrier()
#define PG8_SCHED __builtin_amdgcn_sched_barrier(0)
    Unit cur, nxt; int ui = 0;
    if (!S.next(0, cur)) return;
    f32x4 acc[2][2][4][2];
#pragma unroll
    for (int a = 0; a < 2; ++a)
#pragma unroll
        for (int b = 0; b < 2; ++b)
#pragma unroll
            for (int m = 0; m < 4; ++m)
#pragma unroll
                for (int n = 0; n < 2; ++n) acc[a][b][m][n] = (f32x4){0.f, 0.f, 0.f, 0.f};
    bf16x8 At[4][2], B0[2][2], B1[2][2];
    const char* cA = (const char*)g.A + (size_t)cur.pm * tstep; const char* cB = (const char*)g.Bt + (size_t)cur.pn * tstep;
    S.a_ready(cur);
    if constexpr (SP2) {
        PG8_STAGE(PG8_SB(0, 0), cB, voffB); PG8_STAGE(PG8_SB(0, 1), cB + hstep, voffB); PG8_STAGE(PG8_SA(0, 0), cA, voffA); PG8_STAGE(PG8_SA(0, 1), cA + hstep, voffA);
        if (wr == 1) PG8_BAR;
        PG8_WAIT_V(2); PG8_BAR;
        PG8_STAGE(PG8_SB(1, 0), cB + kstep, voffB); PG8_STAGE(PG8_SA(1, 0), cA + kstep, voffA); PG8_STAGE(PG8_SB(1, 1), cB + hstep + kstep, voffB);
        PG8_WAIT_V(6); PG8_BAR;
    } else {
        PG8_STAGE(PG8_SB(0, 0), cB, voffB); PG8_STAGE(PG8_SA(0, 0), cA, voffA); PG8_STAGE(PG8_SB(0, 1), cB + hstep, voffB); PG8_STAGE(PG8_SA(0, 1), cA + hstep, voffA);
        if (wr == 1) PG8_BAR;
        PG8_WAIT_V(4); PG8_BAR;
        PG8_STAGE(PG8_SB(1, 0), cB + kstep, voffB); PG8_STAGE(PG8_SA(1, 0), cA + kstep, voffA); PG8_STAGE(PG8_SB(1, 1), cB + hstep + kstep, voffB);
        PG8_WAIT_V(6); PG8_BAR;
    }
    for (;;) {
        const bool has_next = S.next(ui + 1, nxt);
        const char* nA = has_next ? (const char*)g.A + (size_t)nxt.pm * tstep : cA; const char* nB = has_next ? (const char*)g.Bt + (size_t)nxt.pn * tstep : cB;
        for (int t = 0; t < nt; t += 2) {
            const bool last = (t == nt - 2);
            const char* a1 = cA + (size_t)(t + 1) * kstep;
            const char* a2 = last ? nA : cA + (size_t)(t + 2) * kstep; const char* b2 = last ? nB : cB + (size_t)(t + 2) * kstep;
            const char* a3 = a2 + kstep; const char* b3 = b2 + kstep;
            if (last && has_next) S.a_ready(nxt);
            if constexpr (SP2) {
            PG8_LDB(B0, 0, 0); PG8_LDB(B1, 0, 1); PG8_SCHED; PG8_LDA(At, 0, 0); PG8_STAGE(PG8_SA(1, 1), a1 + hstep, voffA);
            PG8_WAIT_V(8); PG8_WAIT_L(0); PG8_BAR; PG8_MMA(0, 0, At, B0); PG8_MMA(0, 1, At, B1); PG8_BAR; PG8_SCHED;
            PG8_LDA(At, 0, 1); PG8_STAGE(PG8_SB(0, 0), b2, voffB); PG8_STAGE(PG8_SB(0, 1), b2 + hstep, voffB); PG8_STAGE(PG8_SA(0, 0), a2, voffA);
            PG8_WAIT_V(8); PG8_WAIT_L(0); PG8_BAR; PG8_MMA(1, 0, At, B0); PG8_MMA(1, 1, At, B1); PG8_BAR; PG8_SCHED;
            PG8_LDB(B0, 1, 0); PG8_LDB(B1, 1, 1); PG8_SCHED; PG8_LDA(At, 1, 0); PG8_STAGE(PG8_SA(0, 1), a2 + hstep, voffA);
            PG8_WAIT_V(8); PG8_WAIT_L(0); PG8_BAR; PG8_MMA(0, 0, At, B0); PG8_MMA(0, 1, At, B1); PG8_BAR; PG8_SCHED;
            PG8_LDA(At, 1, 1); PG8_STAGE(PG8_SB(1, 0), b3, voffB); PG8_STAGE(PG8_SB(1, 1), b3 + hstep, voffB); PG8_STAGE(PG8_SA(1, 0), a3, voffA);
            PG8_WAIT_V(8); PG8_WAIT_L(0); PG8_BAR; PG8_MMA(1, 0, At, B0); PG8_MMA(1, 1, At, B1); PG8_BAR; PG8_SCHED;
            } else {
            PG8_LDB(B0, 0, 0); PG8_SCHED; PG8_LDA(At, 0, 0); PG8_STAGE(PG8_SA(1, 1), a1 + hstep, voffA);
            PG8_WAIT_L(8); PG8_BAR; PG8_WAIT_L(0); PG8_MMA(0, 0, At, B0); PG8_BAR; PG8_SCHED;
            PG8_LDB(B1, 0, 1); PG8_STAGE(PG8_SB(0, 0), b2, voffB);
            PG8_BAR; PG8_WAIT_L(0); PG8_MMA(0, 1, At, B1); PG8_BAR;
            PG8_LDA(At, 0, 1); PG8_STAGE(PG8_SA(0, 0), a2, voffA);
            PG8_BAR; PG8_WAIT_L(0); PG8_MMA(1, 0, At, B0); PG8_BAR; PG8_SCHED;
            PG8_STAGE(PG8_SB(0, 1), b2 + hstep, voffB);
            PG8_WAIT_V(6); PG8_BAR; PG8_MMA(1, 1, At, B1); PG8_BAR;
            PG8_LDB(B0, 1, 0); PG8_SCHED; PG8_LDA(At, 1, 0); PG8_STAGE(PG8_SA(0, 1), a2 + hstep, voffA);
            PG8_WAIT_L(8); PG8_BAR; PG8_WAIT_L(0); PG8_MMA(0, 0, At, B0); PG8_BAR; PG8_SCHED;
            PG8_LDB(B1, 1, 1); PG8_STAGE(PG8_SB(1, 0), b3, voffB);
            PG8_BAR; PG8_WAIT_L(0); PG8_MMA(0, 1, At, B1); PG8_BAR;
            PG8_LDA(At, 1, 1); PG8_STAGE(PG8_SA(1, 0), a3, voffA);
            PG8_BAR; PG8_WAIT_L(0); PG8_MMA(1, 0, At, B0); PG8_BAR; PG8_SCHED;
            PG8_STAGE(PG8_SB(1, 1), b3 + hstep, voffB);
            PG8_WAIT_V(6); PG8_BAR; PG8_MMA(1, 1, At, B1); PG8_BAR;
            }
        }
        if constexpr (ALIGN_EPI) { if (wr == 0) PG8_BAR; }
        if constexpr (!Epi::AFTER_DRAIN) { E(acc, cur, wr, wc, fr, fq); S.done(cur); }
        if (!has_next) break;
#pragma unroll
        for (int a = 0; a < 2; ++a)
#pragma unroll
            for (int b = 0; b < 2; ++b)
#pragma unroll
                for (int m = 0; m < 4; ++m)
#pragma unroll
                    for (int n = 0; n < 2; ++n) acc[a][b][m][n] = (f32x4){0.f, 0.f, 0.f, 0.f};
        cur = nxt; cA = nA; cB = nB; ++ui;
        if constexpr (ALIGN_EPI) { if (wr == 1) PG8_BAR; }
    }
    PG8_WAIT_V(0);
    if constexpr (!ALIGN_EPI) { if (wr == 0) PG8_BAR; }
    PG8_BAR;
#undef PG8_SA
#undef PG8_SB
#undef PG8_STAGE
#undef PG8_LDA
#undef PG8_LDB
#undef PG8_MMA
#undef PG8_WAIT_V
#undef PG8_WAIT_L
#undef PG8_BAR
#undef PG8_SCHED
}
}

constexpr int NWAVES = 8;
constexpr int NB = 4, SEQ = 2048, T = NB * SEQ, DM = 4096, BR = 1024, DEPTH = 2;
constexpr int INC = 9552;
constexpr int ZC = 9728;
constexpr int Z_S5U = 0, Z_S5G = 1024, Z_CQ = 2048, Z_CKV = 2816, Z_MG = 3328, Z_GQ = 4352, Z_GK = 4864, Z_GV = 5376, Z_GG = 6400, Z_LU = 7424, Z_LG = 8448, Z_KR = 9472, Z_GLR = 9536;
constexpr int QR = 768, KVR = 512, NH = 8, DQK = 192, DNOPE = 128, DROPE = 64, DV = 128;
constexpr int S5G = 64, S5H = 16, S5P = 64;
constexpr int GH = 4, GDK = 128, GDV = 256;
constexpr float EPS = 1e-6f;

constexpr size_t al256(size_t x) { return (x + 255) & ~(size_t)255; }
constexpr size_t WS_CTL = 0, CTL_ZERO_BYTES = 1u << 20;
constexpr size_t WS_WTIN = CTL_ZERO_BYTES;
constexpr size_t WS_WTOUT = WS_WTIN + (size_t)2 * ZC * DM * 2;
constexpr size_t WS_HB = WS_WTOUT + (size_t)2 * DM * DM * 2;
constexpr size_t WS_Z = WS_HB + (size_t)T * DM * 2;
constexpr size_t WS_XB = WS_Z + (size_t)T * ZC * 4;
constexpr size_t WS_CQN = WS_XB + (size_t)T * DM * 4;
constexpr size_t WS_CKVN = WS_CQN + (size_t)T * QR * 4;
constexpr size_t WS_KR = WS_CKVN + (size_t)T * KVR * 4;
constexpr size_t WS_Q = WS_KR + (size_t)T * DROPE * 4;
constexpr size_t WS_KN = WS_Q + (size_t)T * NH * DQK * 4;
constexpr size_t WS_V = WS_KN + (size_t)T * BR * 4;
constexpr size_t WS_LOGA = WS_V + (size_t)T * BR * 4;
constexpr size_t WS_XC = WS_LOGA + (size_t)T * 512 * 4;
constexpr size_t WS_RPRE = WS_XC + (size_t)T * BR * 4;
constexpr size_t WS_IPRE = WS_RPRE + (size_t)T * BR * 4;
constexpr size_t WS_HLRU = WS_IPRE + (size_t)T * BR * 4;
constexpr size_t WS_YS5 = WS_HLRU + (size_t)T * BR * 4;
constexpr size_t WS_S5O = WS_YS5 + (size_t)T * BR * 4;
constexpr size_t WS_OGLA = WS_S5O + (size_t)T * BR * 4;
constexpr size_t WS_OMLA = WS_OGLA + (size_t)T * BR * 4;
constexpr size_t WS_ROPE = WS_OMLA + (size_t)T * BR * 4;
constexpr size_t WS_LAMB = WS_ROPE + (size_t)T * 64 * 4;
constexpr size_t WS_BBAR = WS_LAMB + (size_t)2 * 64 * 64 * 2 * 4;
constexpr size_t WS_END = WS_BBAR + (size_t)2 * 64 * 64 * 16 * 2 * 4;
static_assert(WS_END <= 1251999744ull, "d_ws map exceeds the guaranteed workspace");

constexpr int RING_OFF = 0, RING_BYTES = 131072;
constexpr int LDSCTL_OFF = RING_BYTES, MISC_OFF = LDSCTL_OFF + 320;
constexpr int LDS_BYTES = 147456;

#define GAS __attribute__((address_space(1)))
#define LAS __attribute__((address_space(3)))
typedef unsigned short bf16;
typedef unsigned v4u __attribute__((ext_vector_type(4)));
typedef float f32x4 __attribute__((ext_vector_type(4)));
typedef GAS unsigned gu32;
#define RLX_AGENT __ATOMIC_RELAXED, __HIP_MEMORY_SCOPE_AGENT
#define LDS_WAIT() asm volatile("s_waitcnt lgkmcnt(0)" ::: "memory")
__device__ __forceinline__ unsigned f2bf(float f) { unsigned u = __builtin_bit_cast(unsigned, f); return (u + 0x7fffu + ((u >> 16) & 1u)) >> 16; }
__device__ __forceinline__ unsigned pk2(float lo, float hi) { return f2bf(lo) | (f2bf(hi) << 16); }

#define XB_TMO      128
#define XB_XCNT(j)  (256  + 64 * (j))
#define XB_XSUB(j)  (1280 + 64 * (j))
#define XB_XGEN(j)  (2304 + 64 * (j))
#define XB_TOP      3328
#define XB_TOPGEN   3392
#define XCD_BAR_WORDS 3456
#define XB_SPIN_CAP (1u << 23)
__device__ __forceinline__ unsigned xb_ld(unsigned* p)              { return __hip_atomic_load(p, __ATOMIC_RELAXED, __HIP_MEMORY_SCOPE_AGENT); }
__device__ __forceinline__ unsigned xb_add(unsigned* p, unsigned v) { return __hip_atomic_fetch_add(p, v, __ATOMIC_RELAXED, __HIP_MEMORY_SCOPE_AGENT); }
__device__ __forceinline__ unsigned xb_xcc_id() { return (unsigned)__builtin_amdgcn_s_getreg((3 << 11) | 20) & 0xFu; }
#define XB_SPIN(cond, bar) do { unsigned _sp = 0; while (cond) { __builtin_amdgcn_s_sleep(1); \
    if ((++_sp & 255u) == 0u) { if (xb_ld(&(bar)[XB_TMO])) break; if (_sp > XB_SPIN_CAP) { atomicAdd(&(bar)[XB_TMO], 1u); break; } } } } while (0)
struct XcdBarrier { unsigned* bar; unsigned x; volatile LAS unsigned* st; };
__device__ __forceinline__ XcdBarrier xcd_barrier_post(unsigned* bar, volatile LAS unsigned* st) {
    XcdBarrier b; b.bar = bar; b.x = xb_xcc_id(); b.st = st;
    if (threadIdx.x == 0) (void)xb_add(&bar[XB_XCNT(b.x)], 1u);
    return b;
}
__device__ __forceinline__ void xcd_barrier_complete(unsigned* bar, unsigned x, unsigned& nloc, unsigned& nx) {
    const unsigned G = gridDim.x * gridDim.y * gridDim.z;
    unsigned sum, cnt, mine, sp = 0u;
    for (;;) {
        sum = 0u; cnt = 0u; mine = 0u;
#pragma unroll
        for (unsigned j = 0; j < 16; ++j) { const unsigned c = xb_ld(&bar[XB_XCNT(j)]); sum += c; cnt += (c > 0u) ? 1u : 0u; mine = (j == x) ? c : mine; }
        if (sum == G) break;
        __builtin_amdgcn_s_sleep(1);
        if ((++sp & 255u) == 0u) { if (xb_ld(&bar[XB_TMO])) break; if (sp > XB_SPIN_CAP) { atomicAdd(&bar[XB_TMO], 1u); break; } }
    }
    nloc = mine > 0u ? mine : 1u; nx = cnt > 0u ? cnt : 1u;
}
__device__ __forceinline__ void xcd_barrier(const XcdBarrier& b) {
    asm volatile("s_waitcnt vmcnt(0)" ::: "memory");
    __syncthreads();
    if (threadIdx.x == 0) {
        unsigned* bar = b.bar;
        __builtin_amdgcn_s_waitcnt(0);
        unsigned nloc = b.st[0], nx = b.st[1];
        if (nloc == 0u) { xcd_barrier_complete(bar, b.x, nloc, nx); b.st[0] = nloc; b.st[1] = nx; }
        const unsigned old = xb_add(&bar[XB_XSUB(b.x)], 1u);
        const unsigned gen = old / nloc;
        if (old + 1u == (gen + 1u) * nloc) {
            __builtin_amdgcn_fence(__ATOMIC_RELEASE, "agent");
            asm volatile("s_waitcnt vmcnt(0)" ::: "memory");
            const unsigned og = xb_add(&bar[XB_TOP], 1u);
            const unsigned tg = og / nx;
            if (og + 1u == (tg + 1u) * nx) xb_add(&bar[XB_TOPGEN], 1u);
            else XB_SPIN(xb_ld(&bar[XB_TOPGEN]) == tg, bar);
            __builtin_amdgcn_fence(__ATOMIC_ACQUIRE, "agent");
            xb_add(&bar[XB_XGEN(b.x)], 1u);
            asm volatile("s_waitcnt vmcnt(0)" ::: "memory");
        } else {
            XB_SPIN(xb_ld(&bar[XB_XGEN(b.x)]) == gen, bar);
            __builtin_amdgcn_fence(__ATOMIC_ACQUIRE, "agent");
            asm volatile("s_waitcnt vmcnt(0)" ::: "memory");
        }
    }
    __syncthreads();
}

struct Args { const void* in[34]; float* out; unsigned char* ws; int ph_lo, ph_hi; };
struct Frame {
    LAS unsigned char* lds;
    unsigned char* ldsg;
    int vcu, G;
};
typedef const __attribute__((address_space(4))) Args* ArgsP;
#define IN_F(i) ((const float*)AP->in[i])
#define PHASE_IDS() int tid = threadIdx.x; asm volatile("" : "+v"(tid)); const int lane = tid & 63; const int wave = __builtin_amdgcn_readfirstlane(tid >> 6); (void)lane; (void)wave; \
    ArgsP AP = (ArgsP)__builtin_amdgcn_kernarg_segment_ptr(); asm volatile("" : "+s"(AP))
#define WSF(off) ((float*)(AP->ws + (off)))

__device__ __forceinline__ float wave_sum(float v) {
#pragma unroll
    for (int o = 1; o < 64; o <<= 1) v += __shfl_xor(v, o);
    return v;
}
__device__ __forceinline__ float wave_max(float v) {
#pragma unroll
    for (int o = 1; o < 64; o <<= 1) v = fmaxf(v, __shfl_xor(v, o));
    return v;
}
__device__ __forceinline__ float sigmoidf_(float x) { return 1.0f / (1.0f + __expf(-x)); }
__device__ __forceinline__ float siluf_(float x) { return x * sigmoidf_(x); }
__device__ __forceinline__ float softplusf_(float x) { return fmaxf(x, 0.f) + log1pf(__expf(-fabsf(x))); }
__device__ __forceinline__ float gelu_tanh(float x) { const float u = 0.7978845608028654f * (x + 0.044715f * x * x * x); const float e = __expf(2.f * u); const float th = 1.f - 2.f / (e + 1.f); return 0.5f * x * (1.f + th); }

__device__ __forceinline__ int zc_src(int n) {
    if (n < 3328) return n; if (n < 6400) return n + 64; if (n < 9472) return n + 80; if (n < 9536) return n - 9472 + 3328; if (n < 9552) return n - 9536 + 6464; return -1;
}
template <bool MAPPED>
__device__ __forceinline__ void p0_transpose_item(const float* W, int K, int Nsrc, int Ndst, bf16* WT, LAS float* scr, int item, int lane) {
    const int nblk = Ndst / 32, kb = item / nblk, nb = item % nblk, k0 = 64 * kb, n0 = 32 * nb;
    const int nd = n0 + (lane & 31); const int ns = MAPPED ? zc_src(nd) : nd;
#pragma unroll 8
    for (int i = 0; i < 32; ++i) { const int kk = 2 * i + (lane >> 5); scr[kk * 33 + (lane & 31)] = ns >= 0 ? W[(size_t)(k0 + kk) * Nsrc + ns] : 0.f; }
    LDS_WAIT(); asm volatile("" ::: "memory");
    const int c = lane & 7;
#pragma unroll
    for (int j = 0; j < 4; ++j) { const int n = (lane >> 3) + 8 * j; const LAS float* s = scr + (8 * c) * 33 + n;
        v4u o; o.x = pk2(s[0 * 33], s[1 * 33]); o.y = pk2(s[2 * 33], s[3 * 33]); o.z = pk2(s[4 * 33], s[5 * 33]); o.w = pk2(s[6 * 33], s[7 * 33]);
        *(GAS v4u*)(WT + (size_t)(n0 + n) * K + k0 + 8 * c) = o; }
    LDS_WAIT(); asm volatile("" ::: "memory");
}
template <bool TOBF>
__device__ __forceinline__ void rms_row(const float* xrow, const float* g, void* orow, int lane) {
    const f32x4* xr = (const f32x4*)xrow + lane; const f32x4* gr = (const f32x4*)g + lane;
    f32x4 v[16]; float s = 0.f;
#pragma unroll
    for (int j = 0; j < 16; ++j) { v[j] = xr[64 * j]; s += (v[j].x * v[j].x + v[j].y * v[j].y) + (v[j].z * v[j].z + v[j].w * v[j].w); }
    const float rs = 1.0f / sqrtf(wave_sum(s) * (1.f / DM) + EPS);
#pragma unroll
    for (int j = 0; j < 16; ++j) { const f32x4 gg = gr[64 * j]; const f32x4 o = v[j] * rs * gg;
        if (TOBF) ((unsigned long long*)orow)[lane + 64 * j] = (unsigned long long)pk2(o.x, o.y) | ((unsigned long long)pk2(o.z, o.w) << 32);
        else ((f32x4*)orow)[lane + 64 * j] = o; }
}

__device__ __forceinline__ void p0_prologue(Frame& F) {
    PHASE_IDS();
    LAS float* scr = (LAS float*)(F.lds + RING_OFF + wave * 16384);
    const int gw = F.vcu * NWAVES + wave, NGW = F.G * NWAVES;
    constexpr int I_IN = (DM / 64) * (ZC / 32), I_OUT = (DM / 64) * (DM / 32);
    constexpr int NITEMS = 2 * I_IN + 2 * I_OUT;
    for (int it = gw; it < NITEMS; it += NGW) {
        int r = it;
        if (r < 2 * I_IN) { const int l = r / I_IN; r -= l * I_IN;
            p0_transpose_item<true>(IN_F(3) + (size_t)l * DM * INC, DM, INC, ZC, (bf16*)(AP->ws + WS_WTIN) + (size_t)l * ZC * DM, scr, r, lane); continue; }
        r -= 2 * I_IN; { const int l = r / I_OUT; r -= l * I_OUT;
            p0_transpose_item<false>(IN_F(32) + (size_t)l * DM * DM, DM, DM, DM, (bf16*)(AP->ws + WS_WTOUT) + (size_t)l * DM * DM, scr, r, lane); }
    }
    { const int* pos = (const int*)AP->in[1]; float* rt = WSF(WS_ROPE);
      for (int e = blockIdx.x * 512 + tid; e < T * 32; e += F.G * 512) { const int m = e >> 5, i = e & 31;
          const double invf = exp(-(double)i * (9.210340371976184 / 32.0));
          double ang = (double)pos[m] * invf; const double k = rint(ang * 0.15915494309189535); ang -= k * 6.283185307179586;
          const float a = (float)ang; rt[m * 64 + i] = cosf(a); rt[m * 64 + 32 + i] = sinf(a); } }
    { float* lb = WSF(WS_LAMB); float* bb = WSF(WS_BBAR);
      for (int e = blockIdx.x * 512 + tid; e < 2 * 64 * 64; e += F.G * 512) { const int l = e >> 12, g = (e >> 6) & 63;
          const float lre = IN_F(4)[e], lim = IN_F(5)[e]; const float dt = expf(IN_F(11)[l * 64 + g]);
          const float mag = expf(lre * dt); float sn, cs; sincosf(lim * dt, &sn, &cs);
          const float bre = mag * cs, bim = mag * sn; lb[2 * e] = bre; lb[2 * e + 1] = bim;
          const float nre = bre - 1.f, nim = bim, den = 1.f / (lre * lre + lim * lim);
          const float fre = (nre * lre + nim * lim) * den, fim = (nim * lre - nre * lim) * den;
          for (int h = 0; h < 16; ++h) { const float br = IN_F(6)[e * 16 + h], bi = IN_F(7)[e * 16 + h];
              bb[(e * 16 + h) * 2] = fre * br - fim * bi; bb[(e * 16 + h) * 2 + 1] = fre * bi + fim * br; } } }
    for (int m = gw; m < T; m += NGW) { asm volatile("" ::: "memory");  rms_row<true>(IN_F(0) + (size_t)m * DM, IN_F(2), (bf16*)(AP->ws + WS_HB) + (size_t)m * DM, lane); }
}

__device__ __forceinline__ void p2_rows(Frame& F, int l) {
    PHASE_IDS();
    const int gw = F.vcu * NWAVES + wave, NGW = F.G * NWAVES;
    const float* z = WSF(WS_Z);
    for (int m = gw; m < T; m += NGW) {
        asm volatile("" ::: "memory");
        const float* zr = z + (size_t)m * ZC;
        { float v[12]; float s = 0.f;
#pragma unroll
          for (int j = 0; j < 12; ++j) { v[j] = zr[Z_CQ + lane + 64 * j]; s += v[j] * v[j]; }
          const float rs = 1.0f / sqrtf(wave_sum(s) * (1.f / QR) + EPS);
#pragma unroll
          for (int j = 0; j < 12; ++j) WSF(WS_CQN)[(size_t)m * QR + lane + 64 * j] = v[j] * rs * IN_F(15)[l * QR + lane + 64 * j]; }
        { float v[8]; float s = 0.f;
#pragma unroll
          for (int j = 0; j < 8; ++j) { v[j] = zr[Z_CKV + lane + 64 * j]; s += v[j] * v[j]; }
          const float rs = 1.0f / sqrtf(wave_sum(s) * (1.f / KVR) + EPS);
#pragma unroll
          for (int j = 0; j < 8; ++j) WSF(WS_CKVN)[(size_t)m * KVR + lane + 64 * j] = v[j] * rs * IN_F(16)[l * KVR + lane + 64 * j]; }
        if (lane < 32) { const float x1 = zr[Z_KR + lane], x2 = zr[Z_KR + 32 + lane]; const float c = WSF(WS_ROPE)[m * 64 + lane], s = WSF(WS_ROPE)[m * 64 + 32 + lane];
            WSF(WS_KR)[m * 64 + lane] = x1 * c - x2 * s; WSF(WS_KR)[m * 64 + 32 + lane] = x2 * c + x1 * s; }
        { float gl[16];
#pragma unroll
          for (int r = 0; r < 16; ++r) gl[r] = zr[Z_GLR + r];
#pragma unroll 1
          for (int j = 0; j < 8; ++j) { const int c = lane + 64 * j; float a = IN_F(22)[l * 512 + c];
#pragma unroll
              for (int r = 0; r < 16; ++r) a += gl[r] * IN_F(21)[(l * 16 + r) * 512 + c];
              WSF(WS_LOGA)[(size_t)m * 512 + c] = -softplusf_(-a) * (1.f / 16.f); } }
        { const int t = m & (SEQ - 1);
#pragma unroll 1
          for (int j = 0; j < 16; ++j) { const int c = lane + 64 * j; float a = IN_F(25)[l * BR + c];
#pragma unroll
              for (int w = 0; w < 4; ++w) { const int tt = t - 3 + w; if (tt >= 0) a += IN_F(24)[(l * 4 + w) * BR + c] * z[(size_t)(m - 3 + w) * ZC + Z_LU + c]; }
              WSF(WS_XC)[(size_t)m * BR + c] = a; } }
    }
}
__device__ __forceinline__ void p2_s5(Frame& F, int l) {
    PHASE_IDS();
    const int gw = F.vcu * NWAVES + wave, NGW = F.G * NWAVES;
    float* wl = (float*)(F.ldsg + RING_OFF + wave * 16384);
    float* xs = wl;
    float* cs = wl + 2048;
    const float* z = WSF(WS_Z);
    for (int it = gw; it < NB * S5G; it += NGW) {
        const int b = it >> 6, g = it & 63, lg = l * 64 + g;
        const float lbr = WSF(WS_LAMB)[(lg * 64 + lane) * 2], lbi = WSF(WS_LAMB)[(lg * 64 + lane) * 2 + 1];
        float br[16], bi[16];
#pragma unroll
        for (int h = 0; h < 16; ++h) { br[h] = WSF(WS_BBAR)[((lg * 64 + lane) * 16 + h) * 2]; bi[h] = WSF(WS_BBAR)[((lg * 64 + lane) * 16 + h) * 2 + 1]; }
#pragma unroll
        for (int h = 0; h < 16; ++h) { cs[(h * 64 + lane) * 2] = IN_F(8)[(lg * 16 + h) * 64 + lane]; cs[(h * 64 + lane) * 2 + 1] = IN_F(9)[(lg * 16 + h) * 64 + lane]; }
        float xr = 0.f, xi = 0.f;
        const int so = lane >> 2, h0 = (lane & 3) * 4;
        float dd[4];
#pragma unroll
        for (int i = 0; i < 4; ++i) dd[i] = IN_F(10)[lg * 16 + h0 + i];
        for (int t0 = 0; t0 < SEQ; t0 += 16) {
            asm volatile("" ::: "memory");
            const size_t m0 = (size_t)b * SEQ + t0;
            const f32x4 uq = *(const f32x4*)(z + (m0 + so) * ZC + Z_S5U + g * 16 + h0);
#pragma unroll
            for (int s = 0; s < 16; ++s) {
                float bur = 0.f, bui = 0.f;
#pragma unroll
                for (int h = 0; h < 16; ++h) { const float comp = (h & 3) == 0 ? uq.x : (h & 3) == 1 ? uq.y : (h & 3) == 2 ? uq.z : uq.w;
                    const float u = __shfl(comp, s * 4 + (h >> 2)); bur += br[h] * u; bui += bi[h] * u; }
                const float nr = lbr * xr - lbi * xi + bur, ni = lbr * xi + lbi * xr + bui; xr = nr; xi = ni;
                xs[(s * 64 + lane) * 2] = xr; xs[(s * 64 + lane) * 2 + 1] = xi;
            }
            LDS_WAIT(); asm volatile("" ::: "memory");
            float acc[4] = {0.f, 0.f, 0.f, 0.f};
            for (int p = 0; p < 64; ++p) { const float ar = xs[(so * 64 + p) * 2], ai = xs[(so * 64 + p) * 2 + 1];
#pragma unroll
                for (int i = 0; i < 4; ++i) acc[i] += cs[((h0 + i) * 64 + p) * 2] * ar - cs[((h0 + i) * 64 + p) * 2 + 1] * ai; }
            f32x4 o; o.x = gelu_tanh(acc[0] + dd[0] * uq.x); o.y = gelu_tanh(acc[1] + dd[1] * uq.y); o.z = gelu_tanh(acc[2] + dd[2] * uq.z); o.w = gelu_tanh(acc[3] + dd[3] * uq.w);
            *(f32x4*)(WSF(WS_YS5) + (m0 + so) * BR + g * 16 + h0) = o;
            LDS_WAIT(); asm volatile("" ::: "memory");
        }
    }
}

template <int MODE>
__device__ __forceinline__ void ngemm_tile(Frame& F, const float* A, int lda, const float* B, int ldb, int K, float* C, int ldc, int row0, int col0, const float* aux) {
    float* As = (float*)(F.ldsg + RING_OFF);
    float* Bs = As + 16 * 132;
    PHASE_IDS();
    const int ty = tid >> 4, tx = tid & 15;
    float acc[4][8];
#pragma unroll
    for (int i = 0; i < 4; ++i)
#pragma unroll
        for (int j = 0; j < 8; ++j) acc[i][j] = 0.f;
    const int ar = tid >> 2, ak = (tid & 3) * 4, bk = tid >> 5, bn = (tid & 31) * 4;
    for (int k0 = 0; k0 < K; k0 += 16) {
        asm volatile("" ::: "memory");
        const f32x4 av = *(const f32x4*)(A + (size_t)(row0 + ar) * lda + k0 + ak);
        const f32x4 bv = *(const f32x4*)(B + (size_t)(k0 + bk) * ldb + col0 + bn);
        __syncthreads();
        As[(ak + 0) * 132 + ar] = av.x; As[(ak + 1) * 132 + ar] = av.y; As[(ak + 2) * 132 + ar] = av.z; As[(ak + 3) * 132 + ar] = av.w;
        *(f32x4*)(Bs + bk * 128 + bn) = bv;
        __syncthreads();
#pragma unroll
        for (int k = 0; k < 16; ++k) {
            const f32x4 a4 = *(const f32x4*)(As + k * 132 + ty * 4);
            const f32x4 b0 = *(const f32x4*)(Bs + k * 128 + tx * 8), b1 = *(const f32x4*)(Bs + k * 128 + tx * 8 + 4);
            const float aa[4] = {a4.x, a4.y, a4.z, a4.w}; const float bb[8] = {b0.x, b0.y, b0.z, b0.w, b1.x, b1.y, b1.z, b1.w};
#pragma unroll
            for (int i = 0; i < 4; ++i)
#pragma unroll
                for (int j = 0; j < 8; ++j) acc[i][j] += aa[i] * bb[j];
        }
    }
#pragma unroll
    for (int i = 0; i < 4; ++i) { const int r = row0 + ty * 4 + i; const int c = col0 + tx * 8;
        float o[8];
#pragma unroll
        for (int j = 0; j < 8; ++j) { float v = acc[i][j]; if (MODE == 1) { const float y = A[(size_t)r * lda + c + j]; v = y * sigmoidf_(v + aux[c + j]); } o[j] = v; }
        *(f32x4*)(C + (size_t)r * ldc + c) = (f32x4){o[0], o[1], o[2], o[3]}; *(f32x4*)(C + (size_t)r * ldc + c + 4) = (f32x4){o[4], o[5], o[6], o[7]}; }
    __syncthreads();
}
__device__ __forceinline__ void p3_gemms(Frame& F, int l) {
    ArgsP AP = (ArgsP)__builtin_amdgcn_kernarg_segment_ptr(); asm volatile("" : "+s"(AP));
    constexpr int NQ = 64 * 12, NK = 64 * 8, NL = 8 * 64;
    constexpr int TOT = NQ + 3 * NK + 2 * NL;
    for (int it = F.vcu; it < TOT; it += F.G) {
        int r = it;
        if (r < NQ) { ngemm_tile<0>(F, WSF(WS_CQN), QR, IN_F(17) + (size_t)l * QR * 1536, 1536, QR, WSF(WS_Q), 1536, (r / 12) * 128, (r % 12) * 128, nullptr); continue; } r -= NQ;
        if (r < NK) { ngemm_tile<0>(F, WSF(WS_CKVN), KVR, IN_F(18) + (size_t)l * KVR * BR, BR, KVR, WSF(WS_KN), BR, (r / 8) * 128, (r % 8) * 128, nullptr); continue; } r -= NK;
        if (r < NK) { ngemm_tile<0>(F, WSF(WS_CKVN), KVR, IN_F(19) + (size_t)l * KVR * BR, BR, KVR, WSF(WS_V), BR, (r / 8) * 128, (r % 8) * 128, nullptr); continue; } r -= NK;
        if (r < NK) { ngemm_tile<1>(F, WSF(WS_YS5), BR, IN_F(12) + (size_t)l * BR * BR, BR, BR, WSF(WS_S5O), BR, (r / 8) * 128, (r % 8) * 128, IN_F(13) + l * BR); continue; } r -= NK;
        if (r < NL) { const int j = r / 64; ngemm_tile<0>(F, WSF(WS_XC) + j * 128, BR, IN_F(26) + (size_t)(l * 8 + j) * 128 * 128, 128, 128, WSF(WS_RPRE) + j * 128, BR, (r % 64) * 128, 0, nullptr); continue; } r -= NL;
        { const int j = r / 64; ngemm_tile<0>(F, WSF(WS_XC) + j * 128, BR, IN_F(28) + (size_t)(l * 8 + j) * 128 * 128, 128, 128, WSF(WS_IPRE) + j * 128, BR, (r % 64) * 128, 0, nullptr); }
    }
}
__device__ __forceinline__ void p3_gla(Frame& F, int l) {
    float* qs = (float*)(F.ldsg + RING_OFF + 32768);
    float* ks = qs + 1024; float* as = ks + 1024;
    PHASE_IDS();
    const float* z = WSF(WS_Z); const int j = tid >> 1, hf = tid & 1;
    for (int it = F.vcu; it < NB * GH; it += F.G) {
        const int b = it >> 2, h = it & 3;
        float S[64];
#pragma unroll
        for (int d = 0; d < 64; ++d) S[d] = 0.f;
        for (int t0 = 0; t0 < SEQ; t0 += 8) {
            const size_t m0 = (size_t)b * SEQ + t0;
            __syncthreads();
            for (int e = tid; e < 1024; e += 512) { const int s = e >> 7, d = e & 127;
                qs[e] = z[(m0 + s) * ZC + Z_GQ + h * 128 + d]; ks[e] = z[(m0 + s) * ZC + Z_GK + h * 128 + d]; as[e] = __expf(WSF(WS_LOGA)[(m0 + s) * 512 + h * 128 + d]); }
            float vv[8];
#pragma unroll
            for (int s = 0; s < 8; ++s) vv[s] = z[(m0 + s) * ZC + Z_GV + h * 256 + j];
            __syncthreads();
#pragma unroll
            for (int s = 0; s < 8; ++s) { float o = 0.f;
#pragma unroll
                for (int d = 0; d < 64; ++d) { const int dd = s * 128 + hf * 64 + d; S[d] = as[dd] * S[d] + ks[dd] * vv[s]; o += qs[dd] * S[d]; }
                o += __shfl_xor(o, 1);
                if (hf == 0) WSF(WS_OGLA)[(m0 + s) * BR + h * 256 + j] = o * 0.08838834764831845f; }
        }
    }
    __syncthreads();
}
__device__ __forceinline__ void p4_lru(Frame& F, int l) {
    PHASE_IDS();
    const int gw = F.vcu * NWAVES + wave, NGW = F.G * NWAVES;
    for (int it = gw; it < NB * 16; it += NGW) {
        const int b = it >> 4, c = (it & 15) * 64 + lane;
        const float ba = IN_F(27)[l * BR + c], bx = IN_F(29)[l * BR + c], sp = softplusf_(-IN_F(30)[l * BR + c]);
        float h = 0.f;
        for (int t = 0; t < SEQ; t += 4) {
            asm volatile("" ::: "memory");
            float rp[4], ip[4], xc[4];
#pragma unroll
            for (int s = 0; s < 4; ++s) { const size_t o = ((size_t)b * SEQ + t + s) * BR + c; rp[s] = WSF(WS_RPRE)[o]; ip[s] = WSF(WS_IPRE)[o]; xc[s] = WSF(WS_XC)[o]; }
#pragma unroll
            for (int s = 0; s < 4; ++s) { const float r = sigmoidf_(rp[s] + ba), ig = sigmoidf_(ip[s] + bx); const float la = -8.f * r * sp;
                const float a = expf(la), gt = sqrtf(-expm1f(2.f * la)) * (ig * xc[s]); h = a * h + gt;
                WSF(WS_HLRU)[((size_t)b * SEQ + t + s) * BR + c] = h; }
        }
    }
}
__device__ __forceinline__ void p4_attn(Frame& F) {
    PHASE_IDS();
    const int gw = F.vcu * NWAVES + wave, NGW = F.G * NWAVES;
    float* pw = (float*)(F.ldsg + RING_OFF + wave * 10240);
    float* qw = pw + 2048;
    const float scale = 0.07216878364870322f;
    for (int it = gw; it < T * NH; it += NGW) {
        asm volatile("" ::: "memory");
        const int h = it & 7, m = it >> 3, b = m >> 11, qi = m & (SEQ - 1);
        { const float* qr = WSF(WS_Q) + (size_t)m * 1536 + h * DQK; qw[lane] = qr[lane]; qw[lane + 64] = qr[lane + 64];
          if (lane < 32) { const float x1 = qr[128 + lane], x2 = qr[160 + lane]; const float c = WSF(WS_ROPE)[m * 64 + lane], s = WSF(WS_ROPE)[m * 64 + 32 + lane];
              qw[128 + lane] = x1 * c - x2 * s; qw[160 + lane] = x2 * c + x1 * s; } }
        LDS_WAIT(); asm volatile("" ::: "memory");
        float mx = -1e30f;
        for (int j = lane; j <= qi; j += 64) {
            const size_t mk = (size_t)b * SEQ + j; const f32x4* kn = (const f32x4*)(WSF(WS_KN) + mk * BR + h * 128); const f32x4* kr = (const f32x4*)(WSF(WS_KR) + mk * 64);
            float s = 0.f;
#pragma unroll 8
            for (int d = 0; d < 32; ++d) { const f32x4 kk = kn[d]; const f32x4 qq = *(const f32x4*)(qw + 4 * d); s += (kk.x * qq.x + kk.y * qq.y) + (kk.z * qq.z + kk.w * qq.w); }
#pragma unroll 8
            for (int d = 0; d < 16; ++d) { const f32x4 kk = kr[d]; const f32x4 qq = *(const f32x4*)(qw + 128 + 4 * d); s += (kk.x * qq.x + kk.y * qq.y) + (kk.z * qq.z + kk.w * qq.w); }
            s *= scale; pw[j] = s; mx = fmaxf(mx, s);
        }
        mx = wave_max(mx);
        float sum = 0.f;
        for (int j = lane; j <= qi; j += 64) { const float p = __expf(pw[j] - mx); pw[j] = p; sum += p; }
        sum = wave_sum(sum);
        LDS_WAIT(); asm volatile("" ::: "memory");
        float o0 = 0.f, o1 = 0.f; const float* vb = WSF(WS_V) + (size_t)b * SEQ * BR + h * 128;
        for (int j = 0; j <= qi; ++j) { const float p = pw[j]; o0 += p * vb[(size_t)j * BR + lane]; o1 += p * vb[(size_t)j * BR + 64 + lane]; }
        const float inv = 1.f / sum;
        WSF(WS_OMLA)[(size_t)m * BR + h * 128 + lane] = o0 * inv; WSF(WS_OMLA)[(size_t)m * BR + h * 128 + 64 + lane] = o1 * inv;
        LDS_WAIT(); asm volatile("" ::: "memory");
    }
}
__device__ __forceinline__ void p5_norms(Frame& F, int l) {
    PHASE_IDS();
    const int gw = F.vcu * NWAVES + wave, NGW = F.G * NWAVES;
    const float* z = WSF(WS_Z); bf16* yb = (bf16*)(AP->ws + WS_HB);
    for (int m = gw; m < T; m += NGW) {
#pragma unroll
        for (int br = 0; br < 4; ++br) {
            asm volatile("" ::: "memory");
            const float* src = br == 0 ? WSF(WS_S5O) : br == 1 ? WSF(WS_OMLA) : br == 2 ? WSF(WS_OGLA) : WSF(WS_HLRU);
            const float* gg = (br == 0 ? IN_F(14) : br == 1 ? IN_F(20) : br == 2 ? IN_F(23) : IN_F(31)) + l * BR;
            const int zg = br == 0 ? Z_S5G : br == 1 ? Z_MG : br == 2 ? Z_GG : Z_LG;
            f32x4 v[4]; float ss[4]; float tot = 0.f;
#pragma unroll
            for (int j = 0; j < 4; ++j) { v[j] = *(const f32x4*)(src + (size_t)m * BR + 256 * j + 4 * lane); ss[j] = wave_sum((v[j].x * v[j].x + v[j].y * v[j].y) + (v[j].z * v[j].z + v[j].w * v[j].w)); tot += ss[j]; }
#pragma unroll
            for (int j = 0; j < 4; ++j) { const float rs = br == 2 ? 1.0f / sqrtf(ss[j] * (1.f / 256.f) + EPS) : 1.0f / sqrtf(tot * (1.f / 1024.f) + EPS);
                const f32x4 g4 = *(const f32x4*)(gg + 256 * j + 4 * lane); const f32x4 gt = *(const f32x4*)(z + (size_t)m * ZC + zg + 256 * j + 4 * lane);
                const float o0 = v[j].x * rs * g4.x * siluf_(gt.x), o1 = v[j].y * rs * g4.y * siluf_(gt.y), o2 = v[j].z * rs * g4.z * siluf_(gt.z), o3 = v[j].w * rs * g4.w * siluf_(gt.w);
                *(unsigned long long*)(yb + (size_t)m * DM + br * BR + 256 * j + 4 * lane) = (unsigned long long)pk2(o0, o1) | ((unsigned long long)pk2(o2, o3) << 32); }
        }
    }
}
__device__ __forceinline__ void p7_norm(Frame& F, int l) {
    PHASE_IDS();
    const int gw = F.vcu * NWAVES + wave, NGW = F.G * NWAVES;
    for (int m = gw; m < T; m += NGW) {
        asm volatile("" ::: "memory");
        if (l + 1 < DEPTH) rms_row<true>(WSF(WS_XB) + (size_t)m * DM, IN_F(2) + (l + 1) * DM, (bf16*)(AP->ws + WS_HB) + (size_t)m * DM, lane);
        else rms_row<false>(WSF(WS_XB) + (size_t)m * DM, IN_F(33), AP->out + (size_t)m * DM, lane);
    }
}

constexpr int PH_PER_LAYER = 7, N_PHASES = 1 + DEPTH * PH_PER_LAYER;
__global__ void __launch_bounds__(NWAVES * 64, 2) hybrid_fwd(Args args) {
    extern __shared__ __attribute__((aligned(16))) unsigned char lds[];
    Frame F;
    F.lds = (LAS unsigned char*)lds; F.ldsg = lds;
    F.G = gridDim.x; { const int bx = blockIdx.x; F.vcu = (F.G % 8 == 0) ? (bx % 8) * (F.G / 8) + bx / 8 : bx; }
    volatile LAS unsigned* MISC = (volatile LAS unsigned*)(F.lds + MISC_OFF);
    for (int u = threadIdx.x; u < (LDS_BYTES - LDSCTL_OFF) / 4; u += NWAVES * 64) ((LAS unsigned*)(F.lds + LDSCTL_OFF))[u] = 0u;
    __syncthreads();
    ArgsP AP0 = (ArgsP)__builtin_amdgcn_kernarg_segment_ptr();
    const bool multi = (args.ph_hi - args.ph_lo) > 1;
    XcdBarrier bar; bar.bar = (unsigned*)(AP0->ws + WS_CTL) + 4096; bar.x = 0; bar.st = nullptr;
    if (multi) bar = xcd_barrier_post((unsigned*)(AP0->ws + WS_CTL) + 4096, MISC + 8);
    const int lo = args.ph_lo, hi = args.ph_hi;
#define IN(k) (lo <= (k) && (k) < hi)
#define SEAM(k) do { if (IN(k) && IN((k) + 1)) xcd_barrier(bar); } while (0)
    if (IN(0)) {
#ifndef SK_P0
 p0_prologue(F);
#endif
 } SEAM(0);
    for (int ll = 0; ll < DEPTH; ++ll) {
        int l = ll; asm volatile("" : "+s"(l) :: "memory");
        const int pb = 1 + l * PH_PER_LAYER;
        if (IN(pb + 0)) {
            ArgsP AP = (ArgsP)__builtin_amdgcn_kernarg_segment_ptr(); asm volatile("" : "+s"(AP));
            pg8::Gemm g{(const bf16*)(AP->ws + WS_HB), (const bf16*)(AP->ws + WS_WTIN) + (size_t)l * ZC * DM, T, ZC, DM}; pg8::StaticOrder S; S.init(T, ZC, F.G, (int)blockIdx.x);
            pg8::EpiF32 E{WSF(WS_Z), ZC};
            pg8::gemm_phase<pg8::EpiF32, pg8::StaticOrder, true, true>(F.lds + RING_OFF, g, S, E);
        } SEAM(pb + 0);
        if (IN(pb + 1)) {
#ifndef SK_P2R
 p2_rows(F, l);
#endif
#ifndef SK_P2S
 p2_s5(F, l);
#endif
 } SEAM(pb + 1);
        if (IN(pb + 2)) {
#ifndef SK_P3G
 p3_gla(F, l);
#endif
#ifndef SK_P3M
 p3_gemms(F, l);
#endif
 } SEAM(pb + 2);
        if (IN(pb + 3)) {
#ifndef SK_P4L
 p4_lru(F, l);
#endif
#ifndef SK_P4A
 p4_attn(F);
#endif
 } SEAM(pb + 3);
        if (IN(pb + 4)) {
#ifndef SK_P5
 p5_norms(F, l);
#endif
 } SEAM(pb + 4);
        if (IN(pb + 5)) {
            ArgsP AP = (ArgsP)__builtin_amdgcn_kernarg_segment_ptr(); asm volatile("" : "+s"(AP));
            pg8::Gemm g{(const bf16*)(AP->ws + WS_HB), (const bf16*)(AP->ws + WS_WTOUT) + (size_t)l * DM * DM, T, DM, DM}; pg8::StaticOrder S; S.init(T, DM, F.G, (int)blockIdx.x);
            pg8::EpiRes E{l == 0 ? IN_F(0) : WSF(WS_XB), WSF(WS_XB), DM};
            pg8::gemm_phase<pg8::EpiRes, pg8::StaticOrder, true, true>(F.lds + RING_OFF, g, S, E);
        } SEAM(pb + 5);
        if (IN(pb + 6)) {
#ifndef SK_P7
 p7_norm(F, l);
#endif
 } SEAM(pb + 6);
    }
#undef IN
#undef SEAM
}

#ifndef N_LAUNCHES
#define N_LAUNCHES 1
#endif
extern "C" void kernel_launch(void* const* d_in, const int* in_sizes, int n_in, void* d_out, int out_size, void* d_ws, size_t ws_size, hipStream_t stream) {
    static int grid = 0;
    if (grid == 0) {
        if (n_in != 34 || out_size != T * DM || ws_size < WS_END) { fprintf(stderr, "kernel_launch: unexpected problem: n_in %d out %d ws %zu (need %zu)\n", n_in, out_size, ws_size, (size_t)WS_END); grid = -1; return; }
        int dev = 0, cus = 0;
        if (hipGetDevice(&dev) != hipSuccess || hipDeviceGetAttribute(&cus, hipDeviceAttributeMultiprocessorCount, dev) != hipSuccess) { grid = -1; return; }
        if (hipFuncSetAttribute((const void*)hybrid_fwd, hipFuncAttributeMaxDynamicSharedMemorySize, LDS_BYTES) != hipSuccess) { fprintf(stderr, "kernel_launch: hipFuncSetAttribute failed\n"); grid = -1; return; }
        int per_cu = 0;
        if (hipOccupancyMaxActiveBlocksPerMultiprocessor(&per_cu, (const void*)hybrid_fwd, NWAVES * 64, LDS_BYTES) != hipSuccess || per_cu < 1) fprintf(stderr, "kernel_launch: occupancy query says %d blocks/CU\n", per_cu);
        (void)hipGetLastError();
        grid = cus;
    }
    if (grid < 0) return;
    (void)hipMemsetAsync((char*)d_ws + WS_CTL, 0, CTL_ZERO_BYTES, stream);
    Args a{};
    for (int i = 0; i < 34; ++i) a.in[i] = d_in[i];
    a.out = (float*)d_out; a.ws = (unsigned char*)d_ws;
    if (N_LAUNCHES == 1) { a.ph_lo = 0; a.ph_hi = N_PHASES; hipLaunchKernelGGL(hybrid_fwd, dim3(grid), dim3(NWAVES * 64), LDS_BYTES, stream, a); }
    else for (int p = 0; p < N_PHASES; ++p) { a.ph_lo = p; a.ph_hi = p + 1; hipLaunchKernelGGL(hybrid_fwd, dim3(grid), dim3(NWAVES * 64), LDS_BYTES, stream, a); }
}
```

```cpp
#include <hip/hip_runtime.h>
#include <cstdio>
#include <cstdint>

namespace pg8 {
#define PG8_LAS __attribute__((address_space(3)))
typedef unsigned short bf16_t;
typedef short bf16x8 __attribute__((ext_vector_type(8)));
typedef float f32x4 __attribute__((ext_vector_type(4)));
typedef unsigned u32x4 __attribute__((ext_vector_type(4)));
constexpr int BM = 256, BK = 64, HALF = 128, HTB = HALF * BK * 2, STAGE_BYTES = 8 * HTB, NXCD = 8, WGM = 8;

__host__ __device__ __forceinline__ int lds_byte(int r, int c) { const int st = (r >> 4) * 2 + (c >> 5), rr = r & 15, cc = c & 31, ob = rr * 64 + cc * 2; return st * 1024 + (ob ^ (((ob >> 9) & 1) << 5)); }
__host__ __device__ __forceinline__ void stage_rc(int b, int& R, int& C) { const int st = b / 1024, sb = b % 1024, swz = sb ^ (((sb >> 9) & 1) << 5); R = (st >> 1) * 16 + swz / 64; C = (st & 1) * 32 + (swz % 64) / 2; }
__host__ __device__ __forceinline__ int perm32(int rho) { const int n = rho >> 4, i = rho & 15; return 8 * (i >> 2) + 4 * n + (i & 3); }

struct Unit { int pm, pn; };
struct Gemm { const bf16_t* A; const bf16_t* Bt; int M, N, K; int lda, ldb; int a_colstep; };

struct StaticOrder {
    int nM, nN, nwg, G, c;
    __host__ __device__ void init(int M, int N, int G_, int c_) { nM = M / BM; nN = N / BM; nwg = nM * nN; G = G_; c = c_; }
    __host__ __device__ bool next(int i, Unit& u) const {
        const long L = (long)i * G + c; if (L >= nwg) return false;
        int wgid = (int)L; { const int q = nwg / NXCD, r = nwg % NXCD, xcd = wgid % NXCD, off = wgid / NXCD; wgid = (xcd < r ? xcd * (q + 1) : r * (q + 1) + (xcd - r) * q) + off; }
        const int nig = WGM * nN, gid = wgid / nig, fm = gid * WGM, gsz = (nM - fm) < WGM ? (nM - fm) : WGM;
        u.pm = fm + ((wgid % nig) % gsz); u.pn = (wgid % nig) / gsz; return true;
    }
    __device__ __forceinline__ void a_ready(const Unit&) const {}
    __device__ __forceinline__ void done(const Unit&) const {}
};

struct EpiF32 {
    static constexpr bool PERM = false, AFTER_DRAIN = false;
    float* C; int ldc;
    __device__ __forceinline__ void operator()(const f32x4 (&acc)[2][2][4][2], const Unit& u, int wr, int wc, int fr, int fq) const {
        const int row0 = u.pm * BM + wr * 64 + fr, col0 = u.pn * BM + wc * 32 + 4 * fq;
#pragma unroll
        for (int ai = 0; ai < 2; ++ai)
#pragma unroll
            for (int m = 0; m < 4; ++m) { float* rowp = C + (size_t)(row0 + ai * HALF + m * 16) * ldc + col0;
#pragma unroll
                for (int bj = 0; bj < 2; ++bj)
#pragma unroll
                    for (int n = 0; n < 2; ++n) *(f32x4*)(rowp + bj * HALF + n * 16) = acc[ai][bj][m][n]; }
    }
};
struct EpiRes {
    static constexpr bool PERM = false, AFTER_DRAIN = false;
    const float* base; float* O; int ldc;
    __device__ __forceinline__ void operator()(const f32x4 (&acc)[2][2][4][2], const Unit& u, int wr, int wc, int fr, int fq) const {
        const int row0 = u.pm * BM + wr * 64 + fr, col0 = u.pn * BM + wc * 32 + 4 * fq;
#pragma unroll
        for (int ai = 0; ai < 2; ++ai)
#pragma unroll
            for (int m = 0; m < 4; ++m) { const size_t off = (size_t)(row0 + ai * HALF + m * 16) * ldc + col0;
#pragma unroll
                for (int bj = 0; bj < 2; ++bj)
#pragma unroll
                    for (int n = 0; n < 2; ++n) { const f32x4 b = *(const f32x4*)(base + off + bj * HALF + n * 16); *(f32x4*)(O + off + bj * HALF + n * 16) = b + acc[ai][bj][m][n]; } }
    }
};

struct EpiF32Split {
    static constexpr bool PERM = false, AFTER_DRAIN = false;
    float* C0; float* C1; int ldc; int split;
    __device__ __forceinline__ void operator()(const f32x4 (&acc)[2][2][4][2], const Unit& u, int wr, int wc, int fr, int fq) const {
        float* C = u.pn < split ? C0 : C1; const int pn = u.pn < split ? u.pn : u.pn - split;
        const int row0 = u.pm * BM + wr * 64 + fr, col0 = pn * BM + wc * 32 + 4 * fq;
#pragma unroll
        for (int ai = 0; ai < 2; ++ai)
#pragma unroll
            for (int m = 0; m < 4; ++m) { float* rowp = C + (size_t)(row0 + ai * HALF + m * 16) * ldc + col0;
#pragma unroll
                for (int bj = 0; bj < 2; ++bj)
#pragma unroll
                    for (int n = 0; n < 2; ++n) *(f32x4*)(rowp + bj * HALF + n * 16) = acc[ai][bj][m][n]; }
    }
};__device__ __forceinline__ unsigned cvt_pk_bf16(float lo, float hi) { unsigned r; asm volatile("v_cvt_pk_bf16_f32 %0, %1, %2" : "=v"(r) : "v"(lo), "v"(hi)); return r; }
struct EpiBf16Split {
    static constexpr bool PERM = false, AFTER_DRAIN = false;
    bf16_t* O0; bf16_t* O1; int ldc; int split;
    __device__ __forceinline__ void operator()(const f32x4 (&acc)[2][2][4][2], const Unit& u, int wr, int wc, int fr, int fq) const {
        bf16_t* O = u.pn < split ? O0 : O1; const int pn = u.pn < split ? u.pn : u.pn - split;
        const int row0 = u.pm * BM + wr * 64 + fr, col0 = pn * BM + wc * 32 + 4 * fq;
#pragma unroll
        for (int ai = 0; ai < 2; ++ai)
#pragma unroll
            for (int m = 0; m < 4; ++m) { bf16_t* rowp = O + (size_t)(row0 + ai * HALF + m * 16) * ldc + col0;
#pragma unroll
                for (int bj = 0; bj < 2; ++bj)
#pragma unroll
                    for (int n = 0; n < 2; ++n) { const f32x4 v = acc[ai][bj][m][n];
                        *(unsigned long long*)(rowp + bj * HALF + n * 16) = (unsigned long long)cvt_pk_bf16(v[0], v[1]) | ((unsigned long long)cvt_pk_bf16(v[2], v[3]) << 32); } }
    }
};

__device__ __forceinline__ float sigm(float x) { return 1.0f / (1.0f + __expf(-x)); }
struct EpiGlu {
    static constexpr bool PERM = false, AFTER_DRAIN = false;
    const float* Y; const float* bias; float* O; int ldc;
    __device__ __forceinline__ void operator()(const f32x4 (&acc)[2][2][4][2], const Unit& u, int wr, int wc, int fr, int fq) const {
        const int row0 = u.pm * BM + wr * 64 + fr, col0 = u.pn * BM + wc * 32 + 4 * fq;
        f32x4 bv[2][2];
#pragma unroll
        for (int bj = 0; bj < 2; ++bj)
#pragma unroll
            for (int n = 0; n < 2; ++n) bv[bj][n] = *(const f32x4*)(bias + col0 + bj * HALF + n * 16);
#pragma unroll
        for (int ai = 0; ai < 2; ++ai)
#pragma unroll
            for (int m = 0; m < 4; ++m) { const size_t off = (size_t)(row0 + ai * HALF + m * 16) * ldc + col0;
#pragma unroll
                for (int bj = 0; bj < 2; ++bj)
#pragma unroll
                    for (int n = 0; n < 2; ++n) { const f32x4 y = *(const f32x4*)(Y + off + bj * HALF + n * 16); const f32x4 v = acc[ai][bj][m][n] + bv[bj][n];
                        f32x4 o; o.x = y.x * sigm(v.x); o.y = y.y * sigm(v.y); o.z = y.z * sigm(v.z); o.w = y.w * sigm(v.w);
                        *(f32x4*)(O + off + bj * HALF + n * 16) = o; } }
    }
};
struct EpiLru {
    static constexpr bool PERM = false, AFTER_DRAIN = false;
    const float* XC; const float* ba; const float* bx; const float* spl; float* Aout; float* Gout;
    __device__ __forceinline__ void operator()(const f32x4 (&acc)[2][2][4][2], const Unit& u, int wr, int wc, int fr, int fq) const {
        const int row0 = u.pm * BM + wr * 64 + fr, ch0 = u.pn * 128 + wc * 32 + 4 * fq;
#pragma unroll
        for (int n = 0; n < 2; ++n) { const f32x4 va = *(const f32x4*)(ba + ch0 + n * 16), vx = *(const f32x4*)(bx + ch0 + n * 16), sp = *(const f32x4*)(spl + ch0 + n * 16);
#pragma unroll
        for (int ai = 0; ai < 2; ++ai)
#pragma unroll
            for (int m = 0; m < 4; ++m) { const size_t off = (size_t)(row0 + ai * HALF + m * 16) * 1024 + ch0;
                const f32x4 xc = *(const f32x4*)(XC + off + n * 16); f32x4 oa, og;
#pragma unroll
                for (int e = 0; e < 4; ++e) { const float r = sigm(acc[ai][0][m][n][e] + va[e]), ig = sigm(acc[ai][1][m][n][e] + vx[e]);
                    const float la = -8.f * r * sp[e]; const float a = __expf(la); const float x = 2.f * la;
                    const float ser = -x * (1.f + x * (0.5f + x * (0.16666667f + x * (0.041666668f + x * (0.0083333338f + x * 0.0013888889f)))));
                    const float em = x > -0.5f ? ser : 1.f - a * a;
                    oa[e] = a; og[e] = sqrtf(em) * (ig * xc[e]); }
                *(f32x4*)(Aout + off + n * 16) = oa; *(f32x4*)(Gout + off + n * 16) = og; } }
    }
};

template <class Epi, class Sched, bool ALIGN_EPI = false, bool SP2 = false>
__device__ __forceinline__ void gemm_phase(PG8_LAS unsigned char* lds, const Gemm g, const Sched& S, const Epi& E) {
    int tid = threadIdx.x; asm volatile("" : "+v"(tid));
    const int wid = __builtin_amdgcn_readfirstlane(tid >> 6), lane = tid & 63, wr = wid >> 2, wc = wid & 3, fr = lane & 15, fq = lane >> 4;
    int K = g.K; asm volatile("" : "+s"(K));
    const int nt = K / BK;
    unsigned voffA[2], voffB[2];
#pragma unroll
    for (int i = 0; i < 2; ++i) { int R, C; stage_rc(tid * 16 + i * 8192, R, C); const int Rb = Epi::PERM ? ((R & ~31) + perm32(R & 31)) : R;
        voffA[i] = (unsigned)(R * g.lda + C) * 2u; voffB[i] = (unsigned)(Rb * g.ldb + C) * 2u; }
    const size_t kstep = (size_t)(BK * 2);
    const size_t hA = (size_t)HALF * g.lda * 2, hB = (size_t)HALF * g.ldb * 2;
    const size_t tA = 2 * hA, tB = 2 * hB; const size_t acs = (size_t)g.a_colstep;
    const unsigned ldsw = (unsigned)wid * 1024u;
    const int aoff = lds_byte(wr * 64 + fr, fq * 8), boff = lds_byte(wc * 32 + fr, fq * 8);
#define PG8_SA(b, h) (((b) * 2 + (h)) * HTB)
#define PG8_SB(b, h) ((4 + (b) * 2 + (h)) * HTB)
#define PG8_STAGE(bufoff, gbase, voff) do { _Pragma("unroll") for (int _i = 0; _i < 2; ++_i) \
        __builtin_amdgcn_global_load_lds((const unsigned*)((const char*)(gbase) + (voff)[_i]), (PG8_LAS unsigned*)(lds + (bufoff) + ldsw + _i * 8192), 16, 0, 0); } while (0)
#define PG8_LDA(dst, b, h) do { _Pragma("unroll") for (int m = 0; m < 4; ++m) _Pragma("unroll") for (int k = 0; k < 2; ++k) dst[m][k] = *(const PG8_LAS bf16x8*)(lds + PG8_SA(b, h) + aoff + m * 2048 + k * 1024); } while (0)
#define PG8_LDB(dst, b, h) do { _Pragma("unroll") for (int n = 0; n < 2; ++n) _Pragma("unroll") for (int k = 0; k < 2; ++k) dst[n][k] = *(const PG8_LAS bf16x8*)(lds + PG8_SB(b, h) + boff + n * 2048 + k * 1024); } while (0)
#define PG8_MMA(ai, bj, At, Bt) do { __builtin_amdgcn_s_setprio(1); _Pragma("unroll") for (int m = 0; m < 4; ++m) _Pragma("unroll") for (int n = 0; n < 2; ++n) _Pragma("unroll") for (int k = 0; k < 2; ++k) \
        acc[ai][bj][m][n] = __builtin_amdgcn_mfma_f32_16x16x32_bf16(Bt[n][k], At[m][k], acc[ai][bj][m][n], 0, 0, 0); __builtin_amdgcn_s_setprio(0); } while (0)
#define PG8_WAIT_V(n) asm volatile("s_waitcnt vmcnt(" #n ")" ::: "memory")
#define PG8_WAIT_L(n) asm volatile("s_waitcnt lgkmcnt(" #n ")" ::: "memory")
#define PG8_BAR __builtin_amdgcn_s_barrier()
#define PG8_SCHED __builtin_amdgcn_sched_barrier(0)
    Unit cur, nxt; int ui = 0;
    if (!S.next(0, cur)) return;
    f32x4 acc[2][2][4][2];
#pragma unroll
    for (int a = 0; a < 2; ++a)
#pragma unroll
        for (int b = 0; b < 2; ++b)
#pragma unroll
            for (int m = 0; m < 4; ++m)
#pragma unroll
                for (int n = 0; n < 2; ++n) acc[a][b][m][n] = (f32x4){0.f, 0.f, 0.f, 0.f};
    bf16x8 At[4][2], B0[2][2], B1[2][2];
    const char* cA = (const char*)g.A + (size_t)cur.pm * tA + (size_t)cur.pn * acs; const char* cB = (const char*)g.Bt + (size_t)cur.pn * tB;
    S.a_ready(cur);
    if constexpr (SP2) {
        PG8_STAGE(PG8_SB(0, 0), cB, voffB); PG8_STAGE(PG8_SB(0, 1), cB + hB, voffB); PG8_STAGE(PG8_SA(0, 0), cA, voffA); PG8_STAGE(PG8_SA(0, 1), cA + hA, voffA);
        if (wr == 1) PG8_BAR;
        PG8_WAIT_V(2); PG8_BAR;
        PG8_STAGE(PG8_SB(1, 0), cB + kstep, voffB); PG8_STAGE(PG8_SA(1, 0), cA + kstep, voffA); PG8_STAGE(PG8_SB(1, 1), cB + hB + kstep, voffB);
        PG8_WAIT_V(6); PG8_BAR;
    } else {
        PG8_STAGE(PG8_SB(0, 0), cB, voffB); PG8_STAGE(PG8_SA(0, 0), cA, voffA); PG8_STAGE(PG8_SB(0, 1), cB + hB, voffB); PG8_STAGE(PG8_SA(0, 1), cA + hA, voffA);
        if (wr == 1) PG8_BAR;
        PG8_WAIT_V(4); PG8_BAR;
        PG8_STAGE(PG8_SB(1, 0), cB + kstep, voffB); PG8_STAGE(PG8_SA(1, 0), cA + kstep, voffA); PG8_STAGE(PG8_SB(1, 1), cB + hB + kstep, voffB);
        PG8_WAIT_V(6); PG8_BAR;
    }
    for (;;) {
        const bool has_next = S.next(ui + 1, nxt);
        const char* nA = has_next ? (const char*)g.A + (size_t)nxt.pm * tA + (size_t)nxt.pn * acs : cA; const char* nB = has_next ? (const char*)g.Bt + (size_t)nxt.pn * tB : cB;
        for (int t = 0; t < nt; t += 2) {
            const bool last = (t == nt - 2);
            const char* a1 = cA + (size_t)(t + 1) * kstep;
            const char* a2 = last ? nA : cA + (size_t)(t + 2) * kstep; const char* b2 = last ? nB : cB + (size_t)(t + 2) * kstep;
            const char* a3 = a2 + kstep; const char* b3 = b2 + kstep;
            if (last && has_next) S.a_ready(nxt);
            if constexpr (SP2) {
            PG8_LDB(B0, 0, 0); PG8_LDB(B1, 0, 1); PG8_SCHED; PG8_LDA(At, 0, 0); PG8_STAGE(PG8_SA(1, 1), a1 + hA, voffA);
            PG8_WAIT_V(8); PG8_WAIT_L(0); PG8_BAR; PG8_MMA(0, 0, At, B0); PG8_MMA(0, 1, At, B1); PG8_BAR; PG8_SCHED;
            PG8_LDA(At, 0, 1); PG8_STAGE(PG8_SB(0, 0), b2, voffB); PG8_STAGE(PG8_SB(0, 1), b2 + hB, voffB); PG8_STAGE(PG8_SA(0, 0), a2, voffA);
            PG8_WAIT_V(8); PG8_WAIT_L(0); PG8_BAR; PG8_MMA(1, 0, At, B0); PG8_MMA(1, 1, At, B1); PG8_BAR; PG8_SCHED;
            PG8_LDB(B0, 1, 0); PG8_LDB(B1, 1, 1); PG8_SCHED; PG8_LDA(At, 1, 0); PG8_STAGE(PG8_SA(0, 1), a2 + hA, voffA);
            PG8_WAIT_V(8); PG8_WAIT_L(0); PG8_BAR; PG8_MMA(0, 0, At, B0); PG8_MMA(0, 1, At, B1); PG8_BAR; PG8_SCHED;
            PG8_LDA(At, 1, 1); PG8_STAGE(PG8_SB(1, 0), b3, voffB); PG8_STAGE(PG8_SB(1, 1), b3 + hB, voffB); PG8_STAGE(PG8_SA(1, 0), a3, voffA);
            PG8_WAIT_V(8); PG8_WAIT_L(0); PG8_BAR; PG8_MMA(1, 0, At, B0); PG8_MMA(1, 1, At, B1); PG8_BAR; PG8_SCHED;
            } else {
            PG8_LDB(B0, 0, 0); PG8_SCHED; PG8_LDA(At, 0, 0); PG8_STAGE(PG8_SA(1, 1), a1 + hA, voffA);
            PG8_WAIT_L(8); PG8_BAR; PG8_WAIT_L(0); PG8_MMA(0, 0, At, B0); PG8_BAR; PG8_SCHED;
            PG8_LDB(B1, 0, 1); PG8_STAGE(PG8_SB(0, 0), b2, voffB);
            PG8_BAR; PG8_WAIT_L(0); PG8_MMA(0, 1, At, B1); PG8_BAR;
            PG8_LDA(At, 0, 1); PG8_STAGE(PG8_SA(0, 0), a2, voffA);
            PG8_BAR; PG8_WAIT_L(0); PG8_MMA(1, 0, At, B0); PG8_BAR; PG8_SCHED;
            PG8_STAGE(PG8_SB(0, 1), b2 + hB, voffB);
            PG8_WAIT_V(6); PG8_BAR; PG8_MMA(1, 1, At, B1); PG8_BAR;
            PG8_LDB(B0, 1, 0); PG8_SCHED; PG8_LDA(At, 1, 0); PG8_STAGE(PG8_SA(0, 1), a2 + hA, voffA);
            PG8_WAIT_L(8); PG8_BAR; PG8_WAIT_L(0); PG8_MMA(0, 0, At, B0); PG8_BAR; PG8_SCHED;
            PG8_LDB(B1, 1, 1); PG8_STAGE(PG8_SB(1, 0), b3, voffB);
            PG8_BAR; PG8_WAIT_L(0); PG8_MMA(0, 1, At, B1); PG8_BAR;
            PG8_LDA(At, 1, 1); PG8_STAGE(PG8_SA(1, 0), a3, voffA);
            PG8_BAR; PG8_WAIT_L(0); PG8_MMA(1, 0, At, B0); PG8_BAR; PG8_SCHED;
            PG8_STAGE(PG8_SB(1, 1), b3 + hB, voffB);
            PG8_WAIT_V(6); PG8_BAR; PG8_MMA(1, 1, At, B1); PG8_BAR;
            }
        }
        if constexpr (ALIGN_EPI) { if (wr == 0) PG8_BAR; }
        PG8_SCHED; asm volatile("" ::: "memory");
        if constexpr (!Epi::AFTER_DRAIN) { int fr2 = fr, fq2 = fq; asm volatile("" : "+v"(fr2), "+v"(fq2));
            E(acc, cur, wr, wc, fr2, fq2); S.done(cur); }
        PG8_SCHED;
        if (!has_next) break;
#pragma unroll
        for (int a = 0; a < 2; ++a)
#pragma unroll
            for (int b = 0; b < 2; ++b)
#pragma unroll
                for (int m = 0; m < 4; ++m)
#pragma unroll
                    for (int n = 0; n < 2; ++n) acc[a][b][m][n] = (f32x4){0.f, 0.f, 0.f, 0.f};
        cur = nxt; cA = nA; cB = nB; ++ui;
        if constexpr (ALIGN_EPI) { if (wr == 1) PG8_BAR; }
    }
    PG8_WAIT_V(0);
    if constexpr (!ALIGN_EPI) { if (wr == 0) PG8_BAR; }
    PG8_BAR;
#undef PG8_SA
#undef PG8_SB
#undef PG8_STAGE
#undef PG8_LDA
#undef PG8_LDB
#undef PG8_MMA
#undef PG8_WAIT_V
#undef PG8_WAIT_L
#undef PG8_BAR
#undef PG8_SCHED
}
}

constexpr int NWAVES = 8;
constexpr int NB = 4, SEQ = 2048, T = NB * SEQ, DM = 4096, BR = 1024, DEPTH = 2;
constexpr int INC = 9552;
constexpr int ZC = 9728;
constexpr int Z_S5U = 0, Z_S5G = 1024, Z_CQ = 2048, Z_CKV = 2816, Z_MG = 3328, Z_GQ = 4352, Z_GK = 4864, Z_GV = 5376, Z_GG = 6400, Z_LU = 7424, Z_LG = 8448, Z_KR = 9472, Z_GLR = 9536;
constexpr int QR = 768, KVR = 512, NH = 8, DQK = 192, DNOPE = 128, DROPE = 64, DV = 128;
constexpr int S5G = 64, S5H = 16, S5P = 64;
constexpr int GH = 4, GDK = 128, GDV = 256;
constexpr float EPS = 1e-6f;

constexpr size_t al256(size_t x) { return (x + 255) & ~(size_t)255; }
constexpr size_t WS_CTL = 0, CTL_ZERO_BYTES = 1u << 20;
constexpr size_t WS_WTIN = CTL_ZERO_BYTES;
constexpr size_t WS_WTOUT = WS_WTIN + (size_t)2 * ZC * DM * 2;
constexpr size_t WS_HB = WS_WTOUT + (size_t)2 * DM * DM * 2;
constexpr size_t WS_Z = WS_HB + (size_t)T * DM * 2;
constexpr size_t WS_XB = WS_Z + (size_t)T * ZC * 4;
constexpr size_t WS_CQB = WS_XB + (size_t)T * DM * 4;
constexpr size_t WS_CKVB = WS_CQB + (size_t)T * QR * 2;
constexpr size_t WS_XCB = WS_CKVB + (size_t)T * KVR * 2;
constexpr size_t WS_YS5B = WS_XCB + (size_t)T * BR * 2;
constexpr size_t WS_WTUQ = WS_YS5B + (size_t)T * BR * 2;
constexpr size_t WS_WTUKV = WS_WTUQ + (size_t)2 * 1536 * QR * 2;
constexpr size_t WS_WTGLU = WS_WTUKV + (size_t)2 * 2048 * KVR * 2;
constexpr size_t WS_WTLRU = WS_WTGLU + (size_t)2 * BR * BR * 2;
constexpr size_t WS_KR = WS_WTLRU + (size_t)2 * 8 * 256 * 1024 * 2;
constexpr size_t WS_Q = WS_KR + (size_t)T * DROPE * 4;
constexpr size_t WS_KN = WS_Q + (size_t)T * NH * DQK * 4;
constexpr size_t WS_V = WS_KN + (size_t)T * BR * 4;
constexpr size_t WS_LOGA = WS_V + (size_t)T * BR * 4;
constexpr size_t WS_XC = WS_LOGA + (size_t)T * 512 * 4;
constexpr size_t WS_RPRE = WS_XC + (size_t)T * BR * 4;
constexpr size_t WS_IPRE = WS_RPRE + (size_t)T * BR * 4;
constexpr size_t WS_HLRU = WS_IPRE + (size_t)T * BR * 4;
constexpr size_t WS_YS5 = WS_HLRU + (size_t)T * BR * 4;
constexpr size_t WS_S5O = WS_YS5 + (size_t)T * BR * 4;
constexpr size_t WS_OGLA = WS_S5O + (size_t)T * BR * 4;
constexpr size_t WS_OMLA = WS_OGLA + (size_t)T * BR * 4;
constexpr size_t WS_ROPE = WS_OMLA + (size_t)T * BR * 4;
constexpr size_t WS_LAMB = WS_ROPE + (size_t)T * 64 * 4;
constexpr size_t WS_BBAR = WS_LAMB + (size_t)2 * 64 * 64 * 2 * 4;
constexpr size_t WS_SPL = WS_BBAR + (size_t)2 * 64 * 64 * 16 * 2 * 4;
constexpr size_t WS_END = WS_SPL + (size_t)2 * 1024 * 4;
static_assert(WS_END <= 1251999744ull, "d_ws map exceeds the guaranteed workspace");

constexpr int RING_OFF = 0, RING_BYTES = 131072;
constexpr int LDSCTL_OFF = RING_BYTES, MISC_OFF = LDSCTL_OFF + 320;
constexpr int LDS_BYTES = 147456;

#define GAS __attribute__((address_space(1)))
#define LAS __attribute__((address_space(3)))
typedef unsigned short bf16;
typedef unsigned v4u __attribute__((ext_vector_type(4)));
typedef float f32x4 __attribute__((ext_vector_type(4)));
typedef GAS unsigned gu32;
#define RLX_AGENT __ATOMIC_RELAXED, __HIP_MEMORY_SCOPE_AGENT
#define LDS_WAIT() asm volatile("s_waitcnt lgkmcnt(0)" ::: "memory")
__device__ __forceinline__ unsigned f2bf(float f) { unsigned u = __builtin_bit_cast(unsigned, f); return (u + 0x7fffu + ((u >> 16) & 1u)) >> 16; }
__device__ __forceinline__ unsigned pk2(float lo, float hi) { return f2bf(lo) | (f2bf(hi) << 16); }

#define XB_TMO      128
#define XB_XCNT(j)  (256  + 64 * (j))
#define XB_XSUB(j)  (1280 + 64 * (j))
#define XB_XGEN(j)  (2304 + 64 * (j))
#define XB_TOP      3328
#define XB_TOPGEN   3392
#define XCD_BAR_WORDS 3456
#define XB_SPIN_CAP (1u << 23)
__device__ __forceinline__ unsigned xb_ld(unsigned* p)              { return __hip_atomic_load(p, __ATOMIC_RELAXED, __HIP_MEMORY_SCOPE_AGENT); }
__device__ __forceinline__ unsigned xb_add(unsigned* p, unsigned v) { return __hip_atomic_fetch_add(p, v, __ATOMIC_RELAXED, __HIP_MEMORY_SCOPE_AGENT); }
__device__ __forceinline__ unsigned xb_xcc_id() { return (unsigned)__builtin_amdgcn_s_getreg((3 << 11) | 20) & 0xFu; }
#define XB_SPIN(cond, bar) do { unsigned _sp = 0; while (cond) { __builtin_amdgcn_s_sleep(1); \
    if ((++_sp & 255u) == 0u) { if (xb_ld(&(bar)[XB_TMO])) break; if (_sp > XB_SPIN_CAP) { atomicAdd(&(bar)[XB_TMO], 1u); break; } } } } while (0)
struct XcdBarrier { unsigned* bar; unsigned x; volatile LAS unsigned* st; };
__device__ __forceinline__ XcdBarrier xcd_barrier_post(unsigned* bar, volatile LAS unsigned* st) {
    XcdBarrier b; b.bar = bar; b.x = xb_xcc_id(); b.st = st;
    if (threadIdx.x == 0) (void)xb_add(&bar[XB_XCNT(b.x)], 1u);
    return b;
}
__device__ __forceinline__ void xcd_barrier_complete(unsigned* bar, unsigned x, unsigned& nloc, unsigned& nx) {
    const unsigned G = gridDim.x * gridDim.y * gridDim.z;
    unsigned sum, cnt, mine, sp = 0u;
    for (;;) {
        sum = 0u; cnt = 0u; mine = 0u;
#pragma unroll
        for (unsigned j = 0; j < 16; ++j) { const unsigned c = xb_ld(&bar[XB_XCNT(j)]); sum += c; cnt += (c > 0u) ? 1u : 0u; mine = (j == x) ? c : mine; }
        if (sum == G) break;
        __builtin_amdgcn_s_sleep(1);
        if ((++sp & 255u) == 0u) { if (xb_ld(&bar[XB_TMO])) break; if (sp > XB_SPIN_CAP) { atomicAdd(&bar[XB_TMO], 1u); break; } }
    }
    nloc = mine > 0u ? mine : 1u; nx = cnt > 0u ? cnt : 1u;
}
__device__ __forceinline__ void xcd_barrier(const XcdBarrier& b) {
    asm volatile("s_waitcnt vmcnt(0)" ::: "memory");
    __syncthreads();
    if (threadIdx.x == 0) {
        unsigned* bar = b.bar;
        __builtin_amdgcn_s_waitcnt(0);
        unsigned nloc = b.st[0], nx = b.st[1];
        if (nloc == 0u) { xcd_barrier_complete(bar, b.x, nloc, nx); b.st[0] = nloc; b.st[1] = nx; }
        const unsigned old = xb_add(&bar[XB_XSUB(b.x)], 1u);
        const unsigned gen = old / nloc;
        if (old + 1u == (gen + 1u) * nloc) {
            __builtin_amdgcn_fence(__ATOMIC_RELEASE, "agent");
            asm volatile("s_waitcnt vmcnt(0)" ::: "memory");
            const unsigned og = xb_add(&bar[XB_TOP], 1u);
            const unsigned tg = og / nx;
            if (og + 1u == (tg + 1u) * nx) xb_add(&bar[XB_TOPGEN], 1u);
            else XB_SPIN(xb_ld(&bar[XB_TOPGEN]) == tg, bar);
            __builtin_amdgcn_fence(__ATOMIC_ACQUIRE, "agent");
            xb_add(&bar[XB_XGEN(b.x)], 1u);
            asm volatile("s_waitcnt vmcnt(0)" ::: "memory");
        } else {
            XB_SPIN(xb_ld(&bar[XB_XGEN(b.x)]) == gen, bar);
            __builtin_amdgcn_fence(__ATOMIC_ACQUIRE, "agent");
            asm volatile("s_waitcnt vmcnt(0)" ::: "memory");
        }
    }
    __syncthreads();
}

struct Args { const void* in[34]; float* out; unsigned char* ws; int ph_lo, ph_hi; };
struct Frame {
    LAS unsigned char* lds;
    unsigned char* ldsg;
    int vcu, G;
};
typedef const __attribute__((address_space(4))) Args* ArgsP;
#define IN_F(i) ((const float*)AP->in[i])
#define PHASE_IDS() int tid = threadIdx.x; asm volatile("" : "+v"(tid)); const int lane = tid & 63; const int wave = __builtin_amdgcn_readfirstlane(tid >> 6); (void)lane; (void)wave; \
    ArgsP AP = (ArgsP)__builtin_amdgcn_kernarg_segment_ptr(); asm volatile("" : "+s"(AP))
#define WSF(off) ((float*)(AP->ws + (off)))

__device__ __forceinline__ float wave_sum(float v) {
#pragma unroll
    for (int o = 1; o < 64; o <<= 1) v += __shfl_xor(v, o);
    return v;
}
__device__ __forceinline__ float wave_max(float v) {
#pragma unroll
    for (int o = 1; o < 64; o <<= 1) v = fmaxf(v, __shfl_xor(v, o));
    return v;
}
__device__ __forceinline__ float sigmoidf_(float x) { return 1.0f / (1.0f + __expf(-x)); }
__device__ __forceinline__ float siluf_(float x) { return x * sigmoidf_(x); }
__device__ __forceinline__ float softplusf_(float x) { return fmaxf(x, 0.f) + log1pf(__expf(-fabsf(x))); }
__device__ __forceinline__ float gelu_tanh(float x) { const float u = 0.7978845608028654f * (x + 0.044715f * x * x * x); const float e = __expf(2.f * u); const float th = 1.f - 2.f / (e + 1.f); return 0.5f * x * (1.f + th); }

__device__ __forceinline__ int zc_src(int n) {
    if (n < 3328) return n; if (n < 6400) return n + 64; if (n < 9472) return n + 80; if (n < 9536) return n - 9472 + 3328; if (n < 9552) return n - 9536 + 6464; return -1;
}
template <bool MAPPED>
__device__ __forceinline__ void p0_transpose_item(const float* W, int K, int Nsrc, int Ndst, bf16* WT, LAS float* scr, int item, int lane, int ldw = 0) {
    if (ldw == 0) ldw = K;
    const int nblk = Ndst / 32, kb = item / nblk, nb = item % nblk, k0 = 64 * kb, n0 = 32 * nb;
    const int nd = n0 + (lane & 31); const int ns = MAPPED ? zc_src(nd) : nd;
#pragma unroll 8
    for (int i = 0; i < 32; ++i) { const int kk = 2 * i + (lane >> 5); scr[kk * 33 + (lane & 31)] = ns >= 0 ? W[(size_t)(k0 + kk) * Nsrc + ns] : 0.f; }
    LDS_WAIT(); asm volatile("" ::: "memory");
    const int c = lane & 7;
#pragma unroll
    for (int j = 0; j < 4; ++j) { const int n = (lane >> 3) + 8 * j; const LAS float* s = scr + (8 * c) * 33 + n;
        v4u o; o.x = pk2(s[0 * 33], s[1 * 33]); o.y = pk2(s[2 * 33], s[3 * 33]); o.z = pk2(s[4 * 33], s[5 * 33]); o.w = pk2(s[6 * 33], s[7 * 33]);
        *(GAS v4u*)(WT + (size_t)(n0 + n) * ldw + k0 + 8 * c) = o; }
    LDS_WAIT(); asm volatile("" ::: "memory");
}
template <bool TOBF>
__device__ __forceinline__ void rms_row(const float* xrow, const float* g, void* orow, int lane) {
    const f32x4* xr = (const f32x4*)xrow + lane; const f32x4* gr = (const f32x4*)g + lane;
    f32x4 v[16]; float s = 0.f;
#pragma unroll
    for (int j = 0; j < 16; ++j) { v[j] = xr[64 * j]; s += (v[j].x * v[j].x + v[j].y * v[j].y) + (v[j].z * v[j].z + v[j].w * v[j].w); }
    const float rs = 1.0f / sqrtf(wave_sum(s) * (1.f / DM) + EPS);
#pragma unroll
    for (int j = 0; j < 16; ++j) { const f32x4 gg = gr[64 * j]; const f32x4 o = v[j] * rs * gg;
        if (TOBF) ((unsigned long long*)orow)[lane + 64 * j] = (unsigned long long)pk2(o.x, o.y) | ((unsigned long long)pk2(o.z, o.w) << 32);
        else ((f32x4*)orow)[lane + 64 * j] = o; }
}

__device__ __forceinline__ void p0_prologue(Frame& F) {
    PHASE_IDS();
    LAS float* scr = (LAS float*)(F.lds + RING_OFF + wave * 16384);
    const int gw = F.vcu * NWAVES + wave, NGW = F.G * NWAVES;
    constexpr int I_IN = (DM / 64) * (ZC / 32), I_OUT = (DM / 64) * (DM / 32);
    constexpr int I_UQ = (QR / 64) * (1536 / 32), I_UK = (KVR / 64) * (BR / 32), I_GLU = (BR / 64) * (BR / 32), I_LRU = 2 * 4;
    constexpr int NSMALL = 2 * (I_UQ + 2 * I_UK + I_GLU + 16 * I_LRU);
    constexpr int NITEMS = 2 * I_IN + 2 * I_OUT + NSMALL;
    for (int it = gw; it < NITEMS; it += NGW) {
        int r = it;
        if (r < NSMALL) { const int l = r / (NSMALL / 2); r -= l * (NSMALL / 2);
            if (r < I_UQ) { p0_transpose_item<false>(IN_F(17) + (size_t)l * QR * 1536, QR, 1536, 1536, (bf16*)(AP->ws + WS_WTUQ) + (size_t)l * 1536 * QR, scr, r, lane); continue; } r -= I_UQ;
            if (r < I_UK) { p0_transpose_item<false>(IN_F(18) + (size_t)l * KVR * BR, KVR, BR, BR, (bf16*)(AP->ws + WS_WTUKV) + (size_t)l * 2048 * KVR, scr, r, lane); continue; } r -= I_UK;
            if (r < I_UK) { p0_transpose_item<false>(IN_F(19) + (size_t)l * KVR * BR, KVR, BR, BR, (bf16*)(AP->ws + WS_WTUKV) + ((size_t)l * 2048 + 1024) * KVR, scr, r, lane); continue; } r -= I_UK;
            if (r < I_GLU) { p0_transpose_item<false>(IN_F(12) + (size_t)l * BR * BR, BR, BR, BR, (bf16*)(AP->ws + WS_WTGLU) + (size_t)l * BR * BR, scr, r, lane); continue; } r -= I_GLU;
            { const int jj = r / I_LRU, gate = jj & 1, j = jj >> 1; r -= jj * I_LRU;
              p0_transpose_item<false>(IN_F(gate ? 28 : 26) + (size_t)(l * 8 + j) * 128 * 128, 128, 128, 128, (bf16*)(AP->ws + WS_WTLRU) + ((size_t)(l * 8 + j) * 256 + gate * 128) * 1024, scr, r, lane, 1024); continue; }
        }
        r -= NSMALL;
        if (r < 2 * I_IN) { const int l = r / I_IN; r -= l * I_IN;
            p0_transpose_item<true>(IN_F(3) + (size_t)l * DM * INC, DM, INC, ZC, (bf16*)(AP->ws + WS_WTIN) + (size_t)l * ZC * DM, scr, r, lane); continue; }
        r -= 2 * I_IN; { const int l = r / I_OUT; r -= l * I_OUT;
            p0_transpose_item<false>(IN_F(32) + (size_t)l * DM * DM, DM, DM, DM, (bf16*)(AP->ws + WS_WTOUT) + (size_t)l * DM * DM, scr, r, lane); }
    }
    { const int* pos = (const int*)AP->in[1]; float* rt = WSF(WS_ROPE);
      for (int e = blockIdx.x * 512 + tid; e < T * 32; e += F.G * 512) { const int m = e >> 5, i = e & 31;
          const double invf = exp(-(double)i * (9.210340371976184 / 32.0));
          double ang = (double)pos[m] * invf; const double k = rint(ang * 0.15915494309189535); ang -= k * 6.283185307179586;
          const float a = (float)ang; rt[m * 64 + i] = cosf(a); rt[m * 64 + 32 + i] = sinf(a); } }
    { float* lb = WSF(WS_LAMB); float* bb = WSF(WS_BBAR);
      for (int e = blockIdx.x * 512 + tid; e < 2 * 64 * 64; e += F.G * 512) { const int l = e >> 12, g = (e >> 6) & 63;
          const float lre = IN_F(4)[e], lim = IN_F(5)[e]; const float dt = expf(IN_F(11)[l * 64 + g]);
          const float mag = expf(lre * dt); float sn, cs; sincosf(lim * dt, &sn, &cs);
          const float bre = mag * cs, bim = mag * sn; lb[2 * e] = bre; lb[2 * e + 1] = bim;
          const float nre = bre - 1.f, nim = bim, den = 1.f / (lre * lre + lim * lim);
          const float fre = (nre * lre + nim * lim) * den, fim = (nim * lre - nre * lim) * den;
          for (int h = 0; h < 16; ++h) { const float br = IN_F(6)[e * 16 + h], bi = IN_F(7)[e * 16 + h];
              bb[(e * 16 + h) * 2] = fre * br - fim * bi; bb[(e * 16 + h) * 2 + 1] = fre * bi + fim * br; } } }
    for (int e = blockIdx.x * 512 + tid; e < 2 * BR; e += F.G * 512) WSF(WS_SPL)[e] = softplusf_(-IN_F(30)[e]);
    for (int m = gw; m < T; m += NGW) { asm volatile("" ::: "memory");  rms_row<true>(IN_F(0) + (size_t)m * DM, IN_F(2), (bf16*)(AP->ws + WS_HB) + (size_t)m * DM, lane); }
}

__device__ __forceinline__ void p2_rows(Frame& F, int l) {
    PHASE_IDS();
    const int gw = F.vcu * NWAVES + wave, NGW = F.G * NWAVES;
    const float* z = WSF(WS_Z);
    for (int m = gw; m < T; m += NGW) {
        asm volatile("" ::: "memory");
        const float* zr = z + (size_t)m * ZC;
        { float v[12]; float s = 0.f;
#pragma unroll
          for (int j = 0; j < 12; ++j) { v[j] = zr[Z_CQ + lane + 64 * j]; s += v[j] * v[j]; }
          const float rs = 1.0f / sqrtf(wave_sum(s) * (1.f / QR) + EPS);
#pragma unroll
          for (int j = 0; j < 12; ++j) ((bf16*)(AP->ws + WS_CQB))[(size_t)m * QR + lane + 64 * j] = (bf16)f2bf(v[j] * rs * IN_F(15)[l * QR + lane + 64 * j]); }
        { float v[8]; float s = 0.f;
#pragma unroll
          for (int j = 0; j < 8; ++j) { v[j] = zr[Z_CKV + lane + 64 * j]; s += v[j] * v[j]; }
          const float rs = 1.0f / sqrtf(wave_sum(s) * (1.f / KVR) + EPS);
#pragma unroll
          for (int j = 0; j < 8; ++j) ((bf16*)(AP->ws + WS_CKVB))[(size_t)m * KVR + lane + 64 * j] = (bf16)f2bf(v[j] * rs * IN_F(16)[l * KVR + lane + 64 * j]); }
        if (lane < 32) { const float x1 = zr[Z_KR + lane], x2 = zr[Z_KR + 32 + lane]; const float c = WSF(WS_ROPE)[m * 64 + lane], s = WSF(WS_ROPE)[m * 64 + 32 + lane];
            ((bf16*)(AP->ws + WS_KR))[m * 64 + lane] = (bf16)f2bf(x1 * c - x2 * s); ((bf16*)(AP->ws + WS_KR))[m * 64 + 32 + lane] = (bf16)f2bf(x2 * c + x1 * s); }
        { float gl[16];
#pragma unroll
          for (int r = 0; r < 16; ++r) gl[r] = zr[Z_GLR + r];
#pragma unroll 1
          for (int j = 0; j < 8; ++j) { const int c = lane + 64 * j; float a = IN_F(22)[l * 512 + c];
#pragma unroll
              for (int r = 0; r < 16; ++r) a += gl[r] * IN_F(21)[(l * 16 + r) * 512 + c];
              WSF(WS_LOGA)[(size_t)m * 512 + c] = -softplusf_(-a) * (1.f / 16.f); } }
        { const int t = m & (SEQ - 1);
#pragma unroll 1
          for (int j = 0; j < 16; ++j) { const int c = lane + 64 * j; float a = IN_F(25)[l * BR + c];
#pragma unroll
              for (int w = 0; w < 4; ++w) { const int tt = t - 3 + w; if (tt >= 0) a += IN_F(24)[(l * 4 + w) * BR + c] * z[(size_t)(m - 3 + w) * ZC + Z_LU + c]; }
              WSF(WS_XC)[(size_t)m * BR + c] = a; ((bf16*)(AP->ws + WS_XCB))[(size_t)m * BR + c] = (bf16)f2bf(a); } }
    }
}
__device__ __forceinline__ void p2_s5(Frame& F, int l) {
    PHASE_IDS();
    const int gw = F.vcu * NWAVES + wave, NGW = F.G * NWAVES;
    float* wl = (float*)(F.ldsg + RING_OFF + wave * 16384);
    float* xs = wl;
    float* cs = wl + 2048;
    const float* z = WSF(WS_Z);
    for (int it = gw; it < NB * S5G; it += NGW) {
        const int b = it >> 6, g = it & 63, lg = l * 64 + g;
        const float lbr = WSF(WS_LAMB)[(lg * 64 + lane) * 2], lbi = WSF(WS_LAMB)[(lg * 64 + lane) * 2 + 1];
        float br[16], bi[16];
#pragma unroll
        for (int h = 0; h < 16; ++h) { br[h] = WSF(WS_BBAR)[((lg * 64 + lane) * 16 + h) * 2]; bi[h] = WSF(WS_BBAR)[((lg * 64 + lane) * 16 + h) * 2 + 1]; }
#pragma unroll
        for (int h = 0; h < 16; ++h) { cs[(h * 64 + lane) * 2] = IN_F(8)[(lg * 16 + h) * 64 + lane]; cs[(h * 64 + lane) * 2 + 1] = IN_F(9)[(lg * 16 + h) * 64 + lane]; }
        float xr = 0.f, xi = 0.f;
        const int so = lane >> 2, h0 = (lane & 3) * 4;
        float dd[4];
#pragma unroll
        for (int i = 0; i < 4; ++i) dd[i] = IN_F(10)[lg * 16 + h0 + i];
        for (int t0 = 0; t0 < SEQ; t0 += 16) {
            asm volatile("" ::: "memory");
            const size_t m0 = (size_t)b * SEQ + t0;
            const f32x4 uq = *(const f32x4*)(z + (m0 + so) * ZC + Z_S5U + g * 16 + h0);
#pragma unroll
            for (int s = 0; s < 16; ++s) {
                float bur = 0.f, bui = 0.f;
#pragma unroll
                for (int h = 0; h < 16; ++h) { const float comp = (h & 3) == 0 ? uq.x : (h & 3) == 1 ? uq.y : (h & 3) == 2 ? uq.z : uq.w;
                    const float u = __shfl(comp, s * 4 + (h >> 2)); bur += br[h] * u; bui += bi[h] * u; }
                const float nr = lbr * xr - lbi * xi + bur, ni = lbr * xi + lbi * xr + bui; xr = nr; xi = ni;
                xs[(s * 64 + lane) * 2] = xr; xs[(s * 64 + lane) * 2 + 1] = xi;
            }
            LDS_WAIT(); asm volatile("" ::: "memory");
            float acc[4] = {0.f, 0.f, 0.f, 0.f};
            for (int p = 0; p < 64; ++p) { const float ar = xs[(so * 64 + p) * 2], ai = xs[(so * 64 + p) * 2 + 1];
#pragma unroll
                for (int i = 0; i < 4; ++i) acc[i] += cs[((h0 + i) * 64 + p) * 2] * ar - cs[((h0 + i) * 64 + p) * 2 + 1] * ai; }
            f32x4 o; o.x = gelu_tanh(acc[0] + dd[0] * uq.x); o.y = gelu_tanh(acc[1] + dd[1] * uq.y); o.z = gelu_tanh(acc[2] + dd[2] * uq.z); o.w = gelu_tanh(acc[3] + dd[3] * uq.w);
            *(f32x4*)(WSF(WS_YS5) + (m0 + so) * BR + g * 16 + h0) = o;
            *(unsigned long long*)((bf16*)(AP->ws + WS_YS5B) + (m0 + so) * BR + g * 16 + h0) = (unsigned long long)pk2(o.x, o.y) | ((unsigned long long)pk2(o.z, o.w) << 32);
            LDS_WAIT(); asm volatile("" ::: "memory");
        }
    }
}

__device__ __forceinline__ void p3_gla(Frame& F, int l) {
    float* qs = (float*)(F.ldsg + RING_OFF + 32768);
    float* ks = qs + 1024; float* as = ks + 1024;
    PHASE_IDS();
    const float* z = WSF(WS_Z); const int j = tid >> 1, hf = tid & 1;
    for (int it = F.vcu; it < NB * GH; it += F.G) {
        const int b = it >> 2, h = it & 3;
        float S[64];
#pragma unroll
        for (int d = 0; d < 64; ++d) S[d] = 0.f;
        for (int t0 = 0; t0 < SEQ; t0 += 8) {
            const size_t m0 = (size_t)b * SEQ + t0;
            __syncthreads();
            for (int e = tid; e < 1024; e += 512) { const int s = e >> 7, d = e & 127;
                qs[e] = z[(m0 + s) * ZC + Z_GQ + h * 128 + d]; ks[e] = z[(m0 + s) * ZC + Z_GK + h * 128 + d]; as[e] = __expf(WSF(WS_LOGA)[(m0 + s) * 512 + h * 128 + d]); }
            float vv[8];
#pragma unroll
            for (int s = 0; s < 8; ++s) vv[s] = z[(m0 + s) * ZC + Z_GV + h * 256 + j];
            __syncthreads();
#pragma unroll
            for (int s = 0; s < 8; ++s) { float o = 0.f;
#pragma unroll
                for (int d = 0; d < 64; ++d) { const int dd = s * 128 + hf * 64 + d; S[d] = as[dd] * S[d] + ks[dd] * vv[s]; o += qs[dd] * S[d]; }
                o += __shfl_xor(o, 1);
                if (hf == 0) WSF(WS_OGLA)[(m0 + s) * BR + h * 256 + j] = o * 0.08838834764831845f; }
        }
    }
    __syncthreads();
}
__device__ __forceinline__ void p4_lru(Frame& F, int l) {
    PHASE_IDS();
    const int gw = F.vcu * NWAVES + wave, NGW = F.G * NWAVES;
    for (int it = gw; it < NB * 16; it += NGW) {
        const int b = it >> 4, c = (it & 15) * 64 + lane;
        float h = 0.f;
        for (int t = 0; t < SEQ; t += 8) {
            asm volatile("" ::: "memory");
            float av[8], gv[8];
#pragma unroll
            for (int s = 0; s < 8; ++s) { const size_t o = ((size_t)b * SEQ + t + s) * BR + c; av[s] = WSF(WS_RPRE)[o]; gv[s] = WSF(WS_IPRE)[o]; }
#pragma unroll
            for (int s = 0; s < 8; ++s) { h = av[s] * h + gv[s]; WSF(WS_HLRU)[((size_t)b * SEQ + t + s) * BR + c] = h; }
        }
    }
}
typedef short bf16x8_t __attribute__((ext_vector_type(8)));
typedef float f32x16_t __attribute__((ext_vector_type(16)));
typedef short s16x4_t __attribute__((ext_vector_type(4)));
typedef unsigned u32x4_t __attribute__((ext_vector_type(4)));
constexpr int AT_KSTR = 400, AT_VSTR = 320, AT_KBYTES = 64 * AT_KSTR, AT_BUF = AT_KBYTES + 64 * AT_VSTR;
__device__ __forceinline__ unsigned cvtpk_s(float lo, float hi) { typedef float f2 __attribute__((ext_vector_type(2))); typedef __bf16 b2 __attribute__((ext_vector_type(2))); f2 v = {lo, hi}; b2 b = __builtin_convertvector(v, b2); return __builtin_bit_cast(unsigned, b); }
__device__ __forceinline__ float bflo(unsigned w) { return __uint_as_float(w << 16); }
__device__ __forceinline__ float bfhi(unsigned w) { return __uint_as_float(w & 0xffff0000u); }
__device__ __forceinline__ void attn_phase(Frame& F) {
    PHASE_IDS();
    const int hh = lane >> 5, r32 = lane & 31;
    LAS unsigned char* L = F.lds + RING_OFF;
    const bf16* Qb = (const bf16*)(AP->ws + WS_Q); const bf16* KNb = (const bf16*)(AP->ws + WS_KN); const bf16* Vb = (const bf16*)(AP->ws + WS_V); const bf16* KRb = (const bf16*)(AP->ws + WS_KR);
    const float SC = 0.07216878364870322f * 1.4426950408889634f;
    const int half = wave >> 2, w4 = wave & 3;
    const int skey = tid >> 4, sc = tid & 15, rkey = tid >> 3, rc = tid & 7;
    for (int u = F.vcu; u < 256; u += F.G) {
        const int b = u >> 6, h = (u >> 3) & 7, i = u & 7;
        const int qblk = half ? i : 15 - i;
        const int qrow0 = qblk * 128 + w4 * 32, qrow = qrow0 + r32;
        const int ntile = 2 * (16 - i), tlast = (qrow0 + 31) >> 6;
        const size_t mrow = (size_t)b * SEQ + qrow;
        bf16x8_t qf[12];
        { const u32x4_t* qp = (const u32x4_t*)(Qb + mrow * 1536 + h * DQK + 8 * hh);
          u32x4_t raw[12];
#pragma unroll
          for (int ks = 0; ks < 12; ++ks) raw[ks] = qp[2 * ks];
#pragma unroll
          for (int ks = 0; ks < 8; ++ks) { u32x4_t o;
#pragma unroll
              for (int w = 0; w < 4; ++w) o[w] = cvtpk_s(bflo(raw[ks][w]) * SC, bfhi(raw[ks][w]) * SC);
              qf[ks] = __builtin_bit_cast(bf16x8_t, o); }
          const float* rt = WSF(WS_ROPE) + mrow * 64;
#pragma unroll
          for (int ks = 8; ks < 10; ++ks) { const int i0 = 16 * (ks - 8) + 8 * hh; u32x4_t o1, o2;
              const f32x4 c0 = *(const f32x4*)(rt + i0), c1 = *(const f32x4*)(rt + i0 + 4), s0 = *(const f32x4*)(rt + 32 + i0), s1 = *(const f32x4*)(rt + 32 + i0 + 4);
              const float cc[8] = {c0.x, c0.y, c0.z, c0.w, c1.x, c1.y, c1.z, c1.w}, ss[8] = {s0.x, s0.y, s0.z, s0.w, s1.x, s1.y, s1.z, s1.w};
#pragma unroll
              for (int w = 0; w < 4; ++w) { const float a0 = bflo(raw[ks][w]), a1 = bfhi(raw[ks][w]), b0 = bflo(raw[ks + 2][w]), b1 = bfhi(raw[ks + 2][w]);
                  o1[w] = cvtpk_s((a0 * cc[2 * w] - b0 * ss[2 * w]) * SC, (a1 * cc[2 * w + 1] - b1 * ss[2 * w + 1]) * SC);
                  o2[w] = cvtpk_s((b0 * cc[2 * w] + a0 * ss[2 * w]) * SC, (b1 * cc[2 * w + 1] + a1 * ss[2 * w + 1]) * SC); }
              qf[ks] = __builtin_bit_cast(bf16x8_t, o1); qf[ks + 2] = __builtin_bit_cast(bf16x8_t, o2); } }
        f32x16_t O[4];
#pragma unroll
        for (int d = 0; d < 4; ++d)
#pragma unroll
            for (int r = 0; r < 16; ++r) O[d][r] = 0.f;
        float m_run = -1e30f, l_run = 0.f;
        const bf16* knp = KNb + ((size_t)b * SEQ + skey) * BR + h * 128 + sc * 8;
        const bf16* vp = Vb + ((size_t)b * SEQ + skey) * BR + h * 128 + sc * 8;
        const bf16* krp = KRb + ((size_t)b * SEQ + rkey) * 64 + rc * 8;
        u32x4_t gk0, gk1, gkr, gv0, gv1;
#define AT_LOAD(t) do { const size_t ko = (size_t)(t) * 64 * BR; gk0 = *(const u32x4_t*)(knp + ko); gk1 = *(const u32x4_t*)(knp + ko + 32 * BR); \
        gv0 = *(const u32x4_t*)(vp + ko); gv1 = *(const u32x4_t*)(vp + ko + 32 * BR); gkr = *(const u32x4_t*)(krp + (size_t)(t) * 64 * 64); } while (0)
#define AT_STORE(p) do { LAS unsigned char* Bp = L + (p) * AT_BUF; \
        *(LAS u32x4_t*)(Bp + skey * AT_KSTR + sc * 16) = gk0; *(LAS u32x4_t*)(Bp + (skey + 32) * AT_KSTR + sc * 16) = gk1; \
        *(LAS u32x4_t*)(Bp + rkey * AT_KSTR + 256 + rc * 16) = gkr; \
        *(LAS u32x4_t*)(Bp + AT_KBYTES + skey * AT_VSTR + sc * 16) = gv0; *(LAS u32x4_t*)(Bp + AT_KBYTES + (skey + 32) * AT_VSTR + sc * 16) = gv1; } while (0)
        __syncthreads();
        AT_LOAD(0); AT_STORE(0);
        __syncthreads();
        for (int t = 0; t < ntile; ++t) {
            if (t + 1 < ntile) AT_LOAD(t + 1);
            if (t <= tlast) {
                LAS unsigned char* Kb = L + (t & 1) * AT_BUF; LAS unsigned char* Vbs = Kb + AT_KBYTES;
                f32x16_t S0, S1;
#pragma unroll
                for (int r = 0; r < 16; ++r) { S0[r] = 0.f; S1[r] = 0.f; }
                const LAS unsigned char* ka = Kb + r32 * AT_KSTR + hh * 16;
#pragma unroll
                for (int ks = 0; ks < 12; ++ks) {
                    const bf16x8_t k0 = *(const LAS bf16x8_t*)(ka + ks * 32), k1 = *(const LAS bf16x8_t*)(ka + 32 * AT_KSTR + ks * 32);
                    S0 = __builtin_amdgcn_mfma_f32_32x32x16_bf16(k0, qf[ks], S0, 0, 0, 0);
                    S1 = __builtin_amdgcn_mfma_f32_32x32x16_bf16(k1, qf[ks], S1, 0, 0, 0);
                }
                if (64 * t + 63 > qrow0) {
                    const int kb = 64 * t + 4 * hh;
#pragma unroll
                    for (int r = 0; r < 16; ++r) { const int key = kb + (r & 3) + 8 * (r >> 2); if (key > qrow) S0[r] = -1e30f; if (key + 32 > qrow) S1[r] = -1e30f; }
                }
                float mx = fmaxf(S0[0], S1[0]);
#pragma unroll
                for (int r = 1; r < 16; ++r) mx = fmaxf(mx, fmaxf(S0[r], S1[r]));
                mx = fmaxf(mx, __shfl_xor(mx, 32));
                if (__any(mx > m_run)) { const float mn = fmaxf(m_run, mx); const float al = __builtin_amdgcn_exp2f(m_run - mn); m_run = mn; l_run *= al;
#pragma unroll
                    for (int d = 0; d < 4; ++d)
#pragma unroll
                        for (int r = 0; r < 16; ++r) O[d][r] *= al; }
                float ls = 0.f;
#pragma unroll
                for (int r = 0; r < 16; ++r) { S0[r] = __builtin_amdgcn_exp2f(S0[r] - m_run); S1[r] = __builtin_amdgcn_exp2f(S1[r] - m_run); ls += S0[r] + S1[r]; }
                l_run += ls;
                bf16x8_t pf[2][2];
#pragma unroll
                for (int s2 = 0; s2 < 2; ++s2) { u32x4_t a, c;
#pragma unroll
                    for (int w = 0; w < 4; ++w) { a[w] = cvtpk_s(S0[8 * s2 + 2 * w], S0[8 * s2 + 2 * w + 1]); c[w] = cvtpk_s(S1[8 * s2 + 2 * w], S1[8 * s2 + 2 * w + 1]); }
                    pf[0][s2] = __builtin_bit_cast(bf16x8_t, a); pf[1][s2] = __builtin_bit_cast(bf16x8_t, c); }
                const LAS unsigned char* va = Vbs + (4 * hh + ((lane & 15) >> 2)) * AT_VSTR + (((lane >> 4) & 1) * 16 + (lane & 3) * 4) * 2;
#pragma unroll
                for (int d = 0; d < 4; ++d)
#pragma unroll
                    for (int kb2 = 0; kb2 < 2; ++kb2)
#pragma unroll
                        for (int s2 = 0; s2 < 2; ++s2) {
                            const LAS unsigned char* p = va + (32 * kb2 + 16 * s2) * AT_VSTR + d * 64;
                            const s16x4_t lo = __builtin_bit_cast(s16x4_t, __builtin_amdgcn_ds_read_tr16_b64_v4i16((LAS s16x4_t*)p));
                            const s16x4_t hi = __builtin_bit_cast(s16x4_t, __builtin_amdgcn_ds_read_tr16_b64_v4i16((LAS s16x4_t*)(p + 8 * AT_VSTR)));
                            const bf16x8_t vf = {lo[0], lo[1], lo[2], lo[3], hi[0], hi[1], hi[2], hi[3]};
                            O[d] = __builtin_amdgcn_mfma_f32_32x32x16_bf16(vf, pf[kb2][s2], O[d], 0, 0, 0);
                        }
            }
            if (t + 1 < ntile) AT_STORE((t + 1) & 1);
            __syncthreads();
        }
#undef AT_LOAD
#undef AT_STORE
        l_run += __shfl_xor(l_run, 32);
        const float inv = 1.f / l_run;
        float* op = WSF(WS_OMLA) + mrow * BR + h * 128 + 4 * hh;
#pragma unroll
        for (int d = 0; d < 4; ++d)
#pragma unroll
            for (int c = 0; c < 4; ++c) *(f32x4*)(op + 32 * d + 8 * c) = (f32x4){O[d][4 * c] * inv, O[d][4 * c + 1] * inv, O[d][4 * c + 2] * inv, O[d][4 * c + 3] * inv};
    }
    __syncthreads();
}
__device__ __forceinline__ void p5_norms(Frame& F, int l) {
    PHASE_IDS();
    const int gw = F.vcu * NWAVES + wave, NGW = F.G * NWAVES;
    const float* z = WSF(WS_Z); bf16* yb = (bf16*)(AP->ws + WS_HB);
    for (int m = gw; m < T; m += NGW) {
#pragma unroll
        for (int br = 0; br < 4; ++br) {
            asm volatile("" ::: "memory");
            const float* src = br == 0 ? WSF(WS_S5O) : br == 1 ? WSF(WS_OMLA) : br == 2 ? WSF(WS_OGLA) : WSF(WS_HLRU);
            const float* gg = (br == 0 ? IN_F(14) : br == 1 ? IN_F(20) : br == 2 ? IN_F(23) : IN_F(31)) + l * BR;
            const int zg = br == 0 ? Z_S5G : br == 1 ? Z_MG : br == 2 ? Z_GG : Z_LG;
            f32x4 v[4]; float ss[4]; float tot = 0.f;
#pragma unroll
            for (int j = 0; j < 4; ++j) { v[j] = *(const f32x4*)(src + (size_t)m * BR + 256 * j + 4 * lane); ss[j] = wave_sum((v[j].x * v[j].x + v[j].y * v[j].y) + (v[j].z * v[j].z + v[j].w * v[j].w)); tot += ss[j]; }
#pragma unroll
            for (int j = 0; j < 4; ++j) { const float rs = br == 2 ? 1.0f / sqrtf(ss[j] * (1.f / 256.f) + EPS) : 1.0f / sqrtf(tot * (1.f / 1024.f) + EPS);
                const f32x4 g4 = *(const f32x4*)(gg + 256 * j + 4 * lane); const f32x4 gt = *(const f32x4*)(z + (size_t)m * ZC + zg + 256 * j + 4 * lane);
                const float o0 = v[j].x * rs * g4.x * siluf_(gt.x), o1 = v[j].y * rs * g4.y * siluf_(gt.y), o2 = v[j].z * rs * g4.z * siluf_(gt.z), o3 = v[j].w * rs * g4.w * siluf_(gt.w);
                *(unsigned long long*)(yb + (size_t)m * DM + br * BR + 256 * j + 4 * lane) = (unsigned long long)pk2(o0, o1) | ((unsigned long long)pk2(o2, o3) << 32); }
        }
    }
}
__device__ __forceinline__ void p7_norm(Frame& F, int l) {
    PHASE_IDS();
    const int gw = F.vcu * NWAVES + wave, NGW = F.G * NWAVES;
    for (int m = gw; m < T; m += NGW) {
        asm volatile("" ::: "memory");
        if (l + 1 < DEPTH) rms_row<true>(WSF(WS_XB) + (size_t)m * DM, IN_F(2) + (l + 1) * DM, (bf16*)(AP->ws + WS_HB) + (size_t)m * DM, lane);
        else rms_row<false>(WSF(WS_XB) + (size_t)m * DM, IN_F(33), AP->out + (size_t)m * DM, lane);
    }
}

constexpr int PH_PER_LAYER = 7, N_PHASES = 1 + DEPTH * PH_PER_LAYER;
__global__ void __launch_bounds__(NWAVES * 64, 2) hybrid_fwd(Args args) {
    extern __shared__ __attribute__((aligned(16))) unsigned char lds[];
    Frame F;
    F.lds = (LAS unsigned char*)lds; F.ldsg = lds;
    F.G = gridDim.x; { const int bx = blockIdx.x; F.vcu = (F.G % 8 == 0) ? (bx % 8) * (F.G / 8) + bx / 8 : bx; }
    volatile LAS unsigned* MISC = (volatile LAS unsigned*)(F.lds + MISC_OFF);
    for (int u = threadIdx.x; u < (LDS_BYTES - LDSCTL_OFF) / 4; u += NWAVES * 64) ((LAS unsigned*)(F.lds + LDSCTL_OFF))[u] = 0u;
    __syncthreads();
    ArgsP AP0 = (ArgsP)__builtin_amdgcn_kernarg_segment_ptr();
    const bool multi = (args.ph_hi - args.ph_lo) > 1;
    XcdBarrier bar; bar.bar = (unsigned*)(AP0->ws + WS_CTL) + 4096; bar.x = 0; bar.st = nullptr;
    if (multi) bar = xcd_barrier_post((unsigned*)(AP0->ws + WS_CTL) + 4096, MISC + 8);
    const int lo = args.ph_lo, hi = args.ph_hi;
#define IN(k) (lo <= (k) && (k) < hi)
#define SEAM(k) do { if (IN(k) && IN((k) + 1)) xcd_barrier(bar); } while (0)
    if (IN(0)) {
#ifndef SK_P0
 p0_prologue(F);
#endif
 } SEAM(0);
    for (int ll = 0; ll < DEPTH; ++ll) {
        int l = ll; asm volatile("" : "+s"(l) :: "memory");
        const int pb = 1 + l * PH_PER_LAYER;
        if (IN(pb + 0)) {
            ArgsP AP = (ArgsP)__builtin_amdgcn_kernarg_segment_ptr(); asm volatile("" : "+s"(AP));
            pg8::Gemm g{(const bf16*)(AP->ws + WS_HB), (const bf16*)(AP->ws + WS_WTIN) + (size_t)l * ZC * DM, T, ZC, DM, DM, DM, 0}; pg8::StaticOrder S; S.init(T, ZC, F.G, (int)blockIdx.x);
            pg8::EpiF32 E{WSF(WS_Z), ZC};
            pg8::gemm_phase<pg8::EpiF32, pg8::StaticOrder, true, true>(F.lds + RING_OFF, g, S, E);
        } SEAM(pb + 0);
        if (IN(pb + 1)) {
#ifndef SK_P2R
 p2_rows(F, l);
#endif
#ifndef SK_P2S
 p2_s5(F, l);
#endif
 } SEAM(pb + 1);
        if (IN(pb + 2)) {
#ifndef SK_P3G
 p3_gla(F, l);
#endif
            { ArgsP AP = (ArgsP)__builtin_amdgcn_kernarg_segment_ptr(); asm volatile("" : "+s"(AP));
#ifndef SK_GQ
              { pg8::Gemm g{(const bf16*)(AP->ws + WS_CQB), (const bf16*)(AP->ws + WS_WTUQ) + (size_t)l * 1536 * QR, T, 1536, QR, QR, QR, 0}; pg8::StaticOrder S; S.init(T, 1536, F.G, (int)blockIdx.x);
                pg8::EpiBf16Split E{(bf16*)(AP->ws + WS_Q), (bf16*)(AP->ws + WS_Q), 1536, 1000}; pg8::gemm_phase<pg8::EpiBf16Split, pg8::StaticOrder, true, true>(F.lds + RING_OFF, g, S, E); }
#endif
#ifndef SK_GKV
              { pg8::Gemm g{(const bf16*)(AP->ws + WS_CKVB), (const bf16*)(AP->ws + WS_WTUKV) + (size_t)l * 2048 * KVR, T, 2048, KVR, KVR, KVR, 0}; pg8::StaticOrder S; S.init(T, 2048, F.G, (int)blockIdx.x);
                pg8::EpiBf16Split E{(bf16*)(AP->ws + WS_KN), (bf16*)(AP->ws + WS_V), BR, 4}; pg8::gemm_phase<pg8::EpiBf16Split, pg8::StaticOrder, true, true>(F.lds + RING_OFF, g, S, E); }
#endif
#ifndef SK_GGLU
              { pg8::Gemm g{(const bf16*)(AP->ws + WS_YS5B), (const bf16*)(AP->ws + WS_WTGLU) + (size_t)l * BR * BR, T, BR, BR, BR, BR, 0}; pg8::StaticOrder S; S.init(T, BR, F.G, (int)blockIdx.x);
                pg8::EpiGlu E{WSF(WS_YS5), IN_F(13) + l * BR, WSF(WS_S5O), BR}; pg8::gemm_phase<pg8::EpiGlu, pg8::StaticOrder, true, true>(F.lds + RING_OFF, g, S, E); }
#endif
#ifndef SK_GLRU
              { pg8::Gemm g{(const bf16*)(AP->ws + WS_XCB), (const bf16*)(AP->ws + WS_WTLRU) + (size_t)l * 8 * 256 * 1024, T, 2048, 128, BR, BR, 256}; pg8::StaticOrder S; S.init(T, 2048, F.G, (int)blockIdx.x);
                pg8::EpiLru E{WSF(WS_XC), IN_F(27) + l * BR, IN_F(29) + l * BR, WSF(WS_SPL) + l * BR, WSF(WS_RPRE), WSF(WS_IPRE)}; pg8::gemm_phase<pg8::EpiLru, pg8::StaticOrder, true, true>(F.lds + RING_OFF, g, S, E); }
#endif
            }
 } SEAM(pb + 2);
        if (IN(pb + 3)) {
#ifndef SK_P4L
 p4_lru(F, l);
#endif
#ifndef SK_P4A
 attn_phase(F);
#endif
 } SEAM(pb + 3);
        if (IN(pb + 4)) {
#ifndef SK_P5
 p5_norms(F, l);
#endif
 } SEAM(pb + 4);
        if (IN(pb + 5)) {
            ArgsP AP = (ArgsP)__builtin_amdgcn_kernarg_segment_ptr(); asm volatile("" : "+s"(AP));
            pg8::Gemm g{(const bf16*)(AP->ws + WS_HB), (const bf16*)(AP->ws + WS_WTOUT) + (size_t)l * DM * DM, T, DM, DM, DM, DM, 0}; pg8::StaticOrder S; S.init(T, DM, F.G, (int)blockIdx.x);
            pg8::EpiRes E{l == 0 ? IN_F(0) : WSF(WS_XB), WSF(WS_XB), DM};
            pg8::gemm_phase<pg8::EpiRes, pg8::StaticOrder, true, true>(F.lds + RING_OFF, g, S, E);
        } SEAM(pb + 5);
        if (IN(pb + 6)) {
#ifndef SK_P7
 p7_norm(F, l);
#endif
 } SEAM(pb + 6);
    }
#undef IN
#undef SEAM
}

#ifndef N_LAUNCHES
#define N_LAUNCHES 1
#endif
extern "C" void kernel_launch(void* const* d_in, const int* in_sizes, int n_in, void* d_out, int out_size, void* d_ws, size_t ws_size, hipStream_t stream) {
    static int grid = 0;
    if (grid == 0) {
        if (n_in != 34 || out_size != T * DM || ws_size < WS_END) { fprintf(stderr, "kernel_launch: unexpected problem: n_in %d out %d ws %zu (need %zu)\n", n_in, out_size, ws_size, (size_t)WS_END); grid = -1; return; }
        int dev = 0, cus = 0;
        if (hipGetDevice(&dev) != hipSuccess || hipDeviceGetAttribute(&cus, hipDeviceAttributeMultiprocessorCount, dev) != hipSuccess) { grid = -1; return; }
        if (hipFuncSetAttribute((const void*)hybrid_fwd, hipFuncAttributeMaxDynamicSharedMemorySize, LDS_BYTES) != hipSuccess) { fprintf(stderr, "kernel_launch: hipFuncSetAttribute failed\n"); grid = -1; return; }
        int per_cu = 0;
        if (hipOccupancyMaxActiveBlocksPerMultiprocessor(&per_cu, (const void*)hybrid_fwd, NWAVES * 64, LDS_BYTES) != hipSuccess || per_cu < 1) fprintf(stderr, "kernel_launch: occupancy query says %d blocks/CU\n", per_cu);
        (void)hipGetLastError();
        grid = cus;
    }
    if (grid < 0) return;
    (void)hipMemsetAsync((char*)d_ws + WS_CTL, 0, CTL_ZERO_BYTES, stream);
    Args a{};
    for (int i = 0; i < 34; ++i) a.in[i] = d_in[i];
    a.out = (float*)d_out; a.ws = (unsigned char*)d_ws;
    if (N_LAUNCHES == 1) { a.ph_lo = 0; a.ph_hi = N_PHASES; hipLaunchKernelGGL(hybrid_fwd, dim3(grid), dim3(NWAVES * 64), LDS_BYTES, stream, a); }
    else for (int p = 0; p < N_PHASES; ++p) { a.ph_lo = p; a.ph_hi = p + 1; hipLaunchKernelGGL(hybrid_fwd, dim3(grid), dim3(NWAVES * 64), LDS_BYTES, stream, a); }
}
```

```cpp
#include <hip/hip_runtime.h>
#include <cstdio>
#include <cstdint>

namespace pg8 {
#define PG8_LAS __attribute__((address_space(3)))
typedef unsigned short bf16_t;
typedef short bf16x8 __attribute__((ext_vector_type(8)));
typedef float f32x4 __attribute__((ext_vector_type(4)));
typedef unsigned u32x4 __attribute__((ext_vector_type(4)));
constexpr int BM = 256, BK = 64, HALF = 128, HTB = HALF * BK * 2, STAGE_BYTES = 8 * HTB, NXCD = 8, WGM = 8;

__host__ __device__ __forceinline__ int lds_byte(int r, int c) { const int st = (r >> 4) * 2 + (c >> 5), rr = r & 15, cc = c & 31, ob = rr * 64 + cc * 2; return st * 1024 + (ob ^ (((ob >> 9) & 1) << 5)); }
__host__ __device__ __forceinline__ void stage_rc(int b, int& R, int& C) { const int st = b / 1024, sb = b % 1024, swz = sb ^ (((sb >> 9) & 1) << 5); R = (st >> 1) * 16 + swz / 64; C = (st & 1) * 32 + (swz % 64) / 2; }
__host__ __device__ __forceinline__ int perm32(int rho) { const int n = rho >> 4, i = rho & 15; return 8 * (i >> 2) + 4 * n + (i & 3); }

struct Unit { int pm, pn; };
struct Gemm { const bf16_t* A; const bf16_t* Bt; int M, N, K; int lda, ldb; int a_colstep; };

struct StaticOrder {
    int nM, nN, nwg, G, c;
    __host__ __device__ void init(int M, int N, int G_, int c_) { nM = M / BM; nN = N / BM; nwg = nM * nN; G = G_; c = c_; }
    __host__ __device__ bool next(int i, Unit& u) const {
        const long L = (long)i * G + c; if (L >= nwg) return false;
        int wgid = (int)L; { const int q = nwg / NXCD, r = nwg % NXCD, xcd = wgid % NXCD, off = wgid / NXCD; wgid = (xcd < r ? xcd * (q + 1) : r * (q + 1) + (xcd - r) * q) + off; }
        const int nig = WGM * nN, gid = wgid / nig, fm = gid * WGM, gsz = (nM - fm) < WGM ? (nM - fm) : WGM;
        u.pm = fm + ((wgid % nig) % gsz); u.pn = (wgid % nig) / gsz; return true;
    }
    __device__ __forceinline__ void a_ready(const Unit&) const {}
    __device__ __forceinline__ void done(const Unit&) const {}
};

struct EpiF32 {
    static constexpr bool PERM = false, AFTER_DRAIN = false;
    float* C; int ldc;
    __device__ __forceinline__ void operator()(const f32x4 (&acc)[2][2][4][2], const Unit& u, int wr, int wc, int fr, int fq) const {
        const int row0 = u.pm * BM + wr * 64 + fr, col0 = u.pn * BM + wc * 32 + 4 * fq;
#pragma unroll
        for (int ai = 0; ai < 2; ++ai)
#pragma unroll
            for (int m = 0; m < 4; ++m) { float* rowp = C + (size_t)(row0 + ai * HALF + m * 16) * ldc + col0;
#pragma unroll
                for (int bj = 0; bj < 2; ++bj)
#pragma unroll
                    for (int n = 0; n < 2; ++n) *(f32x4*)(rowp + bj * HALF + n * 16) = acc[ai][bj][m][n]; }
    }
};
struct EpiRes {
    static constexpr bool PERM = false, AFTER_DRAIN = false;
    const float* base; float* O; int ldc;
    __device__ __forceinline__ void operator()(const f32x4 (&acc)[2][2][4][2], const Unit& u, int wr, int wc, int fr, int fq) const {
        const int row0 = u.pm * BM + wr * 64 + fr, col0 = u.pn * BM + wc * 32 + 4 * fq;
#pragma unroll
        for (int ai = 0; ai < 2; ++ai)
#pragma unroll
            for (int m = 0; m < 4; ++m) { const size_t off = (size_t)(row0 + ai * HALF + m * 16) * ldc + col0;
#pragma unroll
                for (int bj = 0; bj < 2; ++bj)
#pragma unroll
                    for (int n = 0; n < 2; ++n) { const f32x4 b = *(const f32x4*)(base + off + bj * HALF + n * 16); *(f32x4*)(O + off + bj * HALF + n * 16) = b + acc[ai][bj][m][n]; } }
    }
};

struct EpiF32Split {
    static constexpr bool PERM = false, AFTER_DRAIN = false;
    float* C0; float* C1; int ldc; int split;
    __device__ __forceinline__ void operator()(const f32x4 (&acc)[2][2][4][2], const Unit& u, int wr, int wc, int fr, int fq) const {
        float* C = u.pn < split ? C0 : C1; const int pn = u.pn < split ? u.pn : u.pn - split;
        const int row0 = u.pm * BM + wr * 64 + fr, col0 = pn * BM + wc * 32 + 4 * fq;
#pragma unroll
        for (int ai = 0; ai < 2; ++ai)
#pragma unroll
            for (int m = 0; m < 4; ++m) { float* rowp = C + (size_t)(row0 + ai * HALF + m * 16) * ldc + col0;
#pragma unroll
                for (int bj = 0; bj < 2; ++bj)
#pragma unroll
                    for (int n = 0; n < 2; ++n) *(f32x4*)(rowp + bj * HALF + n * 16) = acc[ai][bj][m][n]; }
    }
};__device__ __forceinline__ unsigned cvt_pk_bf16(float lo, float hi) { unsigned r; asm volatile("v_cvt_pk_bf16_f32 %0, %1, %2" : "=v"(r) : "v"(lo), "v"(hi)); return r; }
struct EpiBf16Split {
    static constexpr bool PERM = false, AFTER_DRAIN = false;
    bf16_t* O0; bf16_t* O1; int ldc; int split;
    __device__ __forceinline__ void operator()(const f32x4 (&acc)[2][2][4][2], const Unit& u, int wr, int wc, int fr, int fq) const {
        bf16_t* O = u.pn < split ? O0 : O1; const int pn = u.pn < split ? u.pn : u.pn - split;
        const int row0 = u.pm * BM + wr * 64 + fr, col0 = pn * BM + wc * 32 + 4 * fq;
#pragma unroll
        for (int ai = 0; ai < 2; ++ai)
#pragma unroll
            for (int m = 0; m < 4; ++m) { bf16_t* rowp = O + (size_t)(row0 + ai * HALF + m * 16) * ldc + col0;
#pragma unroll
                for (int bj = 0; bj < 2; ++bj)
#pragma unroll
                    for (int n = 0; n < 2; ++n) { const f32x4 v = acc[ai][bj][m][n];
                        *(unsigned long long*)(rowp + bj * HALF + n * 16) = (unsigned long long)cvt_pk_bf16(v[0], v[1]) | ((unsigned long long)cvt_pk_bf16(v[2], v[3]) << 32); } }
    }
};

__device__ __forceinline__ float sigm(float x) { return 1.0f / (1.0f + __expf(-x)); }
struct EpiGlu {
    static constexpr bool PERM = false, AFTER_DRAIN = false;
    const bf16_t* Y; const float* bias; float* O; int ldc;
    __device__ __forceinline__ void operator()(const f32x4 (&acc)[2][2][4][2], const Unit& u, int wr, int wc, int fr, int fq) const {
        const int row0 = u.pm * BM + wr * 64 + fr, col0 = u.pn * BM + wc * 32 + 4 * fq;
#pragma unroll
        for (int bj = 0; bj < 2; ++bj)
#pragma unroll
            for (int n = 0; n < 2; ++n) { const f32x4 bv = *(const f32x4*)(bias + col0 + bj * HALF + n * 16);
#pragma unroll
        for (int ai = 0; ai < 2; ++ai)
#pragma unroll
            for (int m = 0; m < 4; ++m) { const size_t off = (size_t)(row0 + ai * HALF + m * 16) * ldc + col0 + bj * HALF + n * 16;
                const unsigned long long yb = *(const unsigned long long*)(Y + off); const unsigned y01 = (unsigned)yb, y23 = (unsigned)(yb >> 32);
                const f32x4 v = acc[ai][bj][m][n] + bv; f32x4 o;
                o.x = __uint_as_float(y01 << 16) * sigm(v.x); o.y = __uint_as_float(y01 & 0xffff0000u) * sigm(v.y); o.z = __uint_as_float(y23 << 16) * sigm(v.z); o.w = __uint_as_float(y23 & 0xffff0000u) * sigm(v.w);
                *(f32x4*)(O + off) = o; } }
    }
};
struct EpiLru {
    static constexpr bool PERM = false, AFTER_DRAIN = false;
    const float* XC; const float* ba; const float* bx; const float* spl; float* Aout; float* Gout;
    __device__ __forceinline__ void operator()(const f32x4 (&acc)[2][2][4][2], const Unit& u, int wr, int wc, int fr, int fq) const {
        const int row0 = u.pm * BM + wr * 64 + fr, ch0 = u.pn * 128 + wc * 32 + 4 * fq;
#pragma unroll
        for (int n = 0; n < 2; ++n) { const f32x4 va = *(const f32x4*)(ba + ch0 + n * 16), vx = *(const f32x4*)(bx + ch0 + n * 16), sp = *(const f32x4*)(spl + ch0 + n * 16);
#pragma unroll
        for (int ai = 0; ai < 2; ++ai)
#pragma unroll
            for (int m = 0; m < 4; ++m) { const size_t off = (size_t)(row0 + ai * HALF + m * 16) * 1024 + ch0;
                const f32x4 xc = *(const f32x4*)(XC + off + n * 16); f32x4 oa, og;
#pragma unroll
                for (int e = 0; e < 4; ++e) { const float r = sigm(acc[ai][0][m][n][e] + va[e]), ig = sigm(acc[ai][1][m][n][e] + vx[e]);
                    const float la = -8.f * r * sp[e]; const float a = __expf(la); const float x = 2.f * la;
                    const float ser = -x * (1.f + x * (0.5f + x * (0.16666667f + x * (0.041666668f + x * (0.0083333338f + x * 0.0013888889f)))));
                    const float em = x > -0.5f ? ser : 1.f - a * a;
                    oa[e] = a; og[e] = sqrtf(em) * (ig * xc[e]); }
                *(f32x4*)(Aout + off + n * 16) = oa; *(f32x4*)(Gout + off + n * 16) = og; } }
    }
};

struct EpiS5Loc {
    static constexpr bool PERM = false, AFTER_DRAIN = false;
    float* SL;
    __device__ __forceinline__ void operator()(const f32x4 (&acc)[2][2][4][2], const Unit& u, int wr, int wc, int fr, int fq) const {
        float* base = SL + ((size_t)u.pm * 256 + wr * 64 + fr) * 128 + wc * 32 + 4 * fq;
#pragma unroll
        for (int ai = 0; ai < 2; ++ai)
#pragma unroll
            for (int m = 0; m < 4; ++m)
#pragma unroll
                for (int n = 0; n < 2; ++n) *(f32x4*)(base + (size_t)(ai * HALF + m * 16) * 128 + n * 16) = acc[ai][0][m][n];
    }
};
__device__ __forceinline__ float gelu_t(float x) { const float uu = 0.7978845608028654f * (x + 0.044715f * x * x * x); const float e = __expf(2.f * uu); return 0.5f * x * (2.f - 2.f / (e + 1.f)); }
struct EpiS5Y {
    static constexpr bool PERM = false, AFTER_DRAIN = false;
    bf16_t* Y;
    __device__ __forceinline__ void operator()(const f32x4 (&acc)[2][2][4][2], const Unit& u, int wr, int wc, int fr, int fq) const {
        const int g = u.pm, half = u.pn & 1;
#pragma unroll
        for (int ai = 0; ai < 2; ++ai)
#pragma unroll
            for (int m = 0; m < 4; ++m) { const int r = ai * HALF + wr * 64 + m * 16 + fr; const size_t mrow = (size_t)(r >> 6) * 2048 + (size_t)(r & 63) * 32;
#pragma unroll
                for (int bj = 0; bj < 2; ++bj)
#pragma unroll
                    for (int n = 0; n < 2; ++n) { const int t = 16 * half + 8 * bj + 2 * wc + n; const f32x4 v = acc[ai][bj][m][n];
                        *(unsigned long long*)(Y + (mrow + t) * 1024 + g * 16 + 4 * fq) = (unsigned long long)cvt_pk_bf16(gelu_t(v[0]), gelu_t(v[1])) | ((unsigned long long)cvt_pk_bf16(gelu_t(v[2]), gelu_t(v[3])) << 32); } }
    }
};
struct S5Order {
    int g, mode;
    __device__ __forceinline__ bool next(int i, Unit& u) const { if (g < 0 || i >= mode) return false; u.pm = g; u.pn = (mode == 1) ? g : 2 * g + i; return true; }
    __device__ __forceinline__ void a_ready(const Unit&) const {}
    __device__ __forceinline__ void done(const Unit&) const {}
};

template <class Epi, class Sched, bool ALIGN_EPI = false, bool SP2 = false>
__device__ __forceinline__ void gemm_phase(PG8_LAS unsigned char* lds, const Gemm g, const Sched& S, const Epi& E) {
    int tid = threadIdx.x; asm volatile("" : "+v"(tid));
    const int wid = __builtin_amdgcn_readfirstlane(tid >> 6), lane = tid & 63, wr = wid >> 2, wc = wid & 3, fr = lane & 15, fq = lane >> 4;
    int K = g.K; asm volatile("" : "+s"(K));
    const int nt = K / BK;
    unsigned voffA[2], voffB[2];
#pragma unroll
    for (int i = 0; i < 2; ++i) { int R, C; stage_rc(tid * 16 + i * 8192, R, C); const int Rb = Epi::PERM ? ((R & ~31) + perm32(R & 31)) : R;
        voffA[i] = (unsigned)(R * g.lda + C) * 2u; voffB[i] = (unsigned)(Rb * g.ldb + C) * 2u; }
    const size_t kstep = (size_t)(BK * 2);
    const size_t hA = (size_t)HALF * g.lda * 2, hB = (size_t)HALF * g.ldb * 2;
    const size_t tA = 2 * hA, tB = 2 * hB; const size_t acs = (size_t)g.a_colstep;
    const unsigned ldsw = (unsigned)wid * 1024u;
    const int aoff = lds_byte(wr * 64 + fr, fq * 8), boff = lds_byte(wc * 32 + fr, fq * 8);
#define PG8_SA(b, h) (((b) * 2 + (h)) * HTB)
#define PG8_SB(b, h) ((4 + (b) * 2 + (h)) * HTB)
#define PG8_STAGE(bufoff, gbase, voff) do { _Pragma("unroll") for (int _i = 0; _i < 2; ++_i) \
        __builtin_amdgcn_global_load_lds((const unsigned*)((const char*)(gbase) + (voff)[_i]), (PG8_LAS unsigned*)(lds + (bufoff) + ldsw + _i * 8192), 16, 0, 0); } while (0)
#define PG8_LDA(dst, b, h) do { _Pragma("unroll") for (int m = 0; m < 4; ++m) _Pragma("unroll") for (int k = 0; k < 2; ++k) dst[m][k] = *(const PG8_LAS bf16x8*)(lds + PG8_SA(b, h) + aoff + m * 2048 + k * 1024); } while (0)
#define PG8_LDB(dst, b, h) do { _Pragma("unroll") for (int n = 0; n < 2; ++n) _Pragma("unroll") for (int k = 0; k < 2; ++k) dst[n][k] = *(const PG8_LAS bf16x8*)(lds + PG8_SB(b, h) + boff + n * 2048 + k * 1024); } while (0)
#define PG8_MMA(ai, bj, At, Bt) do { __builtin_amdgcn_s_setprio(1); _Pragma("unroll") for (int m = 0; m < 4; ++m) _Pragma("unroll") for (int n = 0; n < 2; ++n) _Pragma("unroll") for (int k = 0; k < 2; ++k) \
        acc[ai][bj][m][n] = __builtin_amdgcn_mfma_f32_16x16x32_bf16(Bt[n][k], At[m][k], acc[ai][bj][m][n], 0, 0, 0); __builtin_amdgcn_s_setprio(0); } while (0)
#define PG8_WAIT_V(n) asm volatile("s_waitcnt vmcnt(" #n ")" ::: "memory")
#define PG8_WAIT_L(n) asm volatile("s_waitcnt lgkmcnt(" #n ")" ::: "memory")
#define PG8_BAR __builtin_amdgcn_s_barrier()
#define PG8_SCHED __builtin_amdgcn_sched_barrier(0)
    Unit cur, nxt; int ui = 0;
    if (!S.next(0, cur)) return;
    f32x4 acc[2][2][4][2];
#pragma unroll
    for (int a = 0; a < 2; ++a)
#pragma unroll
        for (int b = 0; b < 2; ++b)
#pragma unroll
            for (int m = 0; m < 4; ++m)
#pragma unroll
                for (int n = 0; n < 2; ++n) acc[a][b][m][n] = (f32x4){0.f, 0.f, 0.f, 0.f};
    bf16x8 At[4][2], B0[2][2], B1[2][2];
    const char* cA = (const char*)g.A + (size_t)cur.pm * tA + (size_t)cur.pn * acs; const char* cB = (const char*)g.Bt + (size_t)cur.pn * tB;
    S.a_ready(cur);
    if constexpr (SP2) {
        PG8_STAGE(PG8_SB(0, 0), cB, voffB); PG8_STAGE(PG8_SB(0, 1), cB + hB, voffB); PG8_STAGE(PG8_SA(0, 0), cA, voffA); PG8_STAGE(PG8_SA(0, 1), cA + hA, voffA);
        if (wr == 1) PG8_BAR;
        PG8_WAIT_V(2); PG8_BAR;
        PG8_STAGE(PG8_SB(1, 0), cB + kstep, voffB); PG8_STAGE(PG8_SA(1, 0), cA + kstep, voffA); PG8_STAGE(PG8_SB(1, 1), cB + hB + kstep, voffB);
        PG8_WAIT_V(6); PG8_BAR;
    } else {
        PG8_STAGE(PG8_SB(0, 0), cB, voffB); PG8_STAGE(PG8_SA(0, 0), cA, voffA); PG8_STAGE(PG8_SB(0, 1), cB + hB, voffB); PG8_STAGE(PG8_SA(0, 1), cA + hA, voffA);
        if (wr == 1) PG8_BAR;
        PG8_WAIT_V(4); PG8_BAR;
        PG8_STAGE(PG8_SB(1, 0), cB + kstep, voffB); PG8_STAGE(PG8_SA(1, 0), cA + kstep, voffA); PG8_STAGE(PG8_SB(1, 1), cB + hB + kstep, voffB);
        PG8_WAIT_V(6); PG8_BAR;
    }
    for (;;) {
        const bool has_next = S.next(ui + 1, nxt);
        const char* nA = has_next ? (const char*)g.A + (size_t)nxt.pm * tA + (size_t)nxt.pn * acs : cA; const char* nB = has_next ? (const char*)g.Bt + (size_t)nxt.pn * tB : cB;
        for (int t = 0; t < nt; t += 2) {
            const bool last = (t == nt - 2);
            const char* a1 = cA + (size_t)(t + 1) * kstep;
            const char* a2 = last ? nA : cA + (size_t)(t + 2) * kstep; const char* b2 = last ? nB : cB + (size_t)(t + 2) * kstep;
            const char* a3 = a2 + kstep; const char* b3 = b2 + kstep;
            if (last && has_next) S.a_ready(nxt);
            if constexpr (SP2) {
            PG8_LDB(B0, 0, 0); PG8_LDB(B1, 0, 1); PG8_SCHED; PG8_LDA(At, 0, 0); PG8_STAGE(PG8_SA(1, 1), a1 + hA, voffA);
            PG8_WAIT_V(8); PG8_WAIT_L(0); PG8_BAR; PG8_MMA(0, 0, At, B0); PG8_MMA(0, 1, At, B1); PG8_BAR; PG8_SCHED;
            PG8_LDA(At, 0, 1); PG8_STAGE(PG8_SB(0, 0), b2, voffB); PG8_STAGE(PG8_SB(0, 1), b2 + hB, voffB); PG8_STAGE(PG8_SA(0, 0), a2, voffA);
            PG8_WAIT_V(8); PG8_WAIT_L(0); PG8_BAR; PG8_MMA(1, 0, At, B0); PG8_MMA(1, 1, At, B1); PG8_BAR; PG8_SCHED;
            PG8_LDB(B0, 1, 0); PG8_LDB(B1, 1, 1); PG8_SCHED; PG8_LDA(At, 1, 0); PG8_STAGE(PG8_SA(0, 1), a2 + hA, voffA);
            PG8_WAIT_V(8); PG8_WAIT_L(0); PG8_BAR; PG8_MMA(0, 0, At, B0); PG8_MMA(0, 1, At, B1); PG8_BAR; PG8_SCHED;
            PG8_LDA(At, 1, 1); PG8_STAGE(PG8_SB(1, 0), b3, voffB); PG8_STAGE(PG8_SB(1, 1), b3 + hB, voffB); PG8_STAGE(PG8_SA(1, 0), a3, voffA);
            PG8_WAIT_V(8); PG8_WAIT_L(0); PG8_BAR; PG8_MMA(1, 0, At, B0); PG8_MMA(1, 1, At, B1); PG8_BAR; PG8_SCHED;
            } else {
            PG8_LDB(B0, 0, 0); PG8_SCHED; PG8_LDA(At, 0, 0); PG8_STAGE(PG8_SA(1, 1), a1 + hA, voffA);
            PG8_WAIT_L(8); PG8_BAR; PG8_WAIT_L(0); PG8_MMA(0, 0, At, B0); PG8_BAR; PG8_SCHED;
            PG8_LDB(B1, 0, 1); PG8_STAGE(PG8_SB(0, 0), b2, voffB);
            PG8_BAR; PG8_WAIT_L(0); PG8_MMA(0, 1, At, B1); PG8_BAR;
            PG8_LDA(At, 0, 1); PG8_STAGE(PG8_SA(0, 0), a2, voffA);
            PG8_BAR; PG8_WAIT_L(0); PG8_MMA(1, 0, At, B0); PG8_BAR; PG8_SCHED;
            PG8_STAGE(PG8_SB(0, 1), b2 + hB, voffB);
            PG8_WAIT_V(6); PG8_BAR; PG8_MMA(1, 1, At, B1); PG8_BAR;
            PG8_LDB(B0, 1, 0); PG8_SCHED; PG8_LDA(At, 1, 0); PG8_STAGE(PG8_SA(0, 1), a2 + hA, voffA);
            PG8_WAIT_L(8); PG8_BAR; PG8_WAIT_L(0); PG8_MMA(0, 0, At, B0); PG8_BAR; PG8_SCHED;
            PG8_LDB(B1, 1, 1); PG8_STAGE(PG8_SB(1, 0), b3, voffB);
            PG8_BAR; PG8_WAIT_L(0); PG8_MMA(0, 1, At, B1); PG8_BAR;
            PG8_LDA(At, 1, 1); PG8_STAGE(PG8_SA(1, 0), a3, voffA);
            PG8_BAR; PG8_WAIT_L(0); PG8_MMA(1, 0, At, B0); PG8_BAR; PG8_SCHED;
            PG8_STAGE(PG8_SB(1, 1), b3 + hB, voffB);
            PG8_WAIT_V(6); PG8_BAR; PG8_MMA(1, 1, At, B1); PG8_BAR;
            }
        }
        if constexpr (ALIGN_EPI) { if (wr == 0) PG8_BAR; }
        PG8_SCHED; asm volatile("" ::: "memory");
        if constexpr (!Epi::AFTER_DRAIN) { int fr2 = fr, fq2 = fq; asm volatile("" : "+v"(fr2), "+v"(fq2));
            E(acc, cur, wr, wc, fr2, fq2); S.done(cur); }
        PG8_SCHED;
        if (!has_next) break;
#pragma unroll
        for (int a = 0; a < 2; ++a)
#pragma unroll
            for (int b = 0; b < 2; ++b)
#pragma unroll
                for (int m = 0; m < 4; ++m)
#pragma unroll
                    for (int n = 0; n < 2; ++n) acc[a][b][m][n] = (f32x4){0.f, 0.f, 0.f, 0.f};
        cur = nxt; cA = nA; cB = nB; ++ui;
        if constexpr (ALIGN_EPI) { if (wr == 1) PG8_BAR; }
    }
    PG8_WAIT_V(0);
    if constexpr (!ALIGN_EPI) { if (wr == 0) PG8_BAR; }
    PG8_BAR;
#undef PG8_SA
#undef PG8_SB
#undef PG8_STAGE
#undef PG8_LDA
#undef PG8_LDB
#undef PG8_MMA
#undef PG8_WAIT_V
#undef PG8_WAIT_L
#undef PG8_BAR
#undef PG8_SCHED
}
}

constexpr int NWAVES = 8;
constexpr int NB = 4, SEQ = 2048, T = NB * SEQ, DM = 4096, BR = 1024, DEPTH = 2;
constexpr int INC = 9552;
constexpr int ZC = 9728;
constexpr int Z_S5U = 0, Z_S5G = 1024, Z_CQ = 2048, Z_CKV = 2816, Z_MG = 3328, Z_GQ = 4352, Z_GK = 4864, Z_GV = 5376, Z_GG = 6400, Z_LU = 7424, Z_LG = 8448, Z_KR = 9472, Z_GLR = 9536;
constexpr int QR = 768, KVR = 512, NH = 8, DQK = 192, DNOPE = 128, DROPE = 64, DV = 128;
constexpr int S5G = 64, S5H = 16, S5P = 64;
constexpr int GH = 4, GDK = 128, GDV = 256;
constexpr float EPS = 1e-6f;

constexpr size_t al256(size_t x) { return (x + 255) & ~(size_t)255; }
constexpr size_t WS_CTL = 0, CTL_ZERO_BYTES = 1u << 20;
constexpr size_t WS_WTIN = CTL_ZERO_BYTES;
constexpr size_t WS_WTOUT = WS_WTIN + (size_t)2 * ZC * DM * 2;
constexpr size_t WS_HB = WS_WTOUT + (size_t)2 * DM * DM * 2;
constexpr size_t WS_Z = WS_HB + (size_t)T * DM * 2;
constexpr size_t WS_XB = WS_Z + (size_t)T * ZC * 2;
constexpr size_t WS_CQB = WS_XB + (size_t)T * DM * 4;
constexpr size_t WS_CKVB = WS_CQB + (size_t)T * QR * 2;
constexpr size_t WS_XCB = WS_CKVB + (size_t)T * KVR * 2;
constexpr size_t WS_YS5B = WS_XCB + (size_t)T * BR * 2;
constexpr size_t WS_WTUQ = WS_YS5B + (size_t)T * BR * 2;
constexpr size_t WS_WTUKV = WS_WTUQ + (size_t)2 * 1536 * QR * 2;
constexpr size_t WS_WTGLU = WS_WTUKV + (size_t)2 * 2048 * KVR * 2;
constexpr size_t WS_WTLRU = WS_WTGLU + (size_t)2 * BR * BR * 2;
constexpr size_t WS_KR = WS_WTLRU + (size_t)2 * 8 * 256 * 1024 * 2;
constexpr size_t WS_Q = WS_KR + (size_t)T * DROPE * 2;
constexpr size_t WS_KN = WS_Q + (size_t)T * NH * DQK * 2;
constexpr size_t WS_V = WS_KN + (size_t)T * BR * 2;
constexpr size_t WS_KVT = WS_V + (size_t)T * BR * 2;
constexpr size_t WS_ST = WS_KVT + (size_t)512 * 256 * 128 * 4;
constexpr size_t WS_QDEC = WS_ST + (size_t)512 * 256 * 128 * 2;
constexpr size_t WS_DEC = WS_QDEC + (size_t)T * 512 * 2;
constexpr size_t WS_XC = WS_DEC + (size_t)512 * 128 * 4;
constexpr size_t WS_RPRE = WS_XC + (size_t)T * BR * 4;
constexpr size_t WS_IPRE = WS_RPRE + (size_t)T * BR * 4;
constexpr size_t WS_HLRU = WS_IPRE + (size_t)T * BR * 4;
constexpr size_t WS_S5O = WS_HLRU + (size_t)T * BR * 4;
constexpr size_t WS_OGLA = WS_S5O + (size_t)T * BR * 4;
constexpr size_t WS_OMLA = WS_OGLA + (size_t)T * BR * 4;
constexpr size_t WS_ROPE = WS_OMLA + (size_t)T * BR * 4;
constexpr size_t WS_LAMB = WS_ROPE + (size_t)T * 64 * 4;
constexpr size_t WS_BBAR = WS_LAMB + (size_t)2 * 64 * 64 * 2 * 4;
constexpr size_t WS_SPL = WS_BBAR + (size_t)2 * 64 * 64 * 16 * 2 * 4;
constexpr size_t WS_S5A = WS_SPL + (size_t)2 * 1024 * 4;
constexpr size_t WS_S5B1 = WS_S5A + (size_t)64 * 256 * 640 * 2;
constexpr size_t WS_S5B2 = WS_S5B1 + (size_t)64 * 256 * 640 * 2;
constexpr size_t WS_S5L = WS_S5B2 + (size_t)64 * 512 * 640 * 2;
constexpr size_t WS_L32 = WS_S5L + (size_t)64 * 256 * 128 * 4;
constexpr size_t WS_END = WS_L32 + (size_t)64 * 64 * 2 * 4;
static_assert(WS_END <= 1251999744ull, "d_ws map exceeds the guaranteed workspace");

constexpr int RING_OFF = 0, RING_BYTES = 131072;
constexpr int LDSCTL_OFF = RING_BYTES, MISC_OFF = LDSCTL_OFF + 320;
constexpr int LDS_BYTES = 147456;

#define GAS __attribute__((address_space(1)))
#define LAS __attribute__((address_space(3)))
typedef unsigned short bf16;
typedef unsigned v4u __attribute__((ext_vector_type(4)));
typedef float f32x4 __attribute__((ext_vector_type(4)));
typedef GAS unsigned gu32;
#define RLX_AGENT __ATOMIC_RELAXED, __HIP_MEMORY_SCOPE_AGENT
#define LDS_WAIT() asm volatile("s_waitcnt lgkmcnt(0)" ::: "memory")
__device__ __forceinline__ unsigned f2bf(float f) { unsigned u = __builtin_bit_cast(unsigned, f); return (u + 0x7fffu + ((u >> 16) & 1u)) >> 16; }
__device__ __forceinline__ unsigned pk2(float lo, float hi) { return f2bf(lo) | (f2bf(hi) << 16); }
__device__ __forceinline__ float bf2f(bf16 v) { return __uint_as_float((unsigned)v << 16); }
__device__ __forceinline__ f32x4 z4(const bf16* p) { const unsigned long long w = *(const unsigned long long*)p; const unsigned a = (unsigned)w, b = (unsigned)(w >> 32); return (f32x4){__uint_as_float(a << 16), __uint_as_float(a & 0xffff0000u), __uint_as_float(b << 16), __uint_as_float(b & 0xffff0000u)}; }

#define XB_TMO      128
#define XB_XCNT(j)  (256  + 64 * (j))
#define XB_XSUB(j)  (1280 + 64 * (j))
#define XB_XGEN(j)  (2304 + 64 * (j))
#define XB_TOP      3328
#define XB_TOPGEN   3392
#define XCD_BAR_WORDS 3456
#define XB_SPIN_CAP (1u << 23)
__device__ __forceinline__ unsigned xb_ld(unsigned* p)              { return __hip_atomic_load(p, __ATOMIC_RELAXED, __HIP_MEMORY_SCOPE_AGENT); }
__device__ __forceinline__ unsigned xb_add(unsigned* p, unsigned v) { return __hip_atomic_fetch_add(p, v, __ATOMIC_RELAXED, __HIP_MEMORY_SCOPE_AGENT); }
__device__ __forceinline__ unsigned xb_xcc_id() { return (unsigned)__builtin_amdgcn_s_getreg((3 << 11) | 20) & 0xFu; }
#define XB_SPIN(cond, bar) do { unsigned _sp = 0; while (cond) { __builtin_amdgcn_s_sleep(1); \
    if ((++_sp & 255u) == 0u) { if (xb_ld(&(bar)[XB_TMO])) break; if (_sp > XB_SPIN_CAP) { atomicAdd(&(bar)[XB_TMO], 1u); break; } } } } while (0)
struct XcdBarrier { unsigned* bar; unsigned x; volatile LAS unsigned* st; };
__device__ __forceinline__ XcdBarrier xcd_barrier_post(unsigned* bar, volatile LAS unsigned* st) {
    XcdBarrier b; b.bar = bar; b.x = xb_xcc_id(); b.st = st;
    if (threadIdx.x == 0) (void)xb_add(&bar[XB_XCNT(b.x)], 1u);
    return b;
}
__device__ __forceinline__ void xcd_barrier_complete(unsigned* bar, unsigned x, unsigned& nloc, unsigned& nx) {
    const unsigned G = gridDim.x * gridDim.y * gridDim.z;
    unsigned sum, cnt, mine, sp = 0u;
    for (;;) {
        sum = 0u; cnt = 0u; mine = 0u;
#pragma unroll
        for (unsigned j = 0; j < 16; ++j) { const unsigned c = xb_ld(&bar[XB_XCNT(j)]); sum += c; cnt += (c > 0u) ? 1u : 0u; mine = (j == x) ? c : mine; }
        if (sum == G) break;
        __builtin_amdgcn_s_sleep(1);
        if ((++sp & 255u) == 0u) { if (xb_ld(&bar[XB_TMO])) break; if (sp > XB_SPIN_CAP) { atomicAdd(&bar[XB_TMO], 1u); break; } }
    }
    nloc = mine > 0u ? mine : 1u; nx = cnt > 0u ? cnt : 1u;
}
__device__ __forceinline__ void xcd_barrier(const XcdBarrier& b) {
    asm volatile("s_waitcnt vmcnt(0)" ::: "memory");
    __syncthreads();
    if (threadIdx.x == 0) {
        unsigned* bar = b.bar;
        __builtin_amdgcn_s_waitcnt(0);
        unsigned nloc = b.st[0], nx = b.st[1];
        if (nloc == 0u) { xcd_barrier_complete(bar, b.x, nloc, nx); b.st[0] = nloc; b.st[1] = nx; }
        const unsigned old = xb_add(&bar[XB_XSUB(b.x)], 1u);
        const unsigned gen = old / nloc;
        if (old + 1u == (gen + 1u) * nloc) {
            __builtin_amdgcn_fence(__ATOMIC_RELEASE, "agent");
            asm volatile("s_waitcnt vmcnt(0)" ::: "memory");
            const unsigned og = xb_add(&bar[XB_TOP], 1u);
            const unsigned tg = og / nx;
            if (og + 1u == (tg + 1u) * nx) xb_add(&bar[XB_TOPGEN], 1u);
            else XB_SPIN(xb_ld(&bar[XB_TOPGEN]) == tg, bar);
            __builtin_amdgcn_fence(__ATOMIC_ACQUIRE, "agent");
            xb_add(&bar[XB_XGEN(b.x)], 1u);
            asm volatile("s_waitcnt vmcnt(0)" ::: "memory");
        } else {
            XB_SPIN(xb_ld(&bar[XB_XGEN(b.x)]) == gen, bar);
            __builtin_amdgcn_fence(__ATOMIC_ACQUIRE, "agent");
            asm volatile("s_waitcnt vmcnt(0)" ::: "memory");
        }
    }
    __syncthreads();
}

struct Args { const void* in[34]; float* out; unsigned char* ws; int ph_lo, ph_hi; };
struct Frame {
    LAS unsigned char* lds;
    unsigned char* ldsg;
    int vcu, G;
};
typedef const __attribute__((address_space(4))) Args* ArgsP;
#define IN_F(i) ((const float*)AP->in[i])
#define PHASE_IDS() int tid = threadIdx.x; asm volatile("" : "+v"(tid)); const int lane = tid & 63; const int wave = __builtin_amdgcn_readfirstlane(tid >> 6); (void)lane; (void)wave; \
    ArgsP AP = (ArgsP)__builtin_amdgcn_kernarg_segment_ptr(); asm volatile("" : "+s"(AP))
#define WSF(off) ((float*)(AP->ws + (off)))

__device__ __forceinline__ float wave_sum(float v) {
#pragma unroll
    for (int o = 1; o < 64; o <<= 1) v += __shfl_xor(v, o);
    return v;
}
__device__ __forceinline__ float wave_max(float v) {
#pragma unroll
    for (int o = 1; o < 64; o <<= 1) v = fmaxf(v, __shfl_xor(v, o));
    return v;
}
__device__ __forceinline__ float sigmoidf_(float x) { return 1.0f / (1.0f + __expf(-x)); }
__device__ __forceinline__ float siluf_(float x) { return x * sigmoidf_(x); }
__device__ __forceinline__ float softplusf_(float x) { return fmaxf(x, 0.f) + log1pf(__expf(-fabsf(x))); }
__device__ __forceinline__ float gelu_tanh(float x) { const float u = 0.7978845608028654f * (x + 0.044715f * x * x * x); const float e = __expf(2.f * u); const float th = 1.f - 2.f / (e + 1.f); return 0.5f * x * (1.f + th); }

__device__ __forceinline__ int zc_src(int n) {
    if (n < 3328) return n; if (n < 6400) return n + 64; if (n < 9472) return n + 80; if (n < 9536) return n - 9472 + 3328; if (n < 9552) return n - 9536 + 6464; return -1;
}
template <bool MAPPED>
__device__ __forceinline__ void p0_transpose_item(const float* W, int K, int Nsrc, int Ndst, bf16* WT, LAS float* scr, int item, int lane, int ldw = 0) {
    if (ldw == 0) ldw = K;
    const int nblk = Ndst / 32, kb = item / nblk, nb = item % nblk, k0 = 64 * kb, n0 = 32 * nb;
    const int nd = n0 + (lane & 31); const int ns = MAPPED ? zc_src(nd) : nd;
#pragma unroll 8
    for (int i = 0; i < 32; ++i) { const int kk = 2 * i + (lane >> 5); scr[kk * 33 + (lane & 31)] = ns >= 0 ? W[(size_t)(k0 + kk) * Nsrc + ns] : 0.f; }
    LDS_WAIT(); asm volatile("" ::: "memory");
    const int c = lane & 7;
#pragma unroll
    for (int j = 0; j < 4; ++j) { const int n = (lane >> 3) + 8 * j; const LAS float* s = scr + (8 * c) * 33 + n;
        v4u o; o.x = pk2(s[0 * 33], s[1 * 33]); o.y = pk2(s[2 * 33], s[3 * 33]); o.z = pk2(s[4 * 33], s[5 * 33]); o.w = pk2(s[6 * 33], s[7 * 33]);
        *(GAS v4u*)(WT + (size_t)(n0 + n) * ldw + k0 + 8 * c) = o; }
    LDS_WAIT(); asm volatile("" ::: "memory");
}
template <bool TOBF>
__device__ __forceinline__ void rms_row(const float* xrow, const float* g, void* orow, int lane) {
    const f32x4* xr = (const f32x4*)xrow + lane; const f32x4* gr = (const f32x4*)g + lane;
    f32x4 v[16]; float s = 0.f;
#pragma unroll
    for (int j = 0; j < 16; ++j) { v[j] = xr[64 * j]; s += (v[j].x * v[j].x + v[j].y * v[j].y) + (v[j].z * v[j].z + v[j].w * v[j].w); }
    const float rs = 1.0f / sqrtf(wave_sum(s) * (1.f / DM) + EPS);
#pragma unroll
    for (int j = 0; j < 16; ++j) { const f32x4 gg = gr[64 * j]; const f32x4 o = v[j] * rs * gg;
        if (TOBF) ((unsigned long long*)orow)[lane + 64 * j] = (unsigned long long)pk2(o.x, o.y) | ((unsigned long long)pk2(o.z, o.w) << 32);
        else ((f32x4*)orow)[lane + 64 * j] = o; }
}

__device__ __forceinline__ void p0_prologue(Frame& F) {
    PHASE_IDS();
    LAS float* scr = (LAS float*)(F.lds + RING_OFF + wave * 16384);
    const int gw = F.vcu * NWAVES + wave, NGW = F.G * NWAVES;
    constexpr int I_IN = (DM / 64) * (ZC / 32), I_OUT = (DM / 64) * (DM / 32);
    constexpr int I_UQ = (QR / 64) * (1536 / 32), I_UK = (KVR / 64) * (BR / 32), I_GLU = (BR / 64) * (BR / 32), I_LRU = 2 * 4;
    constexpr int NSMALL = 2 * (I_UQ + 2 * I_UK + I_GLU + 16 * I_LRU);
    constexpr int NITEMS = 2 * I_IN + 2 * I_OUT + NSMALL;
    for (int it = gw; it < NITEMS; it += NGW) {
        int r = it;
        if (r < NSMALL) { const int l = r / (NSMALL / 2); r -= l * (NSMALL / 2);
            if (r < I_UQ) { p0_transpose_item<false>(IN_F(17) + (size_t)l * QR * 1536, QR, 1536, 1536, (bf16*)(AP->ws + WS_WTUQ) + (size_t)l * 1536 * QR, scr, r, lane); continue; } r -= I_UQ;
            if (r < I_UK) { p0_transpose_item<false>(IN_F(18) + (size_t)l * KVR * BR, KVR, BR, BR, (bf16*)(AP->ws + WS_WTUKV) + (size_t)l * 2048 * KVR, scr, r, lane); continue; } r -= I_UK;
            if (r < I_UK) { p0_transpose_item<false>(IN_F(19) + (size_t)l * KVR * BR, KVR, BR, BR, (bf16*)(AP->ws + WS_WTUKV) + ((size_t)l * 2048 + 1024) * KVR, scr, r, lane); continue; } r -= I_UK;
            if (r < I_GLU) { p0_transpose_item<false>(IN_F(12) + (size_t)l * BR * BR, BR, BR, BR, (bf16*)(AP->ws + WS_WTGLU) + (size_t)l * BR * BR, scr, r, lane); continue; } r -= I_GLU;
            { const int jj = r / I_LRU, gate = jj & 1, j = jj >> 1; r -= jj * I_LRU;
              p0_transpose_item<false>(IN_F(gate ? 28 : 26) + (size_t)(l * 8 + j) * 128 * 128, 128, 128, 128, (bf16*)(AP->ws + WS_WTLRU) + ((size_t)(l * 8 + j) * 256 + gate * 128) * 1024, scr, r, lane, 1024); continue; }
        }
        r -= NSMALL;
        if (r < 2 * I_IN) { const int l = r / I_IN; r -= l * I_IN;
            p0_transpose_item<true>(IN_F(3) + (size_t)l * DM * INC, DM, INC, ZC, (bf16*)(AP->ws + WS_WTIN) + (size_t)l * ZC * DM, scr, r, lane); continue; }
        r -= 2 * I_IN; { const int l = r / I_OUT; r -= l * I_OUT;
            p0_transpose_item<false>(IN_F(32) + (size_t)l * DM * DM, DM, DM, DM, (bf16*)(AP->ws + WS_WTOUT) + (size_t)l * DM * DM, scr, r, lane); }
    }
    { const int* pos = (const int*)AP->in[1]; float* rt = WSF(WS_ROPE);
      for (int e = blockIdx.x * 512 + tid; e < T * 32; e += F.G * 512) { const int m = e >> 5, i = e & 31;
          const double invf = exp(-(double)i * (9.210340371976184 / 32.0));
          double ang = (double)pos[m] * invf; const double k = rint(ang * 0.15915494309189535); ang -= k * 6.283185307179586;
          const float a = (float)ang; rt[m * 64 + i] = cosf(a); rt[m * 64 + 32 + i] = sinf(a); } }
    { float* lb = WSF(WS_LAMB); float* bb = WSF(WS_BBAR);
      for (int e = blockIdx.x * 512 + tid; e < 2 * 64 * 64; e += F.G * 512) { const int l = e >> 12, g = (e >> 6) & 63;
          const float lre = IN_F(4)[e], lim = IN_F(5)[e]; const float dt = expf(IN_F(11)[l * 64 + g]);
          const float mag = expf(lre * dt); float sn, cs; sincosf(lim * dt, &sn, &cs);
          const float bre = mag * cs, bim = mag * sn; lb[2 * e] = bre; lb[2 * e + 1] = bim;
          const float nre = bre - 1.f, nim = bim, den = 1.f / (lre * lre + lim * lim);
          const float fre = (nre * lre + nim * lim) * den, fim = (nim * lre - nre * lim) * den;
          for (int h = 0; h < 16; ++h) { const float br = IN_F(6)[e * 16 + h], bi = IN_F(7)[e * 16 + h];
              bb[(e * 16 + h) * 2] = fre * br - fim * bi; bb[(e * 16 + h) * 2 + 1] = fre * bi + fim * br; } } }
    for (int e = blockIdx.x * 512 + tid; e < 2 * BR; e += F.G * 512) WSF(WS_SPL)[e] = softplusf_(-IN_F(30)[e]);
    for (int m = gw; m < T; m += NGW) { asm volatile("" ::: "memory");  rms_row<true>(IN_F(0) + (size_t)m * DM, IN_F(2), (bf16*)(AP->ws + WS_HB) + (size_t)m * DM, lane); }
}

__device__ __forceinline__ void p2_rows(Frame& F, int l) {
    PHASE_IDS();
    const int gw = F.vcu * NWAVES + wave, NGW = F.G * NWAVES;
    const bf16* z = (const bf16*)(AP->ws + WS_Z);
    for (int m = gw; m < T; m += NGW) {
        asm volatile("" ::: "memory");
        const bf16* zr = z + (size_t)m * ZC;
        { float v[12]; float s = 0.f;
#pragma unroll
          for (int j = 0; j < 12; ++j) { v[j] = bf2f(zr[Z_CQ + lane + 64 * j]); s += v[j] * v[j]; }
          const float rs = 1.0f / sqrtf(wave_sum(s) * (1.f / QR) + EPS);
#pragma unroll
          for (int j = 0; j < 12; ++j) ((bf16*)(AP->ws + WS_CQB))[(size_t)m * QR + lane + 64 * j] = (bf16)f2bf(v[j] * rs * IN_F(15)[l * QR + lane + 64 * j]); }
        { float v[8]; float s = 0.f;
#pragma unroll
          for (int j = 0; j < 8; ++j) { v[j] = bf2f(zr[Z_CKV + lane + 64 * j]); s += v[j] * v[j]; }
          const float rs = 1.0f / sqrtf(wave_sum(s) * (1.f / KVR) + EPS);
#pragma unroll
          for (int j = 0; j < 8; ++j) ((bf16*)(AP->ws + WS_CKVB))[(size_t)m * KVR + lane + 64 * j] = (bf16)f2bf(v[j] * rs * IN_F(16)[l * KVR + lane + 64 * j]); }
        if (lane < 32) { const float x1 = bf2f(zr[Z_KR + lane]), x2 = bf2f(zr[Z_KR + 32 + lane]); const float c = WSF(WS_ROPE)[m * 64 + lane], s = WSF(WS_ROPE)[m * 64 + 32 + lane];
            ((bf16*)(AP->ws + WS_KR))[m * 64 + lane] = (bf16)f2bf(x1 * c - x2 * s); ((bf16*)(AP->ws + WS_KR))[m * 64 + 32 + lane] = (bf16)f2bf(x2 * c + x1 * s); }
        { const int t = m & (SEQ - 1);
#pragma unroll 1
          for (int j = 0; j < 16; ++j) { const int c = lane + 64 * j; float a = IN_F(25)[l * BR + c];
#pragma unroll
              for (int w = 0; w < 4; ++w) { const int tt = t - 3 + w; if (tt >= 0) a += IN_F(24)[(l * 4 + w) * BR + c] * bf2f(z[(size_t)(m - 3 + w) * ZC + Z_LU + c]); }
              WSF(WS_XC)[(size_t)m * BR + c] = a; ((bf16*)(AP->ws + WS_XCB))[(size_t)m * BR + c] = (bf16)f2bf(a); } }
    }
}
__device__ __forceinline__ void s5_prep(Frame& F, int l, int g) {
    PHASE_IDS();
    LAS unsigned char* L = F.lds + RING_OFF;
    LAS float* PW = (LAS float*)L;
    LAS float* BB = PW + 33 * 128;
    LAS float* CC = BB + 2048;
    LAS float* KK = CC + 2048;
    const int lg = l * 64 + g;
    __syncthreads();
    for (int idx = tid; idx < 33 * 64; idx += 512) { const int tau = idx >> 6, p = idx & 63;
        const float lre = IN_F(4)[lg * 64 + p], lim = IN_F(5)[lg * 64 + p], dt = expf(IN_F(11)[lg]);
        const float mag = expf((float)tau * lre * dt); float sn, cs; sincosf((float)tau * lim * dt, &sn, &cs);
        PW[idx * 2] = mag * cs; PW[idx * 2 + 1] = mag * sn;
        if (tau == 32) { WSF(WS_L32)[(g * 64 + p) * 2] = mag * cs; WSF(WS_L32)[(g * 64 + p) * 2 + 1] = mag * sn; } }
    for (int idx = tid; idx < 1024; idx += 512) { BB[idx * 2] = WSF(WS_BBAR)[((size_t)lg * 1024 + idx) * 2]; BB[idx * 2 + 1] = WSF(WS_BBAR)[((size_t)lg * 1024 + idx) * 2 + 1];
        CC[idx * 2] = IN_F(8)[(size_t)lg * 1024 + idx]; CC[idx * 2 + 1] = IN_F(9)[(size_t)lg * 1024 + idx]; }
    __syncthreads();
    {
      const int tau = tid >> 4, h = tid & 15; float acc[16];
#pragma unroll
      for (int j = 0; j < 16; ++j) acc[j] = 0.f;
      for (int p = 0; p < 64; ++p) { const float cr = CC[(h * 64 + p) * 2], ci = CC[(h * 64 + p) * 2 + 1], pr = PW[(tau * 64 + p) * 2], pi = PW[(tau * 64 + p) * 2 + 1];
          const float xr = cr * pr - ci * pi, xi = cr * pi + ci * pr;
#pragma unroll
          for (int j = 0; j < 16; ++j) acc[j] += xr * BB[(p * 16 + j) * 2] - xi * BB[(p * 16 + j) * 2 + 1]; }
      if (tau == 0) acc[h] += IN_F(10)[lg * 16 + h];
#pragma unroll
      for (int j = 0; j < 16; ++j) KK[tau * 256 + h * 16 + j] = acc[j]; }
    __syncthreads();
    bf16* B2 = (bf16*)(AP->ws + WS_S5B2) + (size_t)g * 512 * 640; bf16* B1 = (bf16*)(AP->ws + WS_S5B1) + (size_t)g * 256 * 640;
    for (int idx = tid; idx < 512 * 80; idx += 512) { const int R = idx / 80, ch = idx - R * 80, t = R >> 4, h = R & 15; float v[8];
        if (ch < 64) { const int sidx = ch >> 1, h0 = (ch & 1) * 8;
#pragma unroll
            for (int j = 0; j < 8; ++j) v[j] = (t >= sidx) ? KK[(t - sidx) * 256 + h * 16 + h0 + j] : 0.f; }
        else { const int q = ch - 64;
#pragma unroll
            for (int j = 0; j < 8; j += 2) { const int p = 4 * q + (j >> 1); const float cr = CC[(h * 64 + p) * 2], ci = CC[(h * 64 + p) * 2 + 1], pr = PW[((t + 1) * 64 + p) * 2], pi = PW[((t + 1) * 64 + p) * 2 + 1];
                v[j] = cr * pr - ci * pi; v[j + 1] = -(cr * pi + ci * pr); } }
        *(v4u*)(B2 + (size_t)R * 640 + ch * 8) = (v4u){pk2(v[0], v[1]), pk2(v[2], v[3]), pk2(v[4], v[5]), pk2(v[6], v[7])}; }
    for (int idx = tid; idx < 128 * 64; idx += 512) { const int R = idx >> 6, ch = idx & 63, p = R >> 1, ri = R & 1, sidx = ch >> 1, h0 = (ch & 1) * 8; float v[8];
        const float pr = PW[((31 - sidx) * 64 + p) * 2], pi = PW[((31 - sidx) * 64 + p) * 2 + 1];
#pragma unroll
        for (int j = 0; j < 8; ++j) { const float br = BB[(p * 16 + h0 + j) * 2], bi = BB[(p * 16 + h0 + j) * 2 + 1]; v[j] = ri ? (pr * bi + pi * br) : (pr * br - pi * bi); }
        *(v4u*)(B1 + (size_t)R * 640 + ch * 8) = (v4u){pk2(v[0], v[1]), pk2(v[2], v[3]), pk2(v[4], v[5]), pk2(v[6], v[7])}; }
    __syncthreads();
}
__device__ __forceinline__ void s5_stage(Frame& F) {
    PHASE_IDS();
    const int gw = F.vcu * NWAVES + wave, NGW = F.G * NWAVES;
    const bf16* z = (const bf16*)(AP->ws + WS_Z); bf16* A = (bf16*)(AP->ws + WS_S5A);
    for (int it = gw; it < 64 * 256; it += NGW) { const int g = it & 63, r = it >> 6, sidx = lane >> 1, hf = lane & 1;
        const size_t m = (size_t)(r >> 6) * 2048 + (size_t)(r & 63) * 32 + sidx;
        *(v4u*)(A + ((size_t)g * 256 + r) * 640 + sidx * 16 + hf * 8) = *(const v4u*)(z + m * ZC + Z_S5U + g * 16 + hf * 8); }
}
__device__ __forceinline__ void s5_scan(Frame& F, int g) {
    PHASE_IDS();
    asm volatile("s_waitcnt vmcnt(0)" ::: "memory"); __syncthreads();
    if (tid < 256) { const int b = tid >> 6, p = tid & 63; const float lr = WSF(WS_L32)[(g * 64 + p) * 2], li = WSF(WS_L32)[(g * 64 + p) * 2 + 1];
        const float* sl = WSF(WS_S5L) + ((size_t)g * 256 + b * 64) * 128 + 2 * p; bf16* A = (bf16*)(AP->ws + WS_S5A) + ((size_t)g * 256 + b * 64) * 640 + 512 + 2 * p;
        float xr = 0.f, xi = 0.f;
#pragma unroll 8
        for (int c = 0; c < 64; ++c) { *(unsigned*)(A + (size_t)c * 640) = pk2(xr, xi); const float sr = sl[(size_t)c * 128], si = sl[(size_t)c * 128 + 1];
            const float nr = lr * xr - li * xi + sr, ni = lr * xi + li * xr + si; xr = nr; xi = ni; } }
    asm volatile("s_waitcnt vmcnt(0)" ::: "memory"); __syncthreads();
}
typedef short bf16x8_t __attribute__((ext_vector_type(8)));
typedef float f32x16_t __attribute__((ext_vector_type(16)));
typedef short s16x4_t __attribute__((ext_vector_type(4)));
typedef unsigned u32x4_t __attribute__((ext_vector_type(4)));
__device__ __forceinline__ unsigned cvtpk_s(float lo, float hi) { typedef float f2 __attribute__((ext_vector_type(2))); typedef __bf16 b2 __attribute__((ext_vector_type(2))); f2 v = {lo, hi}; b2 b = __builtin_convertvector(v, b2); return __builtin_bit_cast(unsigned, b); }
constexpr int G1_LA = 0, G1_QD = 32768, G1_QSTR = 272, G1_KI = G1_QD + 64 * G1_QSTR, G1_KD = G1_KI + 64 * G1_QSTR, G1_KDSTR = 320, G1_V = G1_KD + 64 * G1_KDSTR, G1_VSTR = 576, G1_GL = G1_V + 64 * G1_VSTR;
static_assert(G1_GL + 4096 <= RING_BYTES, "GLA LDS map");
__device__ __forceinline__ bf16x8_t tr_frag(const LAS unsigned char* p, int hi_off) {
    const s16x4_t lo = __builtin_bit_cast(s16x4_t, __builtin_amdgcn_ds_read_tr16_b64_v4i16((LAS s16x4_t*)p));
    const s16x4_t hi = __builtin_bit_cast(s16x4_t, __builtin_amdgcn_ds_read_tr16_b64_v4i16((LAS s16x4_t*)(p + hi_off)));
    return (bf16x8_t){lo[0], lo[1], lo[2], lo[3], hi[0], hi[1], hi[2], hi[3]};
}
__device__ __forceinline__ void gla_g1(Frame& F, int l) {
    PHASE_IDS();
    const int hh = lane >> 5, r32 = lane & 31;
    LAS unsigned char* L = F.lds + RING_OFF;
    LAS float* LA = (LAS float*)(L + G1_LA); LAS float* GL = (LAS float*)(L + G1_GL);
    const bf16* z = (const bf16*)(AP->ws + WS_Z);
    for (int u = F.vcu; u < 512; u += F.G) {
        const int bh = u >> 5, n = u & 31, b = bh >> 2, h = bh & 3;
        const size_t m0 = (size_t)b * SEQ + 64 * n;
        __syncthreads();
        if (tid < 256) { const int row = tid >> 2, c4 = (tid & 3) * 4; *(LAS f32x4*)(GL + row * 16 + c4) = z4(z + (m0 + row) * ZC + Z_GLR + c4); }
#pragma unroll
        for (int r = 0; r < 8; ++r) { const int idx = tid + 512 * r, row = idx >> 6, c4 = (idx & 63) * 4; const f32x4 v = z4(z + (m0 + row) * ZC + Z_GV + h * 256 + c4);
            *(LAS unsigned long long*)(L + G1_V + row * G1_VSTR + c4 * 2) = (unsigned long long)cvtpk_s(v.x, v.y) | ((unsigned long long)cvtpk_s(v.z, v.w) << 32); }
        __syncthreads();
        const int c = tid >> 3, d0 = (tid & 7) * 16;
        {
          float a[16];
#pragma unroll
          for (int e4 = 0; e4 < 4; ++e4) { const f32x4 bv = *(const f32x4*)(IN_F(22) + l * 512 + h * 128 + d0 + 4 * e4); a[4 * e4] = bv.x; a[4 * e4 + 1] = bv.y; a[4 * e4 + 2] = bv.z; a[4 * e4 + 3] = bv.w; }
#pragma unroll 4
          for (int r = 0; r < 16; ++r) { const float g = GL[c * 16 + r]; const float* wp = IN_F(21) + (size_t)(l * 16 + r) * 512 + h * 128 + d0;
#pragma unroll
              for (int e4 = 0; e4 < 4; ++e4) { const f32x4 w = *(const f32x4*)(wp + 4 * e4); a[4 * e4] += g * w.x; a[4 * e4 + 1] += g * w.y; a[4 * e4 + 2] += g * w.z; a[4 * e4 + 3] += g * w.w; } }
#pragma unroll
          for (int e4 = 0; e4 < 4; ++e4) { f32x4 o;
#pragma unroll
              for (int e = 0; e < 4; ++e) o[e] = -softplusf_(-a[4 * e4 + e]) * (1.f / 16.f);
              *(LAS f32x4*)(LA + c * 128 + d0 + 4 * e4) = o; } }
        __syncthreads();
        {
          const int col = tid & 127, seg = tid >> 7; float v[16]; float run = 0.f;
#pragma unroll
          for (int i = 0; i < 16; ++i) { run += LA[(16 * seg + i) * 128 + col]; v[i] = run; }
          GL[seg * 128 + col] = run;
          __syncthreads();
          float pre = 0.f;
#pragma unroll
          for (int s2 = 0; s2 < 3; ++s2) pre += (s2 < seg) ? GL[s2 * 128 + col] : 0.f;
#pragma unroll
          for (int i = 0; i < 16; ++i) LA[(16 * seg + i) * 128 + col] = v[i] + pre; }
        __syncthreads();
        {
          const bf16* qp = z + (m0 + c) * ZC + Z_GQ + h * 128 + d0; const bf16* kp = z + (m0 + c) * ZC + Z_GK + h * 128 + d0;
          bf16* qg = (bf16*)(AP->ws + WS_QDEC) + (m0 + c) * 512 + h * 128 + d0;
#pragma unroll
          for (int e4 = 0; e4 < 4; ++e4) { const f32x4 q4 = z4(qp + 4 * e4), k4 = z4(kp + 4 * e4); const f32x4 cu = *(const LAS f32x4*)(LA + c * 128 + d0 + 4 * e4), to = *(const LAS f32x4*)(LA + 63 * 128 + d0 + 4 * e4);
              float qd[4], ki[4], kd[4];
#pragma unroll
              for (int e = 0; e < 4; ++e) { const float ec = __expf(cu[e]), ei = 1.f / ec, et = __expf(to[e]); qd[e] = q4[e] * 0.08838834764831845f * ec; ki[e] = k4[e] * ei; kd[e] = ki[e] * et; }
              const unsigned long long qw = (unsigned long long)cvtpk_s(qd[0], qd[1]) | ((unsigned long long)cvtpk_s(qd[2], qd[3]) << 32);
              *(LAS unsigned long long*)(L + G1_QD + c * G1_QSTR + (d0 + 4 * e4) * 2) = qw; *(unsigned long long*)(qg + 4 * e4) = qw;
              *(LAS unsigned long long*)(L + G1_KI + c * G1_QSTR + (d0 + 4 * e4) * 2) = (unsigned long long)cvtpk_s(ki[0], ki[1]) | ((unsigned long long)cvtpk_s(ki[2], ki[3]) << 32);
              *(LAS unsigned long long*)(L + G1_KD + c * G1_KDSTR + (d0 + 4 * e4) * 2) = (unsigned long long)cvtpk_s(kd[0], kd[1]) | ((unsigned long long)cvtpk_s(kd[2], kd[3]) << 32); }
          if (tid < 128) WSF(WS_DEC)[u * 128 + tid] = __expf(LA[63 * 128 + tid]); }
        __syncthreads();
        { const int cb = wave & 1, dvg = wave >> 1;
          f32x16_t S0, S1;
#pragma unroll
          for (int r = 0; r < 16; ++r) { S0[r] = 0.f; S1[r] = 0.f; }
          const LAS unsigned char* qa = L + G1_QD + (32 * cb + r32) * G1_QSTR + hh * 16; const LAS unsigned char* ka = L + G1_KI + r32 * G1_QSTR + hh * 16;
#pragma unroll
          for (int ks = 0; ks < 8; ++ks) { const bf16x8_t qf = *(const LAS bf16x8_t*)(qa + ks * 32);
              S0 = __builtin_amdgcn_mfma_f32_32x32x16_bf16(*(const LAS bf16x8_t*)(ka + ks * 32), qf, S0, 0, 0, 0);
              if (cb) S1 = __builtin_amdgcn_mfma_f32_32x32x16_bf16(*(const LAS bf16x8_t*)(ka + 32 * G1_QSTR + ks * 32), qf, S1, 0, 0, 0); }
#pragma unroll
          for (int r = 0; r < 16; ++r) { const int sl = (r & 3) + 8 * (r >> 2) + 4 * hh; if (sl > r32) { if (cb) S1[r] = 0.f; else S0[r] = 0.f; } }
          bf16x8_t pf[2][2];
#pragma unroll
          for (int s2 = 0; s2 < 2; ++s2) { u32x4_t a, c2;
#pragma unroll
              for (int w = 0; w < 4; ++w) { a[w] = cvtpk_s(S0[8 * s2 + 2 * w], S0[8 * s2 + 2 * w + 1]); c2[w] = cvtpk_s(S1[8 * s2 + 2 * w], S1[8 * s2 + 2 * w + 1]); }
              pf[0][s2] = __builtin_bit_cast(bf16x8_t, a); pf[1][s2] = __builtin_bit_cast(bf16x8_t, c2); }
          const LAS unsigned char* va = L + G1_V + (4 * hh + ((lane & 15) >> 2)) * G1_VSTR + (64 * dvg + ((lane >> 4) & 1) * 16 + (lane & 3) * 4) * 2;
          float* op = WSF(WS_OGLA) + (m0 + 32 * cb + r32) * BR + h * 256 + 64 * dvg + 4 * hh;
#pragma unroll
          for (int dvb = 0; dvb < 2; ++dvb) { f32x16_t O;
#pragma unroll
              for (int r = 0; r < 16; ++r) O[r] = 0.f;
#pragma unroll
              for (int s2 = 0; s2 < 2; ++s2) { O = __builtin_amdgcn_mfma_f32_32x32x16_bf16(tr_frag(va + (16 * s2) * G1_VSTR + dvb * 64, 8 * G1_VSTR), pf[0][s2], O, 0, 0, 0);
                  if (cb) O = __builtin_amdgcn_mfma_f32_32x32x16_bf16(tr_frag(va + (32 + 16 * s2) * G1_VSTR + dvb * 64, 8 * G1_VSTR), pf[1][s2], O, 0, 0, 0); }
#pragma unroll
              for (int cq = 0; cq < 4; ++cq) *(f32x4*)(op + 32 * dvb + 8 * cq) = (f32x4){O[4 * cq], O[4 * cq + 1], O[4 * cq + 2], O[4 * cq + 3]}; } }
        { f32x16_t KV[4];
#pragma unroll
          for (int j = 0; j < 4; ++j)
#pragma unroll
              for (int r = 0; r < 16; ++r) KV[j][r] = 0.f;
          const int rowl = 8 * hh + ((lane & 15) >> 2), coll = ((lane >> 4) & 1) * 16 + (lane & 3) * 4;
          const LAS unsigned char* va = L + G1_V + rowl * G1_VSTR + (32 * wave + coll) * 2; const LAS unsigned char* ka = L + G1_KD + rowl * G1_KDSTR + coll * 2;
#pragma unroll
          for (int ks = 0; ks < 4; ++ks) { const bf16x8_t vf = tr_frag(va + 16 * ks * G1_VSTR, 4 * G1_VSTR);
#pragma unroll
              for (int j = 0; j < 4; ++j) KV[j] = __builtin_amdgcn_mfma_f32_32x32x16_bf16(vf, tr_frag(ka + 16 * ks * G1_KDSTR + j * 64, 4 * G1_KDSTR), KV[j], 0, 0, 0); }
          float* kp = WSF(WS_KVT) + ((size_t)u * 256 + 32 * wave + 4 * hh) * 128 + r32;
#pragma unroll
          for (int j = 0; j < 4; ++j)
#pragma unroll
              for (int r = 0; r < 16; ++r) kp[(size_t)((r & 3) + 8 * (r >> 2)) * 128 + 32 * j] = KV[j][r]; }
    }
    __syncthreads();
}
__device__ __forceinline__ void gla_g2(Frame& F) {
    PHASE_IDS();
    const float* kvt = WSF(WS_KVT); const float* dec = WSF(WS_DEC); bf16* st = (bf16*)(AP->ws + WS_ST);
    for (int e = F.vcu * 512 + tid; e < 16 * 32768; e += F.G * 512) {
        const int bh = e >> 15, rem = e & 32767, dk = e & 127; float S = 0.f;
#pragma unroll 8
        for (int n = 0; n < 32; ++n) { const size_t ch = (size_t)bh * 32 + n; st[ch * 32768 + rem] = (bf16)f2bf(S); S = dec[ch * 128 + dk] * S + kvt[ch * 32768 + rem]; }
    }
}
__device__ __forceinline__ void gla_g3(Frame& F, int l) {
    PHASE_IDS();
    const int hh = lane >> 5, r32 = lane & 31;
    LAS float* SS = (LAS float*)(F.lds + RING_OFF);
    const bf16* z = (const bf16*)(AP->ws + WS_Z); bf16* yb = (bf16*)(AP->ws + WS_HB);
    for (int u = F.vcu; u < 512; u += F.G) {
        const int bh = u >> 5, n = u & 31, b = bh >> 2, h = bh & 3;
        const size_t m0 = (size_t)b * SEQ + 64 * n;
        const bf16* sp = (const bf16*)(AP->ws + WS_ST) + ((size_t)u * 256 + 32 * wave + r32) * 128 + 8 * hh;
        bf16x8_t af[8];
#pragma unroll
        for (int ks = 0; ks < 8; ++ks) af[ks] = *(const bf16x8_t*)(sp + 16 * ks);
        f32x16_t D[2]; float ssq[2];
#pragma unroll
        for (int cb = 0; cb < 2; ++cb) { const bf16* qd = (const bf16*)(AP->ws + WS_QDEC) + (m0 + 32 * cb + r32) * 512 + h * 128 + 8 * hh;
#pragma unroll
            for (int r = 0; r < 16; ++r) D[cb][r] = 0.f;
#pragma unroll
            for (int ks = 0; ks < 8; ++ks) D[cb] = __builtin_amdgcn_mfma_f32_32x32x16_bf16(af[ks], *(const bf16x8_t*)(qd + 16 * ks), D[cb], 0, 0, 0);
            const float* oi = WSF(WS_OGLA) + (m0 + 32 * cb + r32) * BR + h * 256 + 32 * wave + 4 * hh; float q = 0.f;
#pragma unroll
            for (int cq = 0; cq < 4; ++cq) { const f32x4 x = *(const f32x4*)(oi + 8 * cq);
#pragma unroll
                for (int e = 0; e < 4; ++e) { D[cb][4 * cq + e] += x[e]; q += D[cb][4 * cq + e] * D[cb][4 * cq + e]; } }
            q += __shfl_xor(q, 32); ssq[cb] = q;
            if (hh == 0) SS[wave * 64 + 32 * cb + r32] = q; }
        __syncthreads();
#pragma unroll
        for (int cb = 0; cb < 2; ++cb) { float tot = 0.f;
#pragma unroll
            for (int w = 0; w < 8; ++w) tot += SS[w * 64 + 32 * cb + r32];
            const float rs = 1.0f / sqrtf(tot * (1.f / 256.f) + EPS); const size_t m = m0 + 32 * cb + r32; const int dvb = h * 256 + 32 * wave + 4 * hh;
#pragma unroll
            for (int cq = 0; cq < 4; ++cq) { const f32x4 g4 = *(const f32x4*)(IN_F(23) + l * BR + dvb + 8 * cq), gt = z4(z + m * ZC + Z_GG + dvb + 8 * cq);
                const float o0 = D[cb][4 * cq] * rs * g4.x * siluf_(gt.x), o1 = D[cb][4 * cq + 1] * rs * g4.y * siluf_(gt.y), o2 = D[cb][4 * cq + 2] * rs * g4.z * siluf_(gt.z), o3 = D[cb][4 * cq + 3] * rs * g4.w * siluf_(gt.w);
                *(unsigned long long*)(yb + m * DM + 2 * BR + dvb + 8 * cq) = (unsigned long long)pk2(o0, o1) | ((unsigned long long)pk2(o2, o3) << 32); } }
        __syncthreads();
    }
}
__device__ __forceinline__ void p4_lru(Frame& F, int l) {
    PHASE_IDS();
    LAS float* SA = (LAS float*)(F.lds + RING_OFF); LAS float* SH = SA + 512; LAS float* CI = SH + 512;
    const int ch = tid & 15, seg = tid >> 4;
    for (int u = F.vcu; u < 256; u += F.G) {
        const int b = u >> 6, c0 = (u & 63) * 16;
        const size_t base = ((size_t)b * SEQ + seg * 64) * BR + c0 + ch;
        const float* ap = WSF(WS_RPRE) + base; const float* gp = WSF(WS_IPRE) + base;
        float hl[64], pp[64]; float h = 0.f, P = 1.f;
#pragma unroll
        for (int t = 0; t < 64; ++t) { const float a = ap[(size_t)t * BR], g = gp[(size_t)t * BR]; h = a * h + g; P *= a; hl[t] = h; pp[t] = P; }
        SA[seg * 16 + ch] = P; SH[seg * 16 + ch] = h;
        __syncthreads();
        if (tid < 16) { float c = 0.f;
#pragma unroll 4
            for (int s2 = 0; s2 < 32; ++s2) { CI[s2 * 16 + tid] = c; c = SA[s2 * 16 + tid] * c + SH[s2 * 16 + tid]; } }
        __syncthreads();
        const float cin = CI[seg * 16 + ch]; float* op = WSF(WS_HLRU) + base;
#pragma unroll
        for (int t = 0; t < 64; ++t) op[(size_t)t * BR] = hl[t] + pp[t] * cin;
        __syncthreads();
    }
}
constexpr int AT_KSTR = 400, AT_VSTR = 320, AT_KBYTES = 64 * AT_KSTR, AT_BUF = AT_KBYTES + 64 * AT_VSTR;
__device__ __forceinline__ float bflo(unsigned w) { return __uint_as_float(w << 16); }
__device__ __forceinline__ float bfhi(unsigned w) { return __uint_as_float(w & 0xffff0000u); }
__device__ __forceinline__ void attn_phase(Frame& F) {
    PHASE_IDS();
    const int hh = lane >> 5, r32 = lane & 31;
    LAS unsigned char* L = F.lds + RING_OFF;
    const bf16* Qb = (const bf16*)(AP->ws + WS_Q); const bf16* KNb = (const bf16*)(AP->ws + WS_KN); const bf16* Vb = (const bf16*)(AP->ws + WS_V); const bf16* KRb = (const bf16*)(AP->ws + WS_KR);
    const float SC = 0.07216878364870322f * 1.4426950408889634f;
    const int half = wave >> 2, w4 = wave & 3;
    const int skey = tid >> 4, sc = tid & 15, rkey = tid >> 3, rc = tid & 7;
    for (int u = F.vcu; u < 256; u += F.G) {
        const int b = u >> 6, h = (u >> 3) & 7, i = u & 7;
        const int qblk = half ? i : 15 - i;
        const int qrow0 = qblk * 128 + w4 * 32, qrow = qrow0 + r32;
        const int ntile = 2 * (16 - i), tlast = (qrow0 + 31) >> 6;
        const size_t mrow = (size_t)b * SEQ + qrow;
        bf16x8_t qf[12];
        { const u32x4_t* qp = (const u32x4_t*)(Qb + mrow * 1536 + h * DQK + 8 * hh);
          u32x4_t raw[12];
#pragma unroll
          for (int ks = 0; ks < 12; ++ks) raw[ks] = qp[2 * ks];
#pragma unroll
          for (int ks = 0; ks < 8; ++ks) { u32x4_t o;
#pragma unroll
              for (int w = 0; w < 4; ++w) o[w] = cvtpk_s(bflo(raw[ks][w]) * SC, bfhi(raw[ks][w]) * SC);
              qf[ks] = __builtin_bit_cast(bf16x8_t, o); }
          const float* rt = WSF(WS_ROPE) + mrow * 64;
#pragma unroll
          for (int ks = 8; ks < 10; ++ks) { const int i0 = 16 * (ks - 8) + 8 * hh; u32x4_t o1, o2;
              const f32x4 c0 = *(const f32x4*)(rt + i0), c1 = *(const f32x4*)(rt + i0 + 4), s0 = *(const f32x4*)(rt + 32 + i0), s1 = *(const f32x4*)(rt + 32 + i0 + 4);
              const float cc[8] = {c0.x, c0.y, c0.z, c0.w, c1.x, c1.y, c1.z, c1.w}, ss[8] = {s0.x, s0.y, s0.z, s0.w, s1.x, s1.y, s1.z, s1.w};
#pragma unroll
              for (int w = 0; w < 4; ++w) { const float a0 = bflo(raw[ks][w]), a1 = bfhi(raw[ks][w]), b0 = bflo(raw[ks + 2][w]), b1 = bfhi(raw[ks + 2][w]);
                  o1[w] = cvtpk_s((a0 * cc[2 * w] - b0 * ss[2 * w]) * SC, (a1 * cc[2 * w + 1] - b1 * ss[2 * w + 1]) * SC);
                  o2[w] = cvtpk_s((b0 * cc[2 * w] + a0 * ss[2 * w]) * SC, (b1 * cc[2 * w + 1] + a1 * ss[2 * w + 1]) * SC); }
              qf[ks] = __builtin_bit_cast(bf16x8_t, o1); qf[ks + 2] = __builtin_bit_cast(bf16x8_t, o2); } }
        f32x16_t O[4];
#pragma unroll
        for (int d = 0; d < 4; ++d)
#pragma unroll
            for (int r = 0; r < 16; ++r) O[d][r] = 0.f;
        float m_run = -1e30f, l_run = 0.f;
        const bf16* knp = KNb + ((size_t)b * SEQ + skey) * BR + h * 128 + sc * 8;
        const bf16* vp = Vb + ((size_t)b * SEQ + skey) * BR + h * 128 + sc * 8;
        const bf16* krp = KRb + ((size_t)b * SEQ + rkey) * 64 + rc * 8;
        u32x4_t gk0, gk1, gkr, gv0, gv1;
#define AT_LOAD(t) do { const size_t ko = (size_t)(t) * 64 * BR; gk0 = *(const u32x4_t*)(knp + ko); gk1 = *(const u32x4_t*)(knp + ko + 32 * BR); \
        gv0 = *(const u32x4_t*)(vp + ko); gv1 = *(const u32x4_t*)(vp + ko + 32 * BR); gkr = *(const u32x4_t*)(krp + (size_t)(t) * 64 * 64); } while (0)
#define AT_STORE(p) do { LAS unsigned char* Bp = L + (p) * AT_BUF; \
        *(LAS u32x4_t*)(Bp + skey * AT_KSTR + sc * 16) = gk0; *(LAS u32x4_t*)(Bp + (skey + 32) * AT_KSTR + sc * 16) = gk1; \
        *(LAS u32x4_t*)(Bp + rkey * AT_KSTR + 256 + rc * 16) = gkr; \
        *(LAS u32x4_t*)(Bp + AT_KBYTES + skey * AT_VSTR + sc * 16) = gv0; *(LAS u32x4_t*)(Bp + AT_KBYTES + (skey + 32) * AT_VSTR + sc * 16) = gv1; } while (0)
        __syncthreads();
        AT_LOAD(0); AT_STORE(0);
        __syncthreads();
        for (int t = 0; t < ntile; ++t) {
            if (t + 1 < ntile) AT_LOAD(t + 1);
            if (t <= tlast) {
                LAS unsigned char* Kb = L + (t & 1) * AT_BUF; LAS unsigned char* Vbs = Kb + AT_KBYTES;
                f32x16_t S0, S1;
#pragma unroll
                for (int r = 0; r < 16; ++r) { S0[r] = 0.f; S1[r] = 0.f; }
                const LAS unsigned char* ka = Kb + r32 * AT_KSTR + hh * 16;
#pragma unroll
                for (int ks = 0; ks < 12; ++ks) {
                    const bf16x8_t k0 = *(const LAS bf16x8_t*)(ka + ks * 32), k1 = *(const LAS bf16x8_t*)(ka + 32 * AT_KSTR + ks * 32);
                    S0 = __builtin_amdgcn_mfma_f32_32x32x16_bf16(k0, qf[ks], S0, 0, 0, 0);
                    S1 = __builtin_amdgcn_mfma_f32_32x32x16_bf16(k1, qf[ks], S1, 0, 0, 0);
                }
                if (64 * t + 63 > qrow0) {
                    const int kb = 64 * t + 4 * hh;
#pragma unroll
                    for (int r = 0; r < 16; ++r) { const int key = kb + (r & 3) + 8 * (r >> 2); if (key > qrow) S0[r] = -1e30f; if (key + 32 > qrow) S1[r] = -1e30f; }
                }
                float mx = fmaxf(S0[0], S1[0]);
#pragma unroll
                for (int r = 1; r < 16; ++r) mx = fmaxf(mx, fmaxf(S0[r], S1[r]));
                mx = fmaxf(mx, __shfl_xor(mx, 32));
                if (__any(mx > m_run)) { const float mn = fmaxf(m_run, mx); const float al = __builtin_amdgcn_exp2f(m_run - mn); m_run = mn; l_run *= al;
#pragma unroll
                    for (int d = 0; d < 4; ++d)
#pragma unroll
                        for (int r = 0; r < 16; ++r) O[d][r] *= al; }
                float ls = 0.f;
#pragma unroll
                for (int r = 0; r < 16; ++r) { S0[r] = __builtin_amdgcn_exp2f(S0[r] - m_run); S1[r] = __builtin_amdgcn_exp2f(S1[r] - m_run); ls += S0[r] + S1[r]; }
                l_run += ls;
                bf16x8_t pf[2][2];
#pragma unroll
                for (int s2 = 0; s2 < 2; ++s2) { u32x4_t a, c;
#pragma unroll
                    for (int w = 0; w < 4; ++w) { a[w] = cvtpk_s(S0[8 * s2 + 2 * w], S0[8 * s2 + 2 * w + 1]); c[w] = cvtpk_s(S1[8 * s2 + 2 * w], S1[8 * s2 + 2 * w + 1]); }
                    pf[0][s2] = __builtin_bit_cast(bf16x8_t, a); pf[1][s2] = __builtin_bit_cast(bf16x8_t, c); }
                const LAS unsigned char* va = Vbs + (4 * hh + ((lane & 15) >> 2)) * AT_VSTR + (((lane >> 4) & 1) * 16 + (lane & 3) * 4) * 2;
#pragma unroll
                for (int d = 0; d < 4; ++d)
#pragma unroll
                    for (int kb2 = 0; kb2 < 2; ++kb2)
#pragma unroll
                        for (int s2 = 0; s2 < 2; ++s2) {
                            const LAS unsigned char* p = va + (32 * kb2 + 16 * s2) * AT_VSTR + d * 64;
                            const s16x4_t lo = __builtin_bit_cast(s16x4_t, __builtin_amdgcn_ds_read_tr16_b64_v4i16((LAS s16x4_t*)p));
                            const s16x4_t hi = __builtin_bit_cast(s16x4_t, __builtin_amdgcn_ds_read_tr16_b64_v4i16((LAS s16x4_t*)(p + 8 * AT_VSTR)));
                            const bf16x8_t vf = {lo[0], lo[1], lo[2], lo[3], hi[0], hi[1], hi[2], hi[3]};
                            O[d] = __builtin_amdgcn_mfma_f32_32x32x16_bf16(vf, pf[kb2][s2], O[d], 0, 0, 0);
                        }
            }
            if (t + 1 < ntile) AT_STORE((t + 1) & 1);
            __syncthreads();
        }
#undef AT_LOAD
#undef AT_STORE
        l_run += __shfl_xor(l_run, 32);
        const float inv = 1.f / l_run;
        float* op = WSF(WS_OMLA) + mrow * BR + h * 128 + 4 * hh;
#pragma unroll
        for (int d = 0; d < 4; ++d)
#pragma unroll
            for (int c = 0; c < 4; ++c) *(f32x4*)(op + 32 * d + 8 * c) = (f32x4){O[d][4 * c] * inv, O[d][4 * c + 1] * inv, O[d][4 * c + 2] * inv, O[d][4 * c + 3] * inv};
    }
    __syncthreads();
}
__device__ __forceinline__ void p5_norms(Frame& F, int l) {
    PHASE_IDS();
    const int gw = F.vcu * NWAVES + wave, NGW = F.G * NWAVES;
    const bf16* z = (const bf16*)(AP->ws + WS_Z); bf16* yb = (bf16*)(AP->ws + WS_HB);
    for (int m = gw; m < T; m += NGW) {
#pragma unroll
        for (int br = 0; br < 4; ++br) {
            if (br == 2) continue;
            asm volatile("" ::: "memory");
            const float* src = br == 0 ? WSF(WS_S5O) : br == 1 ? WSF(WS_OMLA) : br == 2 ? WSF(WS_OGLA) : WSF(WS_HLRU);
            const float* gg = (br == 0 ? IN_F(14) : br == 1 ? IN_F(20) : br == 2 ? IN_F(23) : IN_F(31)) + l * BR;
            const int zg = br == 0 ? Z_S5G : br == 1 ? Z_MG : br == 2 ? Z_GG : Z_LG;
            f32x4 v[4]; float ss[4]; float tot = 0.f;
#pragma unroll
            for (int j = 0; j < 4; ++j) { v[j] = *(const f32x4*)(src + (size_t)m * BR + 256 * j + 4 * lane); ss[j] = wave_sum((v[j].x * v[j].x + v[j].y * v[j].y) + (v[j].z * v[j].z + v[j].w * v[j].w)); tot += ss[j]; }
#pragma unroll
            for (int j = 0; j < 4; ++j) { const float rs = br == 2 ? 1.0f / sqrtf(ss[j] * (1.f / 256.f) + EPS) : 1.0f / sqrtf(tot * (1.f / 1024.f) + EPS);
                const f32x4 g4 = *(const f32x4*)(gg + 256 * j + 4 * lane); const f32x4 gt = z4(z + (size_t)m * ZC + zg + 256 * j + 4 * lane);
                const float o0 = v[j].x * rs * g4.x * siluf_(gt.x), o1 = v[j].y * rs * g4.y * siluf_(gt.y), o2 = v[j].z * rs * g4.z * siluf_(gt.z), o3 = v[j].w * rs * g4.w * siluf_(gt.w);
                *(unsigned long long*)(yb + (size_t)m * DM + br * BR + 256 * j + 4 * lane) = (unsigned long long)pk2(o0, o1) | ((unsigned long long)pk2(o2, o3) << 32); }
        }
    }
}
__device__ __forceinline__ void p7_norm(Frame& F, int l) {
    PHASE_IDS();
    const int gw = F.vcu * NWAVES + wave, NGW = F.G * NWAVES;
    for (int m = gw; m < T; m += NGW) {
        asm volatile("" ::: "memory");
        if (l + 1 < DEPTH) rms_row<true>(WSF(WS_XB) + (size_t)m * DM, IN_F(2) + (l + 1) * DM, (bf16*)(AP->ws + WS_HB) + (size_t)m * DM, lane);
        else rms_row<false>(WSF(WS_XB) + (size_t)m * DM, IN_F(33), AP->out + (size_t)m * DM, lane);
    }
}

constexpr int PH_PER_LAYER = 7, N_PHASES = 1 + DEPTH * PH_PER_LAYER;
__global__ void __launch_bounds__(NWAVES * 64, 2) hybrid_fwd(Args args) {
    extern __shared__ __attribute__((aligned(16))) unsigned char lds[];
    Frame F;
    F.lds = (LAS unsigned char*)lds; F.ldsg = lds;
    F.G = gridDim.x; { const int bx = blockIdx.x; F.vcu = (F.G % 8 == 0) ? (bx % 8) * (F.G / 8) + bx / 8 : bx; }
    volatile LAS unsigned* MISC = (volatile LAS unsigned*)(F.lds + MISC_OFF);
    for (int u = threadIdx.x; u < (LDS_BYTES - LDSCTL_OFF) / 4; u += NWAVES * 64) ((LAS unsigned*)(F.lds + LDSCTL_OFF))[u] = 0u;
    __syncthreads();
    ArgsP AP0 = (ArgsP)__builtin_amdgcn_kernarg_segment_ptr();
    const bool multi = (args.ph_hi - args.ph_lo) > 1;
    XcdBarrier bar; bar.bar = (unsigned*)(AP0->ws + WS_CTL) + 4096; bar.x = 0; bar.st = nullptr;
    if (multi) bar = xcd_barrier_post((unsigned*)(AP0->ws + WS_CTL) + 4096, MISC + 8);
    const int lo = args.ph_lo, hi = args.ph_hi;
#define IN(k) (lo <= (k) && (k) < hi)
#define SEAM(k) do { if (IN(k) && IN((k) + 1)) xcd_barrier(bar); } while (0)
    if (IN(0)) {
#ifndef SK_P0
 p0_prologue(F);
#endif
 } SEAM(0);
    for (int ll = 0; ll < DEPTH; ++ll) {
        int l = ll; asm volatile("" : "+s"(l) :: "memory");
        const int pb = 1 + l * PH_PER_LAYER;
        if (IN(pb + 0)) {
            ArgsP AP = (ArgsP)__builtin_amdgcn_kernarg_segment_ptr(); asm volatile("" : "+s"(AP));
            pg8::Gemm g{(const bf16*)(AP->ws + WS_HB), (const bf16*)(AP->ws + WS_WTIN) + (size_t)l * ZC * DM, T, ZC, DM, DM, DM, 0}; pg8::StaticOrder S; S.init(T, ZC, F.G, (int)blockIdx.x);
            pg8::EpiBf16Split E{(bf16*)(AP->ws + WS_Z), (bf16*)(AP->ws + WS_Z), ZC, 1000};
            pg8::gemm_phase<pg8::EpiBf16Split, pg8::StaticOrder, true, true>(F.lds + RING_OFF, g, S, E);
            if ((int)blockIdx.x >= 192) s5_prep(F, l, (int)blockIdx.x - 192);
        } SEAM(pb + 0);
        if (IN(pb + 1)) {
#ifndef SK_P2R
 p2_rows(F, l);
#endif
#ifndef SK_P2S
 s5_stage(F);
#endif
 } SEAM(pb + 1);
        if (IN(pb + 2)) {
#ifndef SK_P3G
 gla_g1(F, l);
#endif
            { ArgsP AP = (ArgsP)__builtin_amdgcn_kernarg_segment_ptr(); asm volatile("" : "+s"(AP));
              { const int gs5 = F.vcu < 64 ? F.vcu : -1;
                { pg8::Gemm g{(const bf16*)(AP->ws + WS_S5A), (const bf16*)(AP->ws + WS_S5B1), 64 * 256, 64 * 256, 512, 640, 640, 0}; pg8::S5Order S{gs5, 1};
                  pg8::EpiS5Loc E{WSF(WS_S5L)}; pg8::gemm_phase<pg8::EpiS5Loc, pg8::S5Order, true, true>(F.lds + RING_OFF, g, S, E); }
                if (gs5 >= 0) s5_scan(F, gs5);
                { pg8::Gemm g{(const bf16*)(AP->ws + WS_S5A), (const bf16*)(AP->ws + WS_S5B2), 64 * 256, 64 * 512, 640, 640, 640, 0}; pg8::S5Order S{gs5, 2};
                  pg8::EpiS5Y E{(bf16*)(AP->ws + WS_YS5B)}; pg8::gemm_phase<pg8::EpiS5Y, pg8::S5Order, true, true>(F.lds + RING_OFF, g, S, E); } }
#ifndef SK_GQ
              { pg8::Gemm g{(const bf16*)(AP->ws + WS_CQB), (const bf16*)(AP->ws + WS_WTUQ) + (size_t)l * 1536 * QR, T, 1536, QR, QR, QR, 0}; pg8::StaticOrder S; S.init(T, 1536, F.G, (int)blockIdx.x);
                pg8::EpiBf16Split E{(bf16*)(AP->ws + WS_Q), (bf16*)(AP->ws + WS_Q), 1536, 1000}; pg8::gemm_phase<pg8::EpiBf16Split, pg8::StaticOrder, true, true>(F.lds + RING_OFF, g, S, E); }
#endif
#ifndef SK_GKV
              { pg8::Gemm g{(const bf16*)(AP->ws + WS_CKVB), (const bf16*)(AP->ws + WS_WTUKV) + (size_t)l * 2048 * KVR, T, 2048, KVR, KVR, KVR, 0}; pg8::StaticOrder S; S.init(T, 2048, F.G, (int)blockIdx.x);
                pg8::EpiBf16Split E{(bf16*)(AP->ws + WS_KN), (bf16*)(AP->ws + WS_V), BR, 4}; pg8::gemm_phase<pg8::EpiBf16Split, pg8::StaticOrder, true, true>(F.lds + RING_OFF, g, S, E); }
#endif
#ifndef SK_GLRU
              { pg8::Gemm g{(const bf16*)(AP->ws + WS_XCB), (const bf16*)(AP->ws + WS_WTLRU) + (size_t)l * 8 * 256 * 1024, T, 2048, 128, BR, BR, 256}; pg8::StaticOrder S; S.init(T, 2048, F.G, (int)blockIdx.x);
                pg8::EpiLru E{WSF(WS_XC), IN_F(27) + l * BR, IN_F(29) + l * BR, WSF(WS_SPL) + l * BR, WSF(WS_RPRE), WSF(WS_IPRE)}; pg8::gemm_phase<pg8::EpiLru, pg8::StaticOrder, true, true>(F.lds + RING_OFF, g, S, E); }
#endif
            }
 } SEAM(pb + 2);
        if (IN(pb + 3)) {
#ifndef SK_P4L
 p4_lru(F, l);
 gla_g2(F);
#endif
            { ArgsP AP = (ArgsP)__builtin_amdgcn_kernarg_segment_ptr(); asm volatile("" : "+s"(AP));
              { pg8::Gemm g{(const bf16*)(AP->ws + WS_YS5B), (const bf16*)(AP->ws + WS_WTGLU) + (size_t)l * BR * BR, T, BR, BR, BR, BR, 0}; pg8::StaticOrder S; S.init(T, BR, F.G, (int)blockIdx.x);
                pg8::EpiGlu E{(const bf16*)(AP->ws + WS_YS5B), IN_F(13) + l * BR, WSF(WS_S5O), BR}; pg8::gemm_phase<pg8::EpiGlu, pg8::StaticOrder, true, true>(F.lds + RING_OFF, g, S, E); }
            }

#ifndef SK_P4A
 attn_phase(F);
#endif
 } SEAM(pb + 3);
        if (IN(pb + 4)) {
#ifndef SK_P5
 p5_norms(F, l);
 gla_g3(F, l);
#endif
 } SEAM(pb + 4);
        if (IN(pb + 5)) {
            ArgsP AP = (ArgsP)__builtin_amdgcn_kernarg_segment_ptr(); asm volatile("" : "+s"(AP));
            pg8::Gemm g{(const bf16*)(AP->ws + WS_HB), (const bf16*)(AP->ws + WS_WTOUT) + (size_t)l * DM * DM, T, DM, DM, DM, DM, 0}; pg8::StaticOrder S; S.init(T, DM, F.G, (int)blockIdx.x);
            pg8::EpiRes E{l == 0 ? IN_F(0) : WSF(WS_XB), WSF(WS_XB), DM};
            pg8::gemm_phase<pg8::EpiRes, pg8::StaticOrder, true, true>(F.lds + RING_OFF, g, S, E);
        } SEAM(pb + 5);
        if (IN(pb + 6)) {
#ifndef SK_P7
 p7_norm(F, l);
#endif
 } SEAM(pb + 6);
    }
#undef IN
#undef SEAM
}

#ifndef N_LAUNCHES
#define N_LAUNCHES 1
#endif
extern "C" void kernel_launch(void* const* d_in, const int* in_sizes, int n_in, void* d_out, int out_size, void* d_ws, size_t ws_size, hipStream_t stream) {
    static int grid = 0;
    if (grid == 0) {
        if (n_in != 34 || out_size != T * DM || ws_size < WS_END) { fprintf(stderr, "kernel_launch: unexpected problem: n_in %d out %d ws %zu (need %zu)\n", n_in, out_size, ws_size, (size_t)WS_END); grid = -1; return; }
        int dev = 0, cus = 0;
        if (hipGetDevice(&dev) != hipSuccess || hipDeviceGetAttribute(&cus, hipDeviceAttributeMultiprocessorCount, dev) != hipSuccess) { grid = -1; return; }
        if (hipFuncSetAttribute((const void*)hybrid_fwd, hipFuncAttributeMaxDynamicSharedMemorySize, LDS_BYTES) != hipSuccess) { fprintf(stderr, "kernel_launch: hipFuncSetAttribute failed\n"); grid = -1; return; }
        int per_cu = 0;
        if (hipOccupancyMaxActiveBlocksPerMultiprocessor(&per_cu, (const void*)hybrid_fwd, NWAVES * 64, LDS_BYTES) != hipSuccess || per_cu < 1) fprintf(stderr, "kernel_launch: occupancy query says %d blocks/CU\n", per_cu);
        (void)hipGetLastError();
        grid = cus;
    }
    if (grid < 0) return;
    (void)hipMemsetAsync((char*)d_ws + WS_CTL, 0, CTL_ZERO_BYTES, stream);
    Args a{};
    for (int i = 0; i < 34; ++i) a.in[i] = d_in[i];
    a.out = (float*)d_out; a.ws = (unsigned char*)d_ws;
    if (N_LAUNCHES == 1) { a.ph_lo = 0; a.ph_hi = N_PHASES; hipLaunchKernelGGL(hybrid_fwd, dim3(grid), dim3(NWAVES * 64), LDS_BYTES, stream, a); }
    else for (int p = 0; p < N_PHASES; ++p) { a.ph_lo = p; a.ph_hi = p + 1; hipLaunchKernelGGL(hybrid_fwd, dim3(grid), dim3(NWAVES * 64), LDS_BYTES, stream, a); }
}
```

```cpp
#include <hip/hip_runtime.h>
#include <cstdio>
#include <cstdint>

__device__ __forceinline__ int lane_id() { int l; asm volatile("v_mbcnt_lo_u32_b32 %0, -1, 0\n\tv_mbcnt_hi_u32_b32 %0, -1, %0" : "=v"(l)); return l; }
namespace pg8 {
#define PG8_LAS __attribute__((address_space(3)))
typedef unsigned short bf16_t;
typedef short bf16x8 __attribute__((ext_vector_type(8)));
typedef float f32x4 __attribute__((ext_vector_type(4)));
typedef unsigned u32x4 __attribute__((ext_vector_type(4)));
constexpr int BM = 256, BK = 64, HALF = 128, HTB = HALF * BK * 2, STAGE_BYTES = 8 * HTB, NXCD = 8, WGM = 8;

__host__ __device__ __forceinline__ int lds_byte(int r, int c) { const int st = (r >> 4) * 2 + (c >> 5), rr = r & 15, cc = c & 31, ob = rr * 64 + cc * 2; return st * 1024 + (ob ^ (((ob >> 9) & 1) << 5)); }
__host__ __device__ __forceinline__ void stage_rc(int b, int& R, int& C) { const int st = b / 1024, sb = b % 1024, swz = sb ^ (((sb >> 9) & 1) << 5); R = (st >> 1) * 16 + swz / 64; C = (st & 1) * 32 + (swz % 64) / 2; }
__host__ __device__ __forceinline__ int perm32(int rho) { const int n = rho >> 4, i = rho & 15; return 8 * (i >> 2) + 4 * n + (i & 3); }

struct Unit { int pm, pn; const char* a; const char* b; int nt, kind; };
struct Gemm { const bf16_t* A; const bf16_t* Bt; int M, N, K; int lda, ldb; int a_colstep; };

struct StaticOrder {
    static constexpr bool MULTI = false;
    int nM, nN, nwg, G, c;
    __host__ __device__ void init(int M, int N, int G_, int c_) { nM = M / BM; nN = N / BM; nwg = nM * nN; G = G_; c = c_; }
    __host__ __device__ bool next(int i, Unit& u) const {
        const long L = (long)i * G + c; if (L >= nwg) return false;
        int wgid = (int)L; { const int q = nwg / NXCD, r = nwg % NXCD, xcd = wgid % NXCD, off = wgid / NXCD; wgid = (xcd < r ? xcd * (q + 1) : r * (q + 1) + (xcd - r) * q) + off; }
        const int nig = WGM * nN, gid = wgid / nig, fm = gid * WGM, gsz = (nM - fm) < WGM ? (nM - fm) : WGM;
        u.pm = fm + ((wgid % nig) % gsz); u.pn = (wgid % nig) / gsz; return true;
    }
    __device__ __forceinline__ void a_ready(const Unit&) const {}
    __device__ __forceinline__ void done(const Unit&) const {}
};

struct EpiF32 {
    static constexpr bool PERM = false, AFTER_DRAIN = false;
    float* C; int ldc;
    __device__ __forceinline__ void operator()(const f32x4 (&acc)[2][2][4][2], const Unit& u, int wr, int wc, int fr, int fq) const {
        const int row0 = u.pm * BM + wr * 64 + fr, col0 = u.pn * BM + wc * 32 + 4 * fq;
#pragma unroll
        for (int ai = 0; ai < 2; ++ai)
#pragma unroll
            for (int m = 0; m < 4; ++m) { float* rowp = C + (size_t)(row0 + ai * HALF + m * 16) * ldc + col0;
#pragma unroll
                for (int bj = 0; bj < 2; ++bj)
#pragma unroll
                    for (int n = 0; n < 2; ++n) *(f32x4*)(rowp + bj * HALF + n * 16) = acc[ai][bj][m][n]; }
    }
};
struct EpiRes {
    static constexpr bool PERM = false, AFTER_DRAIN = false;
    const float* base; float* O; int ldc;
    __device__ __forceinline__ void operator()(const f32x4 (&acc)[2][2][4][2], const Unit& u, int wr, int wc, int fr, int fq) const {
        const int row0 = u.pm * BM + wr * 64 + fr, col0 = u.pn * BM + wc * 32 + 4 * fq;
#pragma unroll
        for (int ai = 0; ai < 2; ++ai)
#pragma unroll
            for (int m = 0; m < 4; ++m) { const size_t off = (size_t)(row0 + ai * HALF + m * 16) * ldc + col0;
#pragma unroll
                for (int bj = 0; bj < 2; ++bj)
#pragma unroll
                    for (int n = 0; n < 2; ++n) { const f32x4 b = *(const f32x4*)(base + off + bj * HALF + n * 16); *(f32x4*)(O + off + bj * HALF + n * 16) = b + acc[ai][bj][m][n]; } }
    }
};

struct EpiF32Split {
    static constexpr bool PERM = false, AFTER_DRAIN = false;
    float* C0; float* C1; int ldc; int split;
    __device__ __forceinline__ void operator()(const f32x4 (&acc)[2][2][4][2], const Unit& u, int wr, int wc, int fr, int fq) const {
        float* C = u.pn < split ? C0 : C1; const int pn = u.pn < split ? u.pn : u.pn - split;
        const int row0 = u.pm * BM + wr * 64 + fr, col0 = pn * BM + wc * 32 + 4 * fq;
#pragma unroll
        for (int ai = 0; ai < 2; ++ai)
#pragma unroll
            for (int m = 0; m < 4; ++m) { float* rowp = C + (size_t)(row0 + ai * HALF + m * 16) * ldc + col0;
#pragma unroll
                for (int bj = 0; bj < 2; ++bj)
#pragma unroll
                    for (int n = 0; n < 2; ++n) *(f32x4*)(rowp + bj * HALF + n * 16) = acc[ai][bj][m][n]; }
    }
};__device__ __forceinline__ unsigned cvt_pk_bf16(float lo, float hi) { unsigned r; asm volatile("v_cvt_pk_bf16_f32 %0, %1, %2" : "=v"(r) : "v"(lo), "v"(hi)); return r; }
struct EpiBf16Split {
    static constexpr bool PERM = false, AFTER_DRAIN = false;
    bf16_t* O0; bf16_t* O1; int ldc; int split;
    __device__ __forceinline__ void operator()(const f32x4 (&acc)[2][2][4][2], const Unit& u, int wr, int wc, int fr, int fq) const {
        bf16_t* O = u.pn < split ? O0 : O1; const int pn = u.pn < split ? u.pn : u.pn - split;
        const int row0 = u.pm * BM + wr * 64 + fr, col0 = pn * BM + wc * 32 + 4 * fq;
#pragma unroll
        for (int ai = 0; ai < 2; ++ai)
#pragma unroll
            for (int m = 0; m < 4; ++m) { bf16_t* rowp = O + (size_t)(row0 + ai * HALF + m * 16) * ldc + col0;
#pragma unroll
                for (int bj = 0; bj < 2; ++bj)
#pragma unroll
                    for (int n = 0; n < 2; ++n) { const f32x4 v = acc[ai][bj][m][n];
                        *(unsigned long long*)(rowp + bj * HALF + n * 16) = (unsigned long long)cvt_pk_bf16(v[0], v[1]) | ((unsigned long long)cvt_pk_bf16(v[2], v[3]) << 32); } }
    }
};

struct EpiBf16P {
    static constexpr bool PERM = true, AFTER_DRAIN = false;
    bf16_t* O; int ldc;
    __device__ __forceinline__ void operator()(const f32x4 (&acc)[2][2][4][2], const Unit& u, int wr, int wc, int fr, int fq) const {
        const int row0 = u.pm * BM + wr * 64 + fr, col0 = u.pn * BM + wc * 32 + 8 * fq;
#pragma unroll
        for (int ai = 0; ai < 2; ++ai)
#pragma unroll
            for (int m = 0; m < 4; ++m) { bf16_t* rowp = O + (size_t)(row0 + ai * HALF + m * 16) * ldc + col0;
#pragma unroll
                for (int bj = 0; bj < 2; ++bj) { const f32x4 v0 = acc[ai][bj][m][0], v1 = acc[ai][bj][m][1]; u32x4 w; w.x = cvt_pk_bf16(v0[0], v0[1]); w.y = cvt_pk_bf16(v0[2], v0[3]); w.z = cvt_pk_bf16(v1[0], v1[1]); w.w = cvt_pk_bf16(v1[2], v1[3]);
                    *(u32x4*)(rowp + bj * HALF) = w; } }
    }
};
struct EpiResP {
    static constexpr bool PERM = true, AFTER_DRAIN = false;
    const float* base; float* O; int ldc;
    __device__ __forceinline__ void operator()(const f32x4 (&acc)[2][2][4][2], const Unit& u, int wr, int wc, int fr, int fq) const {
        const int row0 = u.pm * BM + wr * 64 + fr, col0 = u.pn * BM + wc * 32 + 8 * fq;
#pragma unroll
        for (int ai = 0; ai < 2; ++ai)
#pragma unroll
            for (int m = 0; m < 4; ++m) { const size_t off = (size_t)(row0 + ai * HALF + m * 16) * ldc + col0;
#pragma unroll
                for (int bj = 0; bj < 2; ++bj) { const f32x4 b0 = *(const f32x4*)(base + off + bj * HALF), b1 = *(const f32x4*)(base + off + bj * HALF + 4);
                    *(f32x4*)(O + off + bj * HALF) = b0 + acc[ai][bj][m][0]; *(f32x4*)(O + off + bj * HALF + 4) = b1 + acc[ai][bj][m][1]; } }
    }
};

__device__ __forceinline__ float sigm(float x) { return __builtin_amdgcn_rcpf(1.0f + __expf(-x)); }
struct EpiGlu {
    static constexpr bool PERM = false, AFTER_DRAIN = false;
    const bf16_t* Y; const float* bias; float* O; int ldc;
    __device__ __forceinline__ void operator()(const f32x4 (&acc)[2][2][4][2], const Unit& u, int wr, int wc, int fr, int fq) const {
        const int row0 = u.pm * BM + wr * 64 + fr, col0 = u.pn * BM + wc * 32 + 4 * fq;
        unsigned long long yv[2][4][2][2]; f32x4 bv[2][2];
#pragma unroll
        for (int bj = 0; bj < 2; ++bj)
#pragma unroll
            for (int n = 0; n < 2; ++n) { bv[bj][n] = *(const f32x4*)(bias + col0 + bj * HALF + n * 16);
#pragma unroll
                for (int ai = 0; ai < 2; ++ai)
#pragma unroll
                    for (int m = 0; m < 4; ++m) yv[ai][m][bj][n] = *(const unsigned long long*)(Y + (size_t)(row0 + ai * HALF + m * 16) * ldc + col0 + bj * HALF + n * 16); }
#pragma unroll
        for (int ai = 0; ai < 2; ++ai)
#pragma unroll
            for (int m = 0; m < 4; ++m)
#pragma unroll
                for (int bj = 0; bj < 2; ++bj)
#pragma unroll
                    for (int n = 0; n < 2; ++n) { const size_t off = (size_t)(row0 + ai * HALF + m * 16) * ldc + col0 + bj * HALF + n * 16;
                        const unsigned y01 = (unsigned)yv[ai][m][bj][n], y23 = (unsigned)(yv[ai][m][bj][n] >> 32);
                        const f32x4 v = acc[ai][bj][m][n] + bv[bj][n]; f32x4 o;
                        o.x = __uint_as_float(y01 << 16) * sigm(v.x); o.y = __uint_as_float(y01 & 0xffff0000u) * sigm(v.y); o.z = __uint_as_float(y23 << 16) * sigm(v.z); o.w = __uint_as_float(y23 & 0xffff0000u) * sigm(v.w);
                        *(f32x4*)(O + off) = o; }
    }
};
struct EpiLru {
    static constexpr bool PERM = false, AFTER_DRAIN = false;
    const bf16_t* XC; const float* ba; const float* bx; const float* spl; float* Aout; float* Gout;
    __device__ __forceinline__ void operator()(const f32x4 (&acc)[2][2][4][2], const Unit& u, int wr, int wc, int fr, int fq) const {
        const int row0 = u.pm * BM + wr * 64 + fr, ch0 = u.pn * 128 + wc * 32 + 4 * fq;
        unsigned long long xw[2][4][2]; f32x4 va[2], vx[2], sp[2];
#pragma unroll
        for (int n = 0; n < 2; ++n) { va[n] = *(const f32x4*)(ba + ch0 + n * 16); vx[n] = *(const f32x4*)(bx + ch0 + n * 16); sp[n] = *(const f32x4*)(spl + ch0 + n * 16);
#pragma unroll
            for (int ai = 0; ai < 2; ++ai)
#pragma unroll
                for (int m = 0; m < 4; ++m) xw[ai][m][n] = *(const unsigned long long*)(XC + (size_t)(row0 + ai * HALF + m * 16) * 1024 + ch0 + n * 16); }
#pragma unroll
        for (int n = 0; n < 2; ++n)
#pragma unroll
        for (int ai = 0; ai < 2; ++ai)
#pragma unroll
            for (int m = 0; m < 4; ++m) { const size_t off = (size_t)(row0 + ai * HALF + m * 16) * 1024 + ch0;
                const unsigned a0 = (unsigned)xw[ai][m][n], a1 = (unsigned)(xw[ai][m][n] >> 32);
                const f32x4 xc = (f32x4){__uint_as_float(a0 << 16), __uint_as_float(a0 & 0xffff0000u), __uint_as_float(a1 << 16), __uint_as_float(a1 & 0xffff0000u)}; f32x4 oa, og;
#pragma unroll
                for (int e = 0; e < 4; ++e) { const float r = sigm(acc[ai][0][m][n][e] + va[n][e]), ig = sigm(acc[ai][1][m][n][e] + vx[n][e]);
                    const float la = -8.f * r * sp[n][e]; const float a = __expf(la); const float x = 2.f * la;
                    const float ser = -x * (1.f + x * (0.5f + x * (0.16666667f + x * (0.041666668f + x * (0.0083333338f + x * 0.0013888889f)))));
                    const float em = x > -0.5f ? ser : 1.f - a * a;
                    oa[e] = a; og[e] = __builtin_amdgcn_sqrtf(em) * (ig * xc[e]); }
                *(f32x4*)(Aout + off + n * 16) = oa; *(f32x4*)(Gout + off + n * 16) = og; }
    }
};
struct EpiS5Loc {
    static constexpr bool PERM = false, AFTER_DRAIN = false;
    float* SL;
    __device__ __forceinline__ void operator()(const f32x4 (&acc)[2][2][4][2], const Unit& u, int wr, int wc, int fr, int fq) const {
        float* base = SL + ((size_t)u.pm * 256 + wr * 64 + fr) * 128 + wc * 32 + 4 * fq;
#pragma unroll
        for (int ai = 0; ai < 2; ++ai)
#pragma unroll
            for (int m = 0; m < 4; ++m)
#pragma unroll
                for (int n = 0; n < 2; ++n) *(f32x4*)(base + (size_t)(ai * HALF + m * 16) * 128 + n * 16) = acc[ai][0][m][n];
    }
};
__device__ __forceinline__ float gelu_t(float x) { const float uu = 0.7978845608028654f * (x + 0.044715f * x * x * x); const float e = __expf(2.f * uu); return 0.5f * x * (2.f - 2.f * __builtin_amdgcn_rcpf(e + 1.f)); }
struct EpiS5Y {
    static constexpr bool PERM = false, AFTER_DRAIN = false;
    bf16_t* Y;
    __device__ __forceinline__ void operator()(const f32x4 (&acc)[2][2][4][2], const Unit& u, int wr, int wc, int fr, int fq) const {
        const int g = u.pm, half = u.pn & 1;
#pragma unroll
        for (int ai = 0; ai < 2; ++ai)
#pragma unroll
            for (int m = 0; m < 4; ++m) { const int r = ai * HALF + wr * 64 + m * 16 + fr; const size_t mrow = (size_t)(r >> 6) * 2048 + (size_t)(r & 63) * 32;
#pragma unroll
                for (int bj = 0; bj < 2; ++bj)
#pragma unroll
                    for (int n = 0; n < 2; ++n) { const int t = 16 * half + 8 * bj + 2 * wc + n; const f32x4 v = acc[ai][bj][m][n];
                        *(unsigned long long*)(Y + (mrow + t) * 1024 + g * 16 + 4 * fq) = (unsigned long long)cvt_pk_bf16(gelu_t(v[0]), gelu_t(v[1])) | ((unsigned long long)cvt_pk_bf16(gelu_t(v[2]), gelu_t(v[3])) << 32); } }
    }
};
struct StaticOrderT {
    static constexpr bool MULTI = false;
    int nM, nN, nwg, G, c;
    __host__ __device__ void init(int M, int N, int G_, int c_) { nM = M / BM; nN = N / BM; nwg = nM * nN; G = G_; c = c_; }
    __host__ __device__ bool next(int i, Unit& u) const {
        const long L = (long)i * G + c; if (L >= nwg) return false;
        int wgid = (int)L; { const int q = nwg / NXCD, r = nwg % NXCD, xcd = wgid % NXCD, off = wgid / NXCD; wgid = (xcd < r ? xcd * (q + 1) : r * (q + 1) + (xcd - r) * q) + off; }
        const int nig = WGM * nM, gid = wgid / nig, fn = gid * WGM, gsz = (nN - fn) < WGM ? (nN - fn) : WGM;
        u.pn = fn + ((wgid % nig) % gsz); u.pm = (wgid % nig) / gsz; return true;
    }
    __device__ __forceinline__ void a_ready(const Unit&) const {}
    __device__ __forceinline__ void done(const Unit&) const {}
};
struct RankOrder {
    static constexpr bool MULTI = false;
    int nunits, nN, r, nw;
    __device__ __forceinline__ bool next(int i, Unit& u) const { const int L = i * nw + r; if (r < 0 || L >= nunits) return false; u.pm = L / nN; u.pn = L - u.pm * nN; return true; }
    __device__ __forceinline__ void a_ready(const Unit&) const {}
    __device__ __forceinline__ void done(const Unit&) const {}
};
struct S5Order {
    static constexpr bool MULTI = false;
    int g, mode;
    __device__ __forceinline__ bool next(int i, Unit& u) const { if (g < 0 || i >= mode) return false; u.pm = g; u.pn = (mode == 1) ? g : 2 * g + i; return true; }
    __device__ __forceinline__ void a_ready(const Unit&) const {}
    __device__ __forceinline__ void done(const Unit&) const {}
};

struct P3Order {
    static constexpr bool MULTI = true;
    const char *qa, *qb, *ka, *kb, *la, *lb; int r0, r1, r2;
    __device__ __forceinline__ bool next(int i, Unit& u) const {
        const int n0 = r0 < 0 ? 0 : 1, n1 = r1 < 0 ? 0 : (r1 < 64 ? 2 : 1), n2 = r2 < 0 ? 0 : (r2 < 64 ? 2 : 1);
        if (i < n0) { const int L = r0; u.pm = L / 6; u.pn = L - u.pm * 6; u.a = qa + (size_t)u.pm * 524288; u.b = qb + (size_t)u.pn * 524288; u.nt = 12; u.kind = 0; return true; }
        i -= n0;
        if (i < n1) { const int L = i * 192 + r1; u.pm = L >> 3; u.pn = L & 7; u.a = ka + (size_t)u.pm * 524288; u.b = kb + (size_t)u.pn * 524288; u.nt = 8; u.kind = 1; return true; }
        i -= n1;
        if (i < n2) { const int L = i * 192 + r2; u.pm = L >> 3; u.pn = L & 7; u.a = la + (size_t)u.pm * 524288 + (size_t)u.pn * 256; u.b = lb + (size_t)u.pn * 524288; u.nt = 2; u.kind = 2; return true; }
        return false;
    }
    __device__ __forceinline__ void a_ready(const Unit&) const {}
    __device__ __forceinline__ void done(const Unit&) const {}
};
struct EpiP3 {
    static constexpr bool PERM = false, AFTER_DRAIN = false;
    EpiBf16Split q, kv; EpiLru lru;
    __device__ __forceinline__ void operator()(const f32x4 (&acc)[2][2][4][2], const Unit& u, int wr, int wc, int fr, int fq) const {
        if (u.kind == 0) q(acc, u, wr, wc, fr, fq); else if (u.kind == 1) kv(acc, u, wr, wc, fr, fq); else lru(acc, u, wr, wc, fr, fq);
    }
};

template <class Epi, class Sched, bool ALIGN_EPI = false, bool SP2 = false, bool BLK = false>
__device__ __forceinline__ void gemm_phase(PG8_LAS unsigned char* lds, const Gemm g, const Sched& S, const Epi& E, const int wv) {
    int lane = lane_id(); asm volatile("" : "+v"(lane));
    int wid = wv; asm volatile("" : "+s"(wid));
    const int tid = wid * 64 + lane, wr = wid >> 2, wc = wid & 3, fr = lane & 15, fq = lane >> 4;
    int K = g.K; asm volatile("" : "+s"(K));
    int nt = K / BK;
    unsigned voffA[2], voffB[2];
#pragma unroll
    for (int i = 0; i < 2; ++i) { int R, C; stage_rc(tid * 16 + i * 8192, R, C); const int Rb = Epi::PERM ? ((R & ~31) + perm32(R & 31)) : R;
        voffA[i] = (unsigned)(R * (BLK ? BK : g.lda) + C) * 2u; voffB[i] = (unsigned)(Rb * (BLK ? BK : g.ldb) + C) * 2u; }
    const size_t kstep = BLK ? (size_t)(BM * BK * 2) : (size_t)(BK * 2);
    const size_t hA = BLK ? (size_t)(HALF * BK * 2) : (size_t)HALF * g.lda * 2, hB = BLK ? (size_t)(HALF * BK * 2) : (size_t)HALF * g.ldb * 2;
    const size_t tA = BLK ? (size_t)nt * (BM * BK * 2) : 2 * hA, tB = BLK ? (size_t)nt * (BM * BK * 2) : 2 * hB; const size_t acs = (size_t)g.a_colstep;
    const unsigned ldsw = (unsigned)wid * 1024u;
    const int aoff = lds_byte(wr * 64 + fr, fq * 8), boff = lds_byte(wc * 32 + fr, fq * 8);
#define PG8_SA(b, h) (((b) * 2 + (h)) * HTB)
#define PG8_SB(b, h) ((4 + (b) * 2 + (h)) * HTB)
#define PG8_STAGE(bufoff, gbase, voff) do { _Pragma("unroll") for (int _i = 0; _i < 2; ++_i) \
        __builtin_amdgcn_global_load_lds((const unsigned*)((const char*)(gbase) + (voff)[_i]), (PG8_LAS unsigned*)(lds + (bufoff) + ldsw + _i * 8192), 16, 0, 0); } while (0)
#define PG8_LDA(dst, b, h) do { _Pragma("unroll") for (int m = 0; m < 4; ++m) _Pragma("unroll") for (int k = 0; k < 2; ++k) dst[m][k] = *(const PG8_LAS bf16x8*)(lds + PG8_SA(b, h) + aoff + m * 2048 + k * 1024); } while (0)
#define PG8_LDB(dst, b, h) do { _Pragma("unroll") for (int n = 0; n < 2; ++n) _Pragma("unroll") for (int k = 0; k < 2; ++k) dst[n][k] = *(const PG8_LAS bf16x8*)(lds + PG8_SB(b, h) + boff + n * 2048 + k * 1024); } while (0)
#define PG8_MMA(ai, bj, At, Bt) do { __builtin_amdgcn_s_setprio(1); _Pragma("unroll") for (int m = 0; m < 4; ++m) _Pragma("unroll") for (int n = 0; n < 2; ++n) _Pragma("unroll") for (int k = 0; k < 2; ++k) \
        acc[ai][bj][m][n] = __builtin_amdgcn_mfma_f32_16x16x32_bf16(Bt[n][k], At[m][k], acc[ai][bj][m][n], 0, 0, 0); __builtin_amdgcn_s_setprio(0); } while (0)
#define PG8_WAIT_V(n) asm volatile("s_waitcnt vmcnt(" #n ")" ::: "memory")
#define PG8_WAIT_L(n) asm volatile("s_waitcnt lgkmcnt(" #n ")" ::: "memory")
#define PG8_BAR __builtin_amdgcn_s_barrier()
#define PG8_SCHED __builtin_amdgcn_sched_barrier(0)
    Unit cur, nxt; int ui = 0;
    if (!S.next(0, cur)) return;
    f32x4 acc[2][2][4][2];
#pragma unroll
    for (int a = 0; a < 2; ++a)
#pragma unroll
        for (int b = 0; b < 2; ++b)
#pragma unroll
            for (int m = 0; m < 4; ++m)
#pragma unroll
                for (int n = 0; n < 2; ++n) acc[a][b][m][n] = (f32x4){0.f, 0.f, 0.f, 0.f};
    bf16x8 At[4][2], B0[2][2], B1[2][2];
    const char* cA = Sched::MULTI ? cur.a : (const char*)g.A + (size_t)cur.pm * tA + (size_t)cur.pn * acs; const char* cB = Sched::MULTI ? cur.b : (const char*)g.Bt + (size_t)cur.pn * tB;
    if constexpr (Sched::MULTI) nt = cur.nt;
    S.a_ready(cur);
    if constexpr (SP2) {
        PG8_STAGE(PG8_SB(0, 0), cB, voffB); PG8_STAGE(PG8_SB(0, 1), cB + hB, voffB); PG8_STAGE(PG8_SA(0, 0), cA, voffA); PG8_STAGE(PG8_SA(0, 1), cA + hA, voffA);
        if (wr == 1) PG8_BAR;
        PG8_WAIT_V(2); PG8_BAR;
        PG8_STAGE(PG8_SB(1, 0), cB + kstep, voffB); PG8_STAGE(PG8_SA(1, 0), cA + kstep, voffA); PG8_STAGE(PG8_SB(1, 1), cB + hB + kstep, voffB);
        PG8_WAIT_V(6); PG8_BAR;
    } else {
        PG8_STAGE(PG8_SB(0, 0), cB, voffB); PG8_STAGE(PG8_SA(0, 0), cA, voffA); PG8_STAGE(PG8_SB(0, 1), cB + hB, voffB); PG8_STAGE(PG8_SA(0, 1), cA + hA, voffA);
        if (wr == 1) PG8_BAR;
        PG8_WAIT_V(4); PG8_BAR;
        PG8_STAGE(PG8_SB(1, 0), cB + kstep, voffB); PG8_STAGE(PG8_SA(1, 0), cA + kstep, voffA); PG8_STAGE(PG8_SB(1, 1), cB + hB + kstep, voffB);
        PG8_WAIT_V(6); PG8_BAR;
    }
    for (;;) {
        const bool has_next = S.next(ui + 1, nxt);
        const char* nA = has_next ? (Sched::MULTI ? nxt.a : (const char*)g.A + (size_t)nxt.pm * tA + (size_t)nxt.pn * acs) : cA; const char* nB = has_next ? (Sched::MULTI ? nxt.b : (const char*)g.Bt + (size_t)nxt.pn * tB) : cB;
        for (int t = 0; t < nt; t += 2) {
            const bool last = (t == nt - 2);
            const char* a1 = cA + (size_t)(t + 1) * kstep;
            const char* a2 = last ? nA : cA + (size_t)(t + 2) * kstep; const char* b2 = last ? nB : cB + (size_t)(t + 2) * kstep;
            const char* a3 = a2 + kstep; const char* b3 = b2 + kstep;
            if (last && has_next) S.a_ready(nxt);
            if constexpr (SP2) {
            PG8_LDB(B0, 0, 0); PG8_LDB(B1, 0, 1); PG8_SCHED; PG8_LDA(At, 0, 0); PG8_STAGE(PG8_SA(1, 1), a1 + hA, voffA);
            PG8_WAIT_V(8); PG8_WAIT_L(0); PG8_BAR; PG8_MMA(0, 0, At, B0); PG8_MMA(0, 1, At, B1); PG8_BAR; PG8_SCHED;
            PG8_LDA(At, 0, 1); PG8_STAGE(PG8_SB(0, 0), b2, voffB); PG8_STAGE(PG8_SB(0, 1), b2 + hB, voffB); PG8_STAGE(PG8_SA(0, 0), a2, voffA);
            PG8_WAIT_V(8); PG8_WAIT_L(0); PG8_BAR; PG8_MMA(1, 0, At, B0); PG8_MMA(1, 1, At, B1); PG8_BAR; PG8_SCHED;
            PG8_LDB(B0, 1, 0); PG8_LDB(B1, 1, 1); PG8_SCHED; PG8_LDA(At, 1, 0); PG8_STAGE(PG8_SA(0, 1), a2 + hA, voffA);
            PG8_WAIT_V(8); PG8_WAIT_L(0); PG8_BAR; PG8_MMA(0, 0, At, B0); PG8_MMA(0, 1, At, B1); PG8_BAR; PG8_SCHED;
            PG8_LDA(At, 1, 1); PG8_STAGE(PG8_SB(1, 0), b3, voffB); PG8_STAGE(PG8_SB(1, 1), b3 + hB, voffB); PG8_STAGE(PG8_SA(1, 0), a3, voffA);
            PG8_WAIT_V(8); PG8_WAIT_L(0); PG8_BAR; PG8_MMA(1, 0, At, B0); PG8_MMA(1, 1, At, B1); PG8_BAR; PG8_SCHED;
            } else {
            PG8_LDB(B0, 0, 0); PG8_SCHED; PG8_LDA(At, 0, 0); PG8_STAGE(PG8_SA(1, 1), a1 + hA, voffA);
            PG8_WAIT_L(8); PG8_BAR; PG8_WAIT_L(0); PG8_MMA(0, 0, At, B0); PG8_BAR; PG8_SCHED;
            PG8_LDB(B1, 0, 1); PG8_STAGE(PG8_SB(0, 0), b2, voffB);
            PG8_BAR; PG8_WAIT_L(0); PG8_MMA(0, 1, At, B1); PG8_BAR;
            PG8_LDA(At, 0, 1); PG8_STAGE(PG8_SA(0, 0), a2, voffA);
            PG8_BAR; PG8_WAIT_L(0); PG8_MMA(1, 0, At, B0); PG8_BAR; PG8_SCHED;
            PG8_STAGE(PG8_SB(0, 1), b2 + hB, voffB);
            PG8_WAIT_V(6); PG8_BAR; PG8_MMA(1, 1, At, B1); PG8_BAR;
            PG8_LDB(B0, 1, 0); PG8_SCHED; PG8_LDA(At, 1, 0); PG8_STAGE(PG8_SA(0, 1), a2 + hA, voffA);
            PG8_WAIT_L(8); PG8_BAR; PG8_WAIT_L(0); PG8_MMA(0, 0, At, B0); PG8_BAR; PG8_SCHED;
            PG8_LDB(B1, 1, 1); PG8_STAGE(PG8_SB(1, 0), b3, voffB);
            PG8_BAR; PG8_WAIT_L(0); PG8_MMA(0, 1, At, B1); PG8_BAR;
            PG8_LDA(At, 1, 1); PG8_STAGE(PG8_SA(1, 0), a3, voffA);
            PG8_BAR; PG8_WAIT_L(0); PG8_MMA(1, 0, At, B0); PG8_BAR; PG8_SCHED;
            PG8_STAGE(PG8_SB(1, 1), b3 + hB, voffB);
            PG8_WAIT_V(6); PG8_BAR; PG8_MMA(1, 1, At, B1); PG8_BAR;
            }
        }
        if constexpr (ALIGN_EPI) { if (wr == 0) PG8_BAR; }
        PG8_SCHED; asm volatile("" ::: "memory");
        if constexpr (!Epi::AFTER_DRAIN) { int fr2 = fr, fq2 = fq; asm volatile("" : "+v"(fr2), "+v"(fq2));
            E(acc, cur, wr, wc, fr2, fq2); S.done(cur); }
        PG8_SCHED;
        if (!has_next) break;
#pragma unroll
        for (int a = 0; a < 2; ++a)
#pragma unroll
            for (int b = 0; b < 2; ++b)
#pragma unroll
                for (int m = 0; m < 4; ++m)
#pragma unroll
                    for (int n = 0; n < 2; ++n) acc[a][b][m][n] = (f32x4){0.f, 0.f, 0.f, 0.f};
        cur = nxt; cA = nA; cB = nB; ++ui; if constexpr (Sched::MULTI) nt = cur.nt;
        if constexpr (ALIGN_EPI) { if (wr == 1) PG8_BAR; }
    }
    PG8_WAIT_V(0);
    if constexpr (!ALIGN_EPI) { if (wr == 0) PG8_BAR; }
    PG8_BAR;
#undef PG8_SA
#undef PG8_SB
#undef PG8_STAGE
#undef PG8_LDA
#undef PG8_LDB
#undef PG8_MMA
#undef PG8_WAIT_V
#undef PG8_WAIT_L
#undef PG8_BAR
#undef PG8_SCHED
}
}

constexpr int NWAVES = 8;
constexpr int NB = 4, SEQ = 2048, T = NB * SEQ, DM = 4096, BR = 1024, DEPTH = 2;
constexpr int KS = DM + 64;
constexpr int INC = 9552;
constexpr int ZC = 9728;
constexpr int Z_S5U = 0, Z_S5G = 1024, Z_CQ = 2048, Z_CKV = 2816, Z_MG = 3328, Z_GQ = 4352, Z_GK = 4864, Z_GV = 5376, Z_GG = 6400, Z_LU = 7424, Z_LG = 8448, Z_KR = 9472, Z_GLR = 9536;
constexpr int QR = 768, KVR = 512, NH = 8, DQK = 192, DNOPE = 128, DROPE = 64, DV = 128;
constexpr int S5G = 64, S5H = 16, S5P = 64;
constexpr int GH = 4, GDK = 128, GDV = 256;
constexpr float EPS = 1e-6f;

constexpr size_t al256(size_t x) { return (x + 255) & ~(size_t)255; }
constexpr size_t WS_CTL = 0, CTL_ZERO_BYTES = 1u << 16;
constexpr size_t WS_WTIN = CTL_ZERO_BYTES;
constexpr size_t WS_WTOUT = WS_WTIN + (size_t)2 * ZC * KS * 2;
constexpr size_t WS_HB = WS_WTOUT + (size_t)2 * DM * KS * 2;
constexpr size_t WS_Z = WS_HB + (size_t)T * KS * 2;
constexpr size_t WS_XB = WS_Z + (size_t)T * ZC * 2;
constexpr size_t WS_CQB = WS_XB + (size_t)T * DM * 4;
constexpr size_t WS_CKVB = WS_CQB + (size_t)T * BR * 2;
constexpr size_t WS_XCB = WS_CKVB + (size_t)T * BR * 2;
constexpr size_t WS_YS5B = WS_XCB + (size_t)T * BR * 2;
constexpr size_t WS_WTUQ = WS_YS5B + (size_t)T * BR * 2;
constexpr size_t WS_WTUKV = WS_WTUQ + (size_t)2 * 1536 * BR * 2;
constexpr size_t WS_WTGLU = WS_WTUKV + (size_t)2 * 2048 * BR * 2;
constexpr size_t WS_WTLRU = WS_WTGLU + (size_t)2 * BR * BR * 2;
constexpr size_t WS_KR = WS_WTLRU + (size_t)2 * 8 * 256 * 1024 * 2;
constexpr size_t WS_Q = WS_KR + (size_t)T * DROPE * 2;
constexpr size_t WS_KN = WS_Q + (size_t)T * NH * DQK * 2;
constexpr size_t WS_V = WS_KN + (size_t)T * BR * 2;
constexpr size_t WS_KVT = WS_V + (size_t)T * BR * 2;
constexpr size_t WS_ST = WS_KVT + (size_t)512 * 256 * 128 * 4;
constexpr size_t WS_QDEC = WS_ST + (size_t)512 * 256 * 128 * 2;
constexpr size_t WS_DEC = WS_QDEC + (size_t)T * 512 * 2;
constexpr size_t WS_XC = WS_DEC + (size_t)512 * 128 * 4;
constexpr size_t WS_RPRE = WS_XC + (size_t)T * BR * 4;
constexpr size_t WS_IPRE = WS_RPRE + (size_t)T * BR * 4;
constexpr size_t WS_HLRU = WS_IPRE + (size_t)T * BR * 4;
constexpr size_t WS_S5O = WS_HLRU + (size_t)T * BR * 4;
constexpr size_t WS_OGLA = WS_S5O + (size_t)T * BR * 4;
constexpr size_t WS_OMLA = WS_OGLA + (size_t)T * BR * 4;
constexpr size_t WS_ROPE = WS_OMLA + (size_t)T * BR * 4;
constexpr size_t WS_LAMB = WS_ROPE + (size_t)T * 64 * 4;
constexpr size_t WS_BBAR = WS_LAMB + (size_t)2 * 64 * 64 * 2 * 4;
constexpr size_t WS_SPL = WS_BBAR + (size_t)2 * 64 * 64 * 16 * 2 * 4;
constexpr size_t WS_S5A = WS_SPL + (size_t)2 * 1024 * 4;
constexpr size_t WS_S5B1 = WS_S5A + (size_t)64 * 256 * 640 * 2;
constexpr size_t WS_S5B2 = WS_S5B1 + (size_t)64 * 256 * 640 * 2;
constexpr size_t WS_S5L = WS_S5B2 + (size_t)64 * 512 * 640 * 2;
constexpr size_t WS_L32 = WS_S5L + (size_t)64 * 256 * 128 * 4;
constexpr size_t WS_WG2T = WS_L32 + (size_t)64 * 64 * 2 * 4;
constexpr size_t WS_END = WS_WG2T + (size_t)2 * 512 * 16 * 2;
static_assert(WS_END <= 1251999744ull, "d_ws map exceeds the guaranteed workspace");

constexpr int RING_OFF = 0, RING_BYTES = 131072;
constexpr int LDSCTL_OFF = RING_BYTES, MISC_OFF = LDSCTL_OFF + 320;
constexpr int LDS_BYTES = 147456;

#define GAS __attribute__((address_space(1)))
#define LAS __attribute__((address_space(3)))
typedef unsigned short bf16;
typedef unsigned v4u __attribute__((ext_vector_type(4)));
typedef float f32x4 __attribute__((ext_vector_type(4)));
typedef GAS unsigned gu32;
#define RLX_AGENT __ATOMIC_RELAXED, __HIP_MEMORY_SCOPE_AGENT
#define LDS_WAIT() asm volatile("s_waitcnt lgkmcnt(0)" ::: "memory")
__device__ __forceinline__ unsigned f2bf(float f) { unsigned u = __builtin_bit_cast(unsigned, f); return (u + 0x7fffu + ((u >> 16) & 1u)) >> 16; }
__device__ __forceinline__ unsigned pk2(float lo, float hi) { return f2bf(lo) | (f2bf(hi) << 16); }
__device__ __forceinline__ float bf2f(bf16 v) { return __uint_as_float((unsigned)v << 16); }
__device__ __forceinline__ size_t blk4k(size_t r, int k) { return (((r >> 8) * 64 + (size_t)(k >> 6)) << 14) + ((r & 255) << 6) + (size_t)(k & 63); }
__device__ __forceinline__ f32x4 z4(const bf16* p) { const unsigned long long w = *(const unsigned long long*)p; const unsigned a = (unsigned)w, b = (unsigned)(w >> 32); return (f32x4){__uint_as_float(a << 16), __uint_as_float(a & 0xffff0000u), __uint_as_float(b << 16), __uint_as_float(b & 0xffff0000u)}; }

#define XB_TMO      128
#define XB_XCNT(j)  (256  + 64 * (j))
#define XB_XSUB(j)  (1280 + 64 * (j))
#define XB_XGEN(j)  (2304 + 64 * (j))
#define XB_TOP      3328
#define XB_TOPGEN   3392
#define XCD_BAR_WORDS 3456
#define XB_SPIN_CAP (1u << 23)
__device__ __forceinline__ unsigned xb_ld(unsigned* p)              { return __hip_atomic_load(p, __ATOMIC_RELAXED, __HIP_MEMORY_SCOPE_AGENT); }
__device__ __forceinline__ unsigned xb_add(unsigned* p, unsigned v) { return __hip_atomic_fetch_add(p, v, __ATOMIC_RELAXED, __HIP_MEMORY_SCOPE_AGENT); }
__device__ __forceinline__ unsigned xb_xcc_id() { return (unsigned)__builtin_amdgcn_s_getreg((3 << 11) | 20) & 0xFu; }
#define XB_SPIN(cond, bar) do { unsigned _sp = 0; while (cond) { __builtin_amdgcn_s_sleep(1); \
    if ((++_sp & 255u) == 0u) { if (xb_ld(&(bar)[XB_TMO])) break; if (_sp > XB_SPIN_CAP) { atomicAdd(&(bar)[XB_TMO], 1u); break; } } } } while (0)
struct XcdBarrier { unsigned* bar; unsigned x; volatile LAS unsigned* st; };
__device__ __forceinline__ XcdBarrier xcd_barrier_post(unsigned* bar, volatile LAS unsigned* st, const bool t0) {
    XcdBarrier b; b.bar = bar; b.x = xb_xcc_id(); b.st = st;
    if (t0) (void)xb_add(&bar[XB_XCNT(b.x)], 1u);
    return b;
}
__device__ __forceinline__ void xcd_barrier_complete(unsigned* bar, unsigned x, unsigned& nloc, unsigned& nx) {
    const unsigned G = gridDim.x * gridDim.y * gridDim.z;
    unsigned sum, cnt, mine, sp = 0u;
    for (;;) {
        sum = 0u; cnt = 0u; mine = 0u;
#pragma unroll
        for (unsigned j = 0; j < 16; ++j) { const unsigned c = xb_ld(&bar[XB_XCNT(j)]); sum += c; cnt += (c > 0u) ? 1u : 0u; mine = (j == x) ? c : mine; }
        if (sum == G) break;
        __builtin_amdgcn_s_sleep(1);
        if ((++sp & 255u) == 0u) { if (xb_ld(&bar[XB_TMO])) break; if (sp > XB_SPIN_CAP) { atomicAdd(&bar[XB_TMO], 1u); break; } }
    }
    nloc = mine > 0u ? mine : 1u; nx = cnt > 0u ? cnt : 1u;
}
__device__ __forceinline__ void xcd_barrier(const XcdBarrier& b, const bool t0) {
    asm volatile("s_waitcnt vmcnt(0)" ::: "memory");
    __syncthreads();
    if (t0) {
        unsigned* bar = b.bar;
        __builtin_amdgcn_s_waitcnt(0);
        unsigned nloc = b.st[0], nx = b.st[1];
        if (nloc == 0u) { xcd_barrier_complete(bar, b.x, nloc, nx); b.st[0] = nloc; b.st[1] = nx; }
        const unsigned old = xb_add(&bar[XB_XSUB(b.x)], 1u);
        const unsigned gen = old / nloc;
        if (old + 1u == (gen + 1u) * nloc) {
            __builtin_amdgcn_fence(__ATOMIC_RELEASE, "agent");
            asm volatile("s_waitcnt vmcnt(0)" ::: "memory");
            const unsigned og = xb_add(&bar[XB_TOP], 1u);
            const unsigned tg = og / nx;
            if (og + 1u == (tg + 1u) * nx) xb_add(&bar[XB_TOPGEN], 1u);
            else XB_SPIN(xb_ld(&bar[XB_TOPGEN]) == tg, bar);
            __builtin_amdgcn_fence(__ATOMIC_ACQUIRE, "agent");
            xb_add(&bar[XB_XGEN(b.x)], 1u);
            asm volatile("s_waitcnt vmcnt(0)" ::: "memory");
        } else {
            XB_SPIN(xb_ld(&bar[XB_XGEN(b.x)]) == gen, bar);
            __builtin_amdgcn_fence(__ATOMIC_ACQUIRE, "agent");
            asm volatile("s_waitcnt vmcnt(0)" ::: "memory");
        }
    }
    __syncthreads();
}

struct Args { const void* in[34]; float* out; unsigned char* ws; int ph_lo, ph_hi; };
struct Frame {
    LAS unsigned char* lds;
    unsigned char* ldsg;
    int vcu, G, wv;
};
typedef const __attribute__((address_space(4))) Args* ArgsP;
#define IN_F(i) ((const float*)AP->in[i])
#define PHASE_IDS() int lane = lane_id(); asm volatile("" : "+v"(lane)); const int wave = F.wv; const int tid = wave * 64 + lane; (void)tid; \
    ArgsP AP = (ArgsP)__builtin_amdgcn_kernarg_segment_ptr(); asm volatile("" : "+s"(AP))
#define WSF(off) ((float*)(AP->ws + (off)))

__device__ __forceinline__ float wave_sum(float v) {
#pragma unroll
    for (int o = 1; o < 64; o <<= 1) v += __shfl_xor(v, o);
    return v;
}
__device__ __forceinline__ float wave_max(float v) {
#pragma unroll
    for (int o = 1; o < 64; o <<= 1) v = fmaxf(v, __shfl_xor(v, o));
    return v;
}
__device__ __forceinline__ float sigmoidf_(float x) { return __builtin_amdgcn_rcpf(1.0f + __expf(-x)); }
__device__ __forceinline__ float siluf_(float x) { return x * sigmoidf_(x); }
__device__ __forceinline__ float softplusf_(float x) { return fmaxf(x, 0.f) + log1pf(__expf(-fabsf(x))); }
__device__ __forceinline__ float gelu_tanh(float x) { const float u = 0.7978845608028654f * (x + 0.044715f * x * x * x); const float e = __expf(2.f * u); const float th = 1.f - 2.f / (e + 1.f); return 0.5f * x * (1.f + th); }

__device__ __forceinline__ int zc_src(int n) {
    if (n < 3328) return n; if (n < 6400) return n + 64; if (n < 9472) return n + 80; if (n < 9536) return n - 9472 + 3328; if (n < 9552) return n - 9536 + 6464; return -1;
}
template <bool MAPPED>
__device__ __forceinline__ void p0_transpose_item(const float* W, int K, int Nsrc, int Ndst, bf16* WT, LAS float* scr, int item, int lane, int ldw = 0) {
    if (ldw == 0) ldw = K;
    const int nblk = Ndst / 32, kb = item / nblk, nb = item % nblk, k0 = 64 * kb, n0 = 32 * nb;
    const int nd = n0 + (lane & 31); const int ns = MAPPED ? zc_src(nd) : nd;
    float tv[32];
#pragma unroll
    for (int i = 0; i < 32; ++i) { const int kk = 2 * i + (lane >> 5); tv[i] = ns >= 0 ? W[(size_t)(k0 + kk) * Nsrc + ns] : 0.f; }
#pragma unroll
    for (int i = 0; i < 32; ++i) { const int kk = 2 * i + (lane >> 5); scr[kk * 33 + (lane & 31)] = tv[i]; }
    LDS_WAIT(); asm volatile("" ::: "memory");
    const int c = lane & 7;
#pragma unroll
    for (int j = 0; j < 4; ++j) { const int n = (lane >> 3) + 8 * j; const LAS float* s = scr + (8 * c) * 33 + n;
        v4u o; o.x = pk2(s[0 * 33], s[1 * 33]); o.y = pk2(s[2 * 33], s[3 * 33]); o.z = pk2(s[4 * 33], s[5 * 33]); o.w = pk2(s[6 * 33], s[7 * 33]);
        *(GAS v4u*)(WT + (size_t)(n0 + n) * ldw + k0 + 8 * c) = o; }
    LDS_WAIT(); asm volatile("" ::: "memory");
}
template <bool TOBF>
__device__ __forceinline__ void rms_row(const float* xrow, const float* g, void* orow, int lane, size_t mrow = 0) {
    const f32x4* xr = (const f32x4*)xrow + lane; const f32x4* gr = (const f32x4*)g + lane;
    f32x4 v[16], gv[16]; float s = 0.f;
#pragma unroll
    for (int j = 0; j < 16; ++j) { v[j] = xr[64 * j]; gv[j] = gr[64 * j]; s += (v[j].x * v[j].x + v[j].y * v[j].y) + (v[j].z * v[j].z + v[j].w * v[j].w); }
    const float rs = 1.0f / sqrtf(wave_sum(s) * (1.f / DM) + EPS);
    bf16* ob = (bf16*)orow + blk4k(mrow, 4 * lane);
#pragma unroll
    for (int j = 0; j < 16; ++j) { const f32x4 o = v[j] * rs * gv[j];
        if (TOBF) *(unsigned long long*)(ob + ((size_t)j << 16)) = (unsigned long long)pk2(o.x, o.y) | ((unsigned long long)pk2(o.z, o.w) << 32);
        else ((f32x4*)orow)[lane + 64 * j] = o; }
}

constexpr int TP_I_IN = (DM / 64) * (ZC / 32), TP_I_OUT = (DM / 64) * (DM / 32);
constexpr int TP_I_UQ = (QR / 64) * (1536 / 32), TP_I_UK = (KVR / 64) * (BR / 32), TP_I_GLU = (BR / 64) * (BR / 32), TP_I_LRU = 2 * 4;
constexpr int TP_SM = TP_I_UQ + 2 * TP_I_UK + TP_I_GLU + 16 * TP_I_LRU;
constexpr int TP_NL = TP_SM + TP_I_IN + TP_I_OUT;
struct TpD { const float* src; bf16* dst; int nsrc; int ldw; bool ok; };
__device__ __forceinline__ int tp_item_l0(int j) { if (j < TP_SM) return j; j -= TP_SM; if (j < TP_I_IN) return 2 * TP_SM + j; j -= TP_I_IN; return 2 * TP_SM + 2 * TP_I_IN + j; }
__device__ __forceinline__ int tp_item_l1(int j) { if (j < TP_I_IN) return 2 * TP_SM + TP_I_IN + j; j -= TP_I_IN; if (j < TP_SM) return TP_SM + j; j -= TP_SM; return 2 * TP_SM + 2 * TP_I_IN + TP_I_OUT + j; }
__device__ __forceinline__ TpD tp_decode(ArgsP AP, int lane, int it) {
    int r = it; const float* W; int Nsrc, Ndst, ldw; bf16* WT; bool mapped = false;
    if (r < 2 * TP_SM) { const int l = r / TP_SM; r -= l * TP_SM;
        if (r < TP_I_UQ) { W = IN_F(17) + (size_t)l * QR * 1536; Nsrc = 1536; Ndst = 1536; WT = (bf16*)(AP->ws + WS_WTUQ) + (size_t)l * 1536 * BR; ldw = BR; }
        else if ((r -= TP_I_UQ) < TP_I_UK) { W = IN_F(18) + (size_t)l * KVR * BR; Nsrc = BR; Ndst = BR; WT = (bf16*)(AP->ws + WS_WTUKV) + (size_t)l * 2048 * BR; ldw = BR; }
        else if ((r -= TP_I_UK) < TP_I_UK) { W = IN_F(19) + (size_t)l * KVR * BR; Nsrc = BR; Ndst = BR; WT = (bf16*)(AP->ws + WS_WTUKV) + ((size_t)l * 2048 + 1024) * BR; ldw = BR; }
        else if ((r -= TP_I_UK) < TP_I_GLU) { W = IN_F(12) + (size_t)l * BR * BR; Nsrc = BR; Ndst = BR; WT = (bf16*)(AP->ws + WS_WTGLU) + (size_t)l * BR * BR; ldw = BR; }
        else { r -= TP_I_GLU; const int jj = r / TP_I_LRU, gate = jj & 1, j = jj >> 1; r -= jj * TP_I_LRU;
            W = IN_F(gate ? 28 : 26) + (size_t)(l * 8 + j) * 128 * 128; Nsrc = 128; Ndst = 128; WT = (bf16*)(AP->ws + WS_WTLRU) + ((size_t)(l * 8 + j) * 256 + gate * 128) * 1024; ldw = 1024; }
    } else if ((r -= 2 * TP_SM) < 2 * TP_I_IN) { const int l = r / TP_I_IN; r -= l * TP_I_IN; W = IN_F(3) + (size_t)l * DM * INC; Nsrc = INC; Ndst = ZC; WT = (bf16*)(AP->ws + WS_WTIN) + (size_t)l * ZC * KS; ldw = -1; mapped = true; }
    else { r -= 2 * TP_I_IN; const int l = r / TP_I_OUT; r -= l * TP_I_OUT; W = IN_F(32) + (size_t)l * DM * DM; Nsrc = DM; Ndst = DM; WT = (bf16*)(AP->ws + WS_WTOUT) + (size_t)l * DM * KS; ldw = -1; }
    const int nblk = Ndst / 32, kb = r / nblk, nb = r - kb * nblk, k0 = 64 * kb, n0 = 32 * nb;
    const int nd = n0 + (lane & 31); const int ns = mapped ? zc_src(nd) : nd;
    TpD d; d.ok = ns >= 0; d.nsrc = Nsrc; d.ldw = ldw; d.src = W + (size_t)(k0 + (lane >> 5)) * Nsrc + (ns >= 0 ? ns : 0); if (ldw < 0) { d.ldw = 64; d.dst = WT + blk4k((size_t)n0, k0); } else d.dst = WT + (size_t)n0 * ldw + k0;
    return d;
}
__device__ __forceinline__ void tp_finish(const TpD& d, const float (&tv)[32], LAS float* scr, int lane) {
#pragma unroll
    for (int i = 0; i < 32; ++i) { const int kk = 2 * i + (lane >> 5); scr[kk * 33 + (lane & 31)] = tv[i]; }
    LDS_WAIT(); asm volatile("" ::: "memory");
    const int c = lane & 7;
#pragma unroll
    for (int j = 0; j < 4; ++j) { const int n = (lane >> 3) + 8 * j; const LAS float* sp = scr + (8 * c) * 33 + n;
        v4u o; o.x = pk2(sp[0 * 33], sp[1 * 33]); o.y = pk2(sp[2 * 33], sp[3 * 33]); o.z = pk2(sp[4 * 33], sp[5 * 33]); o.w = pk2(sp[6 * 33], sp[7 * 33]);
        *(GAS v4u*)(d.dst + (size_t)n * d.ldw + 8 * c) = o; }
    LDS_WAIT(); asm volatile("" ::: "memory");
}
constexpr int CW_QH = 8192, CW_HC = 8192 + 64;
__device__ __forceinline__ void bg_seam(Frame& F, int k, bool drain) {
    PHASE_IDS();
    LAS float* scr = (LAS float*)(F.lds + RING_OFF + wave * 16384);
    volatile LAS unsigned* bw = (volatile LAS unsigned*)(F.lds + MISC_OFF) + 16;
    unsigned* ctl = (unsigned*)(AP->ws + WS_CTL);
    __syncthreads();
    if (tid == 0) (void)__hip_atomic_fetch_add(ctl + CW_HC + 64 * k, 1u, __ATOMIC_RELAXED, __HIP_MEMORY_SCOPE_AGENT);
    for (;;) {
        if (tid == 0) { unsigned head = 0xffffffffu;
            if (drain || __hip_atomic_load(ctl + CW_HC + 64 * k, __ATOMIC_RELAXED, __HIP_MEMORY_SCOPE_AGENT) < (unsigned)F.G) head = __hip_atomic_fetch_add(ctl + CW_QH, (unsigned)NWAVES, __ATOMIC_RELAXED, __HIP_MEMORY_SCOPE_AGENT);
            bw[0] = head; }
        __syncthreads();
        const unsigned head = bw[0];
        __syncthreads();
        if (head >= (unsigned)TP_NL) break;
        const int j = (int)head + wave;
        if (j < TP_NL) { const TpD d = tp_decode(AP, lane, tp_item_l1(j)); float tv[32];
#pragma unroll
            for (int i = 0; i < 32; ++i) tv[i] = d.ok ? d.src[(size_t)(2 * i) * d.nsrc] : 0.f;
            tp_finish(d, tv, scr, lane); }
    }
}
__device__ __forceinline__ void p0_prologue(Frame& F) {
    PHASE_IDS();
    LAS float* scr = (LAS float*)(F.lds + RING_OFF + wave * 16384);
    const int gw = F.vcu * NWAVES + wave, NGW = F.G * NWAVES;
    float tv[32]; TpD d0 = tp_decode(AP, lane, tp_item_l0(gw < TP_NL ? gw : 0));
    if (gw < TP_NL) {
#pragma unroll
        for (int i = 0; i < 32; ++i) tv[i] = d0.ok ? d0.src[(size_t)(2 * i) * d0.nsrc] : 0.f; }
    for (int it = gw; it < TP_NL; it += NGW) {
        const int itn = it + NGW; const bool more = itn < TP_NL; const TpD d1 = tp_decode(AP, lane, tp_item_l0(more ? itn : it)); float tn[32];
        if (more) {
#pragma unroll
            for (int i = 0; i < 32; ++i) tn[i] = d1.ok ? d1.src[(size_t)(2 * i) * d1.nsrc] : 0.f; }
        tp_finish(d0, tv, scr, lane);
        d0 = d1;
        if (more) {
#pragma unroll
            for (int i = 0; i < 32; ++i) tv[i] = tn[i]; }
    }
    { const int* pos = (const int*)AP->in[1]; float* rt = WSF(WS_ROPE);
      for (int e = blockIdx.x * 512 + tid; e < T * 32; e += F.G * 512) { const int m = e >> 5, i = e & 31;
          const double invf = exp(-(double)i * (9.210340371976184 / 32.0));
          double ang = (double)pos[m] * invf; const double k = rint(ang * 0.15915494309189535); ang -= k * 6.283185307179586;
          const float a = (float)ang; rt[m * 64 + i] = cosf(a); rt[m * 64 + 32 + i] = sinf(a); } }
    { float* lb = WSF(WS_LAMB); float* bb = WSF(WS_BBAR);
      for (int e = blockIdx.x * 512 + tid; e < 2 * 64 * 64; e += F.G * 512) { const int l = e >> 12, g = (e >> 6) & 63;
          const float lre = IN_F(4)[e], lim = IN_F(5)[e]; const float dt = expf(IN_F(11)[l * 64 + g]);
          const float mag = expf(lre * dt); float sn, cs; sincosf(lim * dt, &sn, &cs);
          const float bre = mag * cs, bim = mag * sn; lb[2 * e] = bre; lb[2 * e + 1] = bim;
          const float nre = bre - 1.f, nim = bim, den = 1.f / (lre * lre + lim * lim);
          const float fre = (nre * lre + nim * lim) * den, fim = (nim * lre - nre * lim) * den;
          float brv[16], biv[16];
#pragma unroll
          for (int h = 0; h < 16; ++h) { brv[h] = IN_F(6)[e * 16 + h]; biv[h] = IN_F(7)[e * 16 + h]; }
#pragma unroll
          for (int h = 0; h < 16; ++h) { bb[(e * 16 + h) * 2] = fre * brv[h] - fim * biv[h]; bb[(e * 16 + h) * 2 + 1] = fre * biv[h] + fim * brv[h]; } } }
    for (int e = blockIdx.x * 512 + tid; e < 2 * BR; e += F.G * 512) WSF(WS_SPL)[e] = softplusf_(-IN_F(30)[e]);
    for (int e = blockIdx.x * 512 + tid; e < 2 * 512 * 16; e += F.G * 512) { const int l = e >> 13, col = (e >> 4) & 511, r = e & 15; ((bf16*)(AP->ws + WS_WG2T))[e] = (bf16)f2bf(IN_F(21)[(size_t)(l * 16 + r) * 512 + col]); }
    for (int m = gw; m < T; m += NGW) { asm volatile("" ::: "memory");  rms_row<true>(IN_F(0) + (size_t)m * DM, IN_F(2), (bf16*)(AP->ws + WS_HB), lane, (size_t)m); }
}

__device__ __forceinline__ void up8(const v4u w, float (&f)[8]) {
#pragma unroll
    for (int i = 0; i < 4; ++i) { f[2 * i] = __uint_as_float(w[i] << 16); f[2 * i + 1] = __uint_as_float(w[i] & 0xffff0000u); } }
__device__ __forceinline__ v4u pk8(const float (&f)[8]) { return (v4u){pk2(f[0], f[1]), pk2(f[2], f[3]), pk2(f[4], f[5]), pk2(f[6], f[7])}; }
__device__ __forceinline__ void p2_rows(Frame& F, int l) {
    PHASE_IDS();
    const int gw = F.vcu * NWAVES + wave, NGW = F.G * NWAVES;
    const bf16* z = (const bf16*)(AP->ws + WS_Z);
    const v4u zero = (v4u){0u, 0u, 0u, 0u};
    const f32x4 gq0 = *(const f32x4*)(IN_F(15) + l * QR + 8 * lane), gq1 = *(const f32x4*)(IN_F(15) + l * QR + 8 * lane + 4);
    const f32x4 hq0 = lane < 32 ? *(const f32x4*)(IN_F(15) + l * QR + 512 + 8 * lane) : (f32x4){0.f, 0.f, 0.f, 0.f}, hq1 = lane < 32 ? *(const f32x4*)(IN_F(15) + l * QR + 512 + 8 * lane + 4) : (f32x4){0.f, 0.f, 0.f, 0.f};
    const f32x4 gk0 = *(const f32x4*)(IN_F(16) + l * KVR + 8 * lane), gk1 = *(const f32x4*)(IN_F(16) + l * KVR + 8 * lane + 4);
    f32x4 cb0[2], cb1[2], cw0[2][4], cw1[2][4];
#pragma unroll
    for (int j = 0; j < 2; ++j) { const int c0 = 8 * (lane + 64 * j); cb0[j] = *(const f32x4*)(IN_F(25) + l * BR + c0); cb1[j] = *(const f32x4*)(IN_F(25) + l * BR + c0 + 4);
#pragma unroll
        for (int w = 0; w < 4; ++w) { cw0[j][w] = *(const f32x4*)(IN_F(24) + (l * 4 + w) * BR + c0); cw1[j][w] = *(const f32x4*)(IN_F(24) + (l * 4 + w) * BR + c0 + 4); } }
    for (int m = gw; m < T; m += NGW) {
        asm volatile("" ::: "memory");
        const bf16* zr = z + (size_t)m * ZC; const int t = m & (SEQ - 1);
        const v4u cq0 = *(const v4u*)(zr + Z_CQ + 8 * lane), cq1 = lane < 32 ? *(const v4u*)(zr + Z_CQ + 512 + 8 * lane) : zero, ckv = *(const v4u*)(zr + Z_CKV + 8 * lane);
        v4u lu[2][4];
#pragma unroll
        for (int j = 0; j < 2; ++j)
#pragma unroll
            for (int w = 0; w < 4; ++w) lu[j][w] = (t - 3 + w >= 0) ? *(const v4u*)(z + (size_t)(m - 3 + w) * ZC + Z_LU + 8 * (lane + 64 * j)) : zero;
        const int l5 = lane & 31;
        const float kx1 = bf2f(zr[Z_KR + l5]), kx2 = bf2f(zr[Z_KR + 32 + l5]), kc = WSF(WS_ROPE)[m * 64 + l5], ksn = WSF(WS_ROPE)[m * 64 + 32 + l5];
        { float a[8], b[8]; up8(cq0, a); up8(cq1, b); float s = 0.f;
#pragma unroll
          for (int e = 0; e < 8; ++e) s += a[e] * a[e] + b[e] * b[e];
          const float rs = 1.0f / sqrtf(wave_sum(s) * (1.f / QR) + EPS);
          const float gg[8] = {gq0.x, gq0.y, gq0.z, gq0.w, gq1.x, gq1.y, gq1.z, gq1.w}, hg[8] = {hq0.x, hq0.y, hq0.z, hq0.w, hq1.x, hq1.y, hq1.z, hq1.w};
#pragma unroll
          for (int e = 0; e < 8; ++e) { a[e] *= rs * gg[e]; b[e] *= rs * hg[e]; }
          *(v4u*)((bf16*)(AP->ws + WS_CQB) + (size_t)m * BR + 8 * lane) = pk8(a);
          if (lane < 32) *(v4u*)((bf16*)(AP->ws + WS_CQB) + (size_t)m * BR + 512 + 8 * lane) = pk8(b); }
        { float a[8]; up8(ckv, a); float s = 0.f;
#pragma unroll
          for (int e = 0; e < 8; ++e) s += a[e] * a[e];
          const float rs = 1.0f / sqrtf(wave_sum(s) * (1.f / KVR) + EPS);
          const float gg[8] = {gk0.x, gk0.y, gk0.z, gk0.w, gk1.x, gk1.y, gk1.z, gk1.w};
#pragma unroll
          for (int e = 0; e < 8; ++e) a[e] *= rs * gg[e];
          *(v4u*)((bf16*)(AP->ws + WS_CKVB) + (size_t)m * BR + 8 * lane) = pk8(a); }
        if (lane < 32) { ((bf16*)(AP->ws + WS_KR))[m * 64 + lane] = (bf16)f2bf(kx1 * kc - kx2 * ksn); ((bf16*)(AP->ws + WS_KR))[m * 64 + 32 + lane] = (bf16)f2bf(kx2 * kc + kx1 * ksn); }
#pragma unroll
        for (int j = 0; j < 2; ++j) { const int c0 = 8 * (lane + 64 * j); float o[8] = {cb0[j].x, cb0[j].y, cb0[j].z, cb0[j].w, cb1[j].x, cb1[j].y, cb1[j].z, cb1[j].w};
#pragma unroll
            for (int w = 0; w < 4; ++w) { float xv[8]; up8(lu[j][w], xv); const f32x4 w0 = cw0[j][w], w1 = cw1[j][w];
                o[0] += w0.x * xv[0]; o[1] += w0.y * xv[1]; o[2] += w0.z * xv[2]; o[3] += w0.w * xv[3]; o[4] += w1.x * xv[4]; o[5] += w1.y * xv[5]; o[6] += w1.z * xv[6]; o[7] += w1.w * xv[7]; }
            *(v4u*)((bf16*)(AP->ws + WS_XCB) + (size_t)m * BR + c0) = pk8(o); }
    }
}
__device__ __forceinline__ void s5_prep(Frame& F, int l, int g) {
    PHASE_IDS();
    LAS unsigned char* L = F.lds + RING_OFF;
    LAS float* PW = (LAS float*)L;
    LAS float* BB = PW + 33 * 128;
    LAS float* CC = BB + 2048;
    LAS float* KK = CC + 2048;
    const int lg = l * 64 + g;
    __syncthreads();
    for (int idx = tid; idx < 33 * 64; idx += 512) { const int tau = idx >> 6, p = idx & 63;
        const float lre = IN_F(4)[lg * 64 + p], lim = IN_F(5)[lg * 64 + p], dt = expf(IN_F(11)[lg]);
        const float mag = expf((float)tau * lre * dt); float sn, cs; sincosf((float)tau * lim * dt, &sn, &cs);
        PW[idx * 2] = mag * cs; PW[idx * 2 + 1] = mag * sn;
        if (tau == 32) { WSF(WS_L32)[(g * 64 + p) * 2] = mag * cs; WSF(WS_L32)[(g * 64 + p) * 2 + 1] = mag * sn; } }
    for (int idx = tid; idx < 1024; idx += 512) { BB[idx * 2] = WSF(WS_BBAR)[((size_t)lg * 1024 + idx) * 2]; BB[idx * 2 + 1] = WSF(WS_BBAR)[((size_t)lg * 1024 + idx) * 2 + 1];
        CC[idx * 2] = IN_F(8)[(size_t)lg * 1024 + idx]; CC[idx * 2 + 1] = IN_F(9)[(size_t)lg * 1024 + idx]; }
    __syncthreads();
    {
      const int tau = tid >> 4, h = tid & 15; float acc[16];
#pragma unroll
      for (int j = 0; j < 16; ++j) acc[j] = 0.f;
      for (int p = 0; p < 64; ++p) { const float cr = CC[(h * 64 + p) * 2], ci = CC[(h * 64 + p) * 2 + 1], pr = PW[(tau * 64 + p) * 2], pi = PW[(tau * 64 + p) * 2 + 1];
          const float xr = cr * pr - ci * pi, xi = cr * pi + ci * pr;
#pragma unroll
          for (int j = 0; j < 16; ++j) acc[j] += xr * BB[(p * 16 + j) * 2] - xi * BB[(p * 16 + j) * 2 + 1]; }
      if (tau == 0) acc[h] += IN_F(10)[lg * 16 + h];
#pragma unroll
      for (int j = 0; j < 16; ++j) KK[tau * 256 + h * 16 + j] = acc[j]; }
    __syncthreads();
    bf16* B2 = (bf16*)(AP->ws + WS_S5B2) + (size_t)g * 512 * 640; bf16* B1 = (bf16*)(AP->ws + WS_S5B1) + (size_t)g * 256 * 640;
    for (int idx = tid; idx < 512 * 80; idx += 512) { const int R = idx / 80, ch = idx - R * 80, t = R >> 4, h = R & 15; float v[8];
        if (ch < 64) { const int sidx = ch >> 1, h0 = (ch & 1) * 8;
#pragma unroll
            for (int j = 0; j < 8; ++j) v[j] = (t >= sidx) ? KK[(t - sidx) * 256 + h * 16 + h0 + j] : 0.f; }
        else { const int q = ch - 64;
#pragma unroll
            for (int j = 0; j < 8; j += 2) { const int p = 4 * q + (j >> 1); const float cr = CC[(h * 64 + p) * 2], ci = CC[(h * 64 + p) * 2 + 1], pr = PW[((t + 1) * 64 + p) * 2], pi = PW[((t + 1) * 64 + p) * 2 + 1];
                v[j] = cr * pr - ci * pi; v[j + 1] = -(cr * pi + ci * pr); } }
        *(v4u*)(B2 + (size_t)R * 640 + ch * 8) = (v4u){pk2(v[0], v[1]), pk2(v[2], v[3]), pk2(v[4], v[5]), pk2(v[6], v[7])}; }
    for (int idx = tid; idx < 128 * 64; idx += 512) { const int R = idx >> 6, ch = idx & 63, p = R >> 1, ri = R & 1, sidx = ch >> 1, h0 = (ch & 1) * 8; float v[8];
        const float pr = PW[((31 - sidx) * 64 + p) * 2], pi = PW[((31 - sidx) * 64 + p) * 2 + 1];
#pragma unroll
        for (int j = 0; j < 8; ++j) { const float br = BB[(p * 16 + h0 + j) * 2], bi = BB[(p * 16 + h0 + j) * 2 + 1]; v[j] = ri ? (pr * bi + pi * br) : (pr * br - pi * bi); }
        *(v4u*)(B1 + (size_t)R * 640 + ch * 8) = (v4u){pk2(v[0], v[1]), pk2(v[2], v[3]), pk2(v[4], v[5]), pk2(v[6], v[7])}; }
    __syncthreads();
}
__device__ __forceinline__ void s5_stage(Frame& F) {
    PHASE_IDS();
    const int gw = F.vcu * NWAVES + wave, NGW = F.G * NWAVES;
    const bf16* z = (const bf16*)(AP->ws + WS_Z); bf16* A = (bf16*)(AP->ws + WS_S5A);
    const int sidx = lane >> 1, hf = lane & 1;
    for (int it0 = gw; it0 < 64 * 256; it0 += 8 * NGW) {
        v4u v[8];
#pragma unroll
        for (int q = 0; q < 8; ++q) { const int it = it0 + q * NGW; if (it < 64 * 256) { const int g = it & 63, r = it >> 6; const size_t m = (size_t)(r >> 6) * 2048 + (size_t)(r & 63) * 32 + sidx;
                v[q] = *(const v4u*)(z + m * ZC + Z_S5U + g * 16 + hf * 8); } }
#pragma unroll
        for (int q = 0; q < 8; ++q) { const int it = it0 + q * NGW; if (it < 64 * 256) { const int g = it & 63, r = it >> 6;
                *(v4u*)(A + ((size_t)g * 256 + r) * 640 + sidx * 16 + hf * 8) = v[q]; } }
    }
}
__device__ __forceinline__ void s5_scan(Frame& F, int g) {
    PHASE_IDS();
    asm volatile("s_waitcnt vmcnt(0)" ::: "memory"); __syncthreads();
    if (tid < 256) { const int b = tid >> 6, p = tid & 63; const float lr = WSF(WS_L32)[(g * 64 + p) * 2], li = WSF(WS_L32)[(g * 64 + p) * 2 + 1];
        const float* sl = WSF(WS_S5L) + ((size_t)g * 256 + b * 64) * 128 + 2 * p; bf16* A = (bf16*)(AP->ws + WS_S5A) + ((size_t)g * 256 + b * 64) * 640 + 512 + 2 * p;
        float xr = 0.f, xi = 0.f; float sre[64], sim[64];
#pragma unroll
        for (int c = 0; c < 64; ++c) { sre[c] = sl[(size_t)c * 128]; sim[c] = sl[(size_t)c * 128 + 1]; }
#pragma unroll
        for (int c = 0; c < 64; ++c) { *(unsigned*)(A + (size_t)c * 640) = pk2(xr, xi);
            const float nr = lr * xr - li * xi + sre[c], ni = lr * xi + li * xr + sim[c]; xr = nr; xi = ni; } }
    asm volatile("s_waitcnt vmcnt(0)" ::: "memory"); __syncthreads();
}
typedef short bf16x8_t __attribute__((ext_vector_type(8)));
typedef float f32x16_t __attribute__((ext_vector_type(16)));
typedef short s16x4_t __attribute__((ext_vector_type(4)));
typedef unsigned u32x4_t __attribute__((ext_vector_type(4)));
__device__ __forceinline__ unsigned cvtpk_s(float lo, float hi) { typedef float f2 __attribute__((ext_vector_type(2))); typedef __bf16 b2 __attribute__((ext_vector_type(2))); f2 v = {lo, hi}; b2 b = __builtin_convertvector(v, b2); return __builtin_bit_cast(unsigned, b); }
constexpr int G1_LA = 0, G1_QD = 32768, G1_QSTR = 272, G1_KI = G1_QD + 64 * G1_QSTR, G1_KD = G1_KI + 64 * G1_QSTR, G1_KDSTR = 320, G1_V = G1_KD + 64 * G1_KDSTR, G1_VSTR = 576, G1_GL = G1_V + 64 * G1_VSTR;
static_assert(G1_GL + 4096 <= RING_BYTES, "GLA LDS map");
__device__ __forceinline__ bf16x8_t tr_frag(const LAS unsigned char* p, int hi_off) {
    const s16x4_t lo = __builtin_bit_cast(s16x4_t, __builtin_amdgcn_ds_read_tr16_b64_v4i16((LAS s16x4_t*)p));
    const s16x4_t hi = __builtin_bit_cast(s16x4_t, __builtin_amdgcn_ds_read_tr16_b64_v4i16((LAS s16x4_t*)(p + hi_off)));
    return (bf16x8_t){lo[0], lo[1], lo[2], lo[3], hi[0], hi[1], hi[2], hi[3]};
}
__device__ __forceinline__ void gla_g1(Frame& F, int l) {
    PHASE_IDS();
    const int hh = lane >> 5, r32 = lane & 31;
    LAS unsigned char* L = F.lds + RING_OFF;
    LAS float* LA = (LAS float*)(L + G1_LA); LAS float* GL = (LAS float*)(L + G1_GL);
    const bf16* z = (const bf16*)(AP->ws + WS_Z);
    for (int k = 0; k < 3; ++k) {
        const int u = F.vcu < 64 ? (k == 0 ? F.vcu : -1) : 64 + (F.vcu - 64) + 192 * k;
        if (u < 0 || u >= 512) break;
        const int bh = u >> 5, n = u & 31, b = bh >> 2, h = bh & 3;
        const size_t m0 = (size_t)b * SEQ + 64 * n;
        __syncthreads();
#pragma unroll
        for (int r = 0; r < 8; ++r) { const int idx = tid + 512 * r, row = idx >> 6, c4 = (idx & 63) * 4;
            *(LAS unsigned long long*)(L + G1_V + row * G1_VSTR + c4 * 2) = *(const unsigned long long*)(z + (m0 + row) * ZC + Z_GV + h * 256 + c4); }
        const int c = tid >> 3, d0 = (tid & 7) * 16;
        {
          const int cbk = wave & 1, dbk = wave >> 1;
          const bf16x8_t af = *(const bf16x8_t*)(z + (m0 + 32 * cbk + r32) * ZC + Z_GLR + 8 * hh);
          const bf16x8_t wf = *(const bf16x8_t*)((const bf16*)(AP->ws + WS_WG2T) + ((size_t)(l * 512 + h * 128 + 32 * dbk + r32)) * 16 + 8 * hh);
          const float bias = IN_F(22)[l * 512 + h * 128 + 32 * dbk + r32];
          f32x16_t D;
#pragma unroll
          for (int r = 0; r < 16; ++r) D[r] = 0.f;
          D = __builtin_amdgcn_mfma_f32_32x32x16_bf16(af, wf, D, 0, 0, 0);
#pragma unroll
          for (int r = 0; r < 16; ++r) { const float x = -(D[r] + bias); const float la = -(fmaxf(x, 0.f) + __logf(1.f + __expf(-fabsf(x)))) * (1.f / 16.f);
              LA[(32 * cbk + (r & 3) + 8 * (r >> 2) + 4 * hh) * 128 + 32 * dbk + r32] = la; } }
        __syncthreads();
        {
          const int col = tid & 127, seg = tid >> 7; float v[16]; float run = 0.f;
#pragma unroll
          for (int i = 0; i < 16; ++i) { run += LA[(16 * seg + i) * 128 + col]; v[i] = run; }
          GL[seg * 128 + col] = run;
          __syncthreads();
          float pre = 0.f;
#pragma unroll
          for (int s2 = 0; s2 < 3; ++s2) pre += (s2 < seg) ? GL[s2 * 128 + col] : 0.f;
#pragma unroll
          for (int i = 0; i < 16; ++i) LA[(16 * seg + i) * 128 + col] = v[i] + pre; }
        __syncthreads();
        {
          const bf16* qp = z + (m0 + c) * ZC + Z_GQ + h * 128 + d0; const bf16* kp = z + (m0 + c) * ZC + Z_GK + h * 128 + d0;
          bf16* qg = (bf16*)(AP->ws + WS_QDEC) + (m0 + c) * 512 + h * 128 + d0;
          f32x4 qv[4], kv4[4];
#pragma unroll
          for (int e4 = 0; e4 < 4; ++e4) { qv[e4] = z4(qp + 4 * e4); kv4[e4] = z4(kp + 4 * e4); }
#pragma unroll
          for (int e4 = 0; e4 < 4; ++e4) { const f32x4 q4 = qv[e4], k4 = kv4[e4]; const f32x4 cu = *(const LAS f32x4*)(LA + c * 128 + d0 + 4 * e4), to = *(const LAS f32x4*)(LA + 63 * 128 + d0 + 4 * e4);
              float qd[4], ki[4], kd[4];
#pragma unroll
              for (int e = 0; e < 4; ++e) { const float ec = __expf(cu[e]), ei = __builtin_amdgcn_rcpf(ec), et = __expf(to[e]); qd[e] = q4[e] * 0.08838834764831845f * ec; ki[e] = k4[e] * ei; kd[e] = ki[e] * et; }
              const unsigned long long qw = (unsigned long long)cvtpk_s(qd[0], qd[1]) | ((unsigned long long)cvtpk_s(qd[2], qd[3]) << 32);
              *(LAS unsigned long long*)(L + G1_QD + c * G1_QSTR + (d0 + 4 * e4) * 2) = qw; *(unsigned long long*)(qg + 4 * e4) = qw;
              *(LAS unsigned long long*)(L + G1_KI + c * G1_QSTR + (d0 + 4 * e4) * 2) = (unsigned long long)cvtpk_s(ki[0], ki[1]) | ((unsigned long long)cvtpk_s(ki[2], ki[3]) << 32);
              *(LAS unsigned long long*)(L + G1_KD + c * G1_KDSTR + (d0 + 4 * e4) * 2) = (unsigned long long)cvtpk_s(kd[0], kd[1]) | ((unsigned long long)cvtpk_s(kd[2], kd[3]) << 32); }
          if (tid < 128) WSF(WS_DEC)[u * 128 + tid] = __expf(LA[63 * 128 + tid]); }
        __syncthreads();
        { const int cb = wave & 1, dvg = wave >> 1;
          f32x16_t S0, S1;
#pragma unroll
          for (int r = 0; r < 16; ++r) { S0[r] = 0.f; S1[r] = 0.f; }
          const LAS unsigned char* qa = L + G1_QD + (32 * cb + r32) * G1_QSTR + hh * 16; const LAS unsigned char* ka = L + G1_KI + r32 * G1_QSTR + hh * 16;
          bf16x8_t qf[8], kf0[8], kf1[8];
#pragma unroll
          for (int ks = 0; ks < 8; ++ks) { qf[ks] = *(const LAS bf16x8_t*)(qa + ks * 32); kf0[ks] = *(const LAS bf16x8_t*)(ka + ks * 32); kf1[ks] = *(const LAS bf16x8_t*)(ka + 32 * G1_QSTR + ks * 32); }
          __builtin_amdgcn_sched_barrier(0);
#pragma unroll
          for (int ks = 0; ks < 8; ++ks) { S0 = __builtin_amdgcn_mfma_f32_32x32x16_bf16(kf0[ks], qf[ks], S0, 0, 0, 0);
              if (cb) S1 = __builtin_amdgcn_mfma_f32_32x32x16_bf16(kf1[ks], qf[ks], S1, 0, 0, 0); }
          const LAS unsigned char* va = L + G1_V + (4 * hh + ((lane & 15) >> 2)) * G1_VSTR + (64 * dvg + ((lane >> 4) & 1) * 16 + (lane & 3) * 4) * 2;
          bf16x8_t vf[2][4];
#pragma unroll
          for (int dvb = 0; dvb < 2; ++dvb)
#pragma unroll
              for (int f = 0; f < 4; ++f) vf[dvb][f] = tr_frag(va + (32 * (f >> 1) + 16 * (f & 1)) * G1_VSTR + dvb * 64, 8 * G1_VSTR);
          __builtin_amdgcn_sched_barrier(0);
#pragma unroll
          for (int r = 0; r < 16; ++r) { const int sl = (r & 3) + 8 * (r >> 2) + 4 * hh; if (sl > r32) { if (cb) S1[r] = 0.f; else S0[r] = 0.f; } }
          bf16x8_t pf[2][2];
#pragma unroll
          for (int s2 = 0; s2 < 2; ++s2) { u32x4_t a, c2;
#pragma unroll
              for (int w = 0; w < 4; ++w) { a[w] = cvtpk_s(S0[8 * s2 + 2 * w], S0[8 * s2 + 2 * w + 1]); c2[w] = cvtpk_s(S1[8 * s2 + 2 * w], S1[8 * s2 + 2 * w + 1]); }
              pf[0][s2] = __builtin_bit_cast(bf16x8_t, a); pf[1][s2] = __builtin_bit_cast(bf16x8_t, c2); }
          float* op = WSF(WS_OGLA) + (m0 + 32 * cb + r32) * BR + h * 256 + 64 * dvg + 4 * hh;
#pragma unroll
          for (int dvb = 0; dvb < 2; ++dvb) { f32x16_t O;
#pragma unroll
              for (int r = 0; r < 16; ++r) O[r] = 0.f;
#pragma unroll
              for (int s2 = 0; s2 < 2; ++s2) { O = __builtin_amdgcn_mfma_f32_32x32x16_bf16(vf[dvb][s2], pf[0][s2], O, 0, 0, 0);
                  if (cb) O = __builtin_amdgcn_mfma_f32_32x32x16_bf16(vf[dvb][2 + s2], pf[1][s2], O, 0, 0, 0); }
#pragma unroll
              for (int cq = 0; cq < 4; ++cq) *(f32x4*)(op + 32 * dvb + 8 * cq) = (f32x4){O[4 * cq], O[4 * cq + 1], O[4 * cq + 2], O[4 * cq + 3]}; } }
        { f32x16_t KV[4];
#pragma unroll
          for (int j = 0; j < 4; ++j)
#pragma unroll
              for (int r = 0; r < 16; ++r) KV[j][r] = 0.f;
          const int rowl = 8 * hh + ((lane & 15) >> 2), coll = ((lane >> 4) & 1) * 16 + (lane & 3) * 4;
          const LAS unsigned char* va = L + G1_V + rowl * G1_VSTR + (32 * wave + coll) * 2; const LAS unsigned char* ka = L + G1_KD + rowl * G1_KDSTR + coll * 2;
          bf16x8_t vfr[4], kfr[4][4];
#pragma unroll
          for (int ks = 0; ks < 4; ++ks) { vfr[ks] = tr_frag(va + 16 * ks * G1_VSTR, 4 * G1_VSTR);
#pragma unroll
              for (int j = 0; j < 4; ++j) kfr[ks][j] = tr_frag(ka + 16 * ks * G1_KDSTR + j * 64, 4 * G1_KDSTR); }
          __builtin_amdgcn_sched_barrier(0);
#pragma unroll
          for (int ks = 0; ks < 4; ++ks)
#pragma unroll
              for (int j = 0; j < 4; ++j) KV[j] = __builtin_amdgcn_mfma_f32_32x32x16_bf16(kfr[ks][j], vfr[ks], KV[j], 0, 0, 0);
          bf16* kp = (bf16*)(AP->ws + WS_KVT) + ((size_t)u * 256 + 32 * wave + r32) * 128 + 4 * hh;
#pragma unroll
          for (int j = 0; j < 4; ++j)
#pragma unroll
              for (int cq = 0; cq < 4; ++cq) *(unsigned long long*)(kp + 32 * j + 8 * cq) = (unsigned long long)cvtpk_s(KV[j][4 * cq], KV[j][4 * cq + 1]) | ((unsigned long long)cvtpk_s(KV[j][4 * cq + 2], KV[j][4 * cq + 3]) << 32); }
    }
    __syncthreads();
}
__device__ __forceinline__ void gla_g2(Frame& F) {
    PHASE_IDS();
    const bf16* kvt = (const bf16*)(AP->ws + WS_KVT); const float* dec = WSF(WS_DEC); bf16* st = (bf16*)(AP->ws + WS_ST);
    constexpr int NG = 16 * 32768 / 4, NA = 65536;
    const int bx = (int)blockIdx.x; const bool clsA = bx < 128;
    for (int e = (clsA ? 0 : NA) + (clsA ? bx : bx - 128) * 512 + tid; e < (clsA ? NA : NG); e += 128 * 512) {
        const int bh = e >> 13, rem = (e & 8191) * 4, dk = rem & 127; f32x4 S = (f32x4){0.f, 0.f, 0.f, 0.f};
#pragma unroll 1
        for (int n0 = 0; n0 < 32; n0 += 16) {
            f32x4 dv[16]; unsigned long long kw[16];
#pragma unroll
            for (int n = 0; n < 16; ++n) { const size_t ch = (size_t)bh * 32 + n0 + n; dv[n] = *(const f32x4*)(dec + ch * 128 + dk); kw[n] = *(const unsigned long long*)(kvt + ch * 32768 + rem); }
#pragma unroll
            for (int n = 0; n < 16; ++n) { const size_t ch = (size_t)bh * 32 + n0 + n;
                *(unsigned long long*)(st + ch * 32768 + rem) = (unsigned long long)pk2(S.x, S.y) | ((unsigned long long)pk2(S.z, S.w) << 32);
                const unsigned a = (unsigned)kw[n], b = (unsigned)(kw[n] >> 32);
                S = dv[n] * S + (f32x4){__uint_as_float(a << 16), __uint_as_float(a & 0xffff0000u), __uint_as_float(b << 16), __uint_as_float(b & 0xffff0000u)}; } }
    }
}
__device__ __forceinline__ void gla_g3(Frame& F, int l) {
    PHASE_IDS();
    const int hh = lane >> 5, r32 = lane & 31;
    LAS float* SS = (LAS float*)(F.lds + RING_OFF);
    const bf16* z = (const bf16*)(AP->ws + WS_Z); bf16* yb = (bf16*)(AP->ws + WS_HB);
    for (int u = F.vcu; u < 512; u += F.G) {
        const int bh = u >> 5, n = u & 31, b = bh >> 2, h = bh & 3;
        const size_t m0 = (size_t)b * SEQ + 64 * n;
        const bf16* sp = (const bf16*)(AP->ws + WS_ST) + ((size_t)u * 256 + 32 * wave + r32) * 128 + 8 * hh;
        const int dvb = h * 256 + 32 * wave + 4 * hh;
        bf16x8_t af[8], qf[2][8]; f32x4 oiv[2][4], g4v[4]; unsigned long long gtw[2][4];
#pragma unroll
        for (int ks = 0; ks < 8; ++ks) af[ks] = *(const bf16x8_t*)(sp + 16 * ks);
#pragma unroll
        for (int cb = 0; cb < 2; ++cb) { const size_t m = m0 + 32 * cb + r32; const bf16* qd = (const bf16*)(AP->ws + WS_QDEC) + m * 512 + h * 128 + 8 * hh;
#pragma unroll
            for (int ks = 0; ks < 8; ++ks) qf[cb][ks] = *(const bf16x8_t*)(qd + 16 * ks);
#pragma unroll
            for (int cq = 0; cq < 4; ++cq) { oiv[cb][cq] = *(const f32x4*)(WSF(WS_OGLA) + m * BR + dvb + 8 * cq); gtw[cb][cq] = *(const unsigned long long*)(z + m * ZC + Z_GG + dvb + 8 * cq); } }
#pragma unroll
        for (int cq = 0; cq < 4; ++cq) g4v[cq] = *(const f32x4*)(IN_F(23) + l * BR + dvb + 8 * cq);
        f32x16_t D[2];
#pragma unroll
        for (int cb = 0; cb < 2; ++cb) {
#pragma unroll
            for (int r = 0; r < 16; ++r) D[cb][r] = 0.f;
#pragma unroll
            for (int ks = 0; ks < 8; ++ks) D[cb] = __builtin_amdgcn_mfma_f32_32x32x16_bf16(af[ks], qf[cb][ks], D[cb], 0, 0, 0);
            float q = 0.f;
#pragma unroll
            for (int cq = 0; cq < 4; ++cq)
#pragma unroll
                for (int e = 0; e < 4; ++e) { D[cb][4 * cq + e] += oiv[cb][cq][e]; q += D[cb][4 * cq + e] * D[cb][4 * cq + e]; }
            q += __shfl_xor(q, 32);
            if (hh == 0) SS[wave * 64 + 32 * cb + r32] = q; }
        __syncthreads();
#pragma unroll
        for (int cb = 0; cb < 2; ++cb) { float tot = 0.f;
#pragma unroll
            for (int w = 0; w < 8; ++w) tot += SS[w * 64 + 32 * cb + r32];
            const float rs = 1.0f / sqrtf(tot * (1.f / 256.f) + EPS); const size_t m = m0 + 32 * cb + r32;
#pragma unroll
            for (int cq = 0; cq < 4; ++cq) { const f32x4 g4 = g4v[cq]; const unsigned a0 = (unsigned)gtw[cb][cq], a1 = (unsigned)(gtw[cb][cq] >> 32);
                const float o0 = D[cb][4 * cq] * rs * g4.x * siluf_(__uint_as_float(a0 << 16)), o1 = D[cb][4 * cq + 1] * rs * g4.y * siluf_(__uint_as_float(a0 & 0xffff0000u));
                const float o2 = D[cb][4 * cq + 2] * rs * g4.z * siluf_(__uint_as_float(a1 << 16)), o3 = D[cb][4 * cq + 3] * rs * g4.w * siluf_(__uint_as_float(a1 & 0xffff0000u));
                *(unsigned long long*)(yb + blk4k(m, 2 * BR + dvb + 8 * cq)) = (unsigned long long)pk2(o0, o1) | ((unsigned long long)pk2(o2, o3) << 32); } }
        __syncthreads();
    }
}
__device__ __forceinline__ void p4_lru(Frame& F, int l) {
    PHASE_IDS();
    LAS float* SA = (LAS float*)(F.lds + RING_OFF); LAS float* SH = SA + 2048; LAS float* CI = SH + 2048;
    const int q4 = (tid & 3) * 4, seg = tid >> 2;
    for (int k = 0; k < 2; ++k) {
        if ((int)blockIdx.x < 128) break;
        const int u = ((int)blockIdx.x - 128) + 128 * k;
        const int b = u >> 6, c0 = (u & 63) * 16;
        const size_t base = ((size_t)b * SEQ + seg * 16) * BR + c0 + q4;
        const float* ap = WSF(WS_RPRE) + base; const float* gp = WSF(WS_IPRE) + base;
        f32x4 av[16], gv[16];
#pragma unroll
        for (int t = 0; t < 16; ++t) { av[t] = *(const f32x4*)(ap + (size_t)t * BR); gv[t] = *(const f32x4*)(gp + (size_t)t * BR); }
        f32x4 h = (f32x4){0.f, 0.f, 0.f, 0.f}, P = (f32x4){1.f, 1.f, 1.f, 1.f};
#pragma unroll
        for (int t = 0; t < 16; ++t) { h = av[t] * h + gv[t]; P = P * av[t]; gv[t] = h; av[t] = P; }
        *(LAS f32x4*)(SA + seg * 16 + q4) = P; *(LAS f32x4*)(SH + seg * 16 + q4) = h;
        __syncthreads();
        if (tid < 64) {
            const int chn = tid & 15, part = tid >> 4; float a[32], hv[32];
#pragma unroll
            for (int s2 = 0; s2 < 32; ++s2) { a[s2] = SA[(part * 32 + s2) * 16 + chn]; hv[s2] = SH[(part * 32 + s2) * 16 + chn]; }
            float Pq = 1.f, Hq = 0.f;
#pragma unroll
            for (int s2 = 0; s2 < 32; ++s2) { Hq = a[s2] * Hq + hv[s2]; Pq *= a[s2]; }
            float pre = 0.f;
#pragma unroll
            for (int pp = 0; pp < 3; ++pp) { const float Hs = __shfl(Hq, chn + 16 * pp), Ps = __shfl(Pq, chn + 16 * pp); if (part > pp) pre = Ps * pre + Hs; }
            float c = pre;
#pragma unroll
            for (int s2 = 0; s2 < 32; ++s2) { CI[(part * 32 + s2) * 16 + chn] = c; c = a[s2] * c + hv[s2]; } }
        __syncthreads();
        const f32x4 cin = *(const LAS f32x4*)(CI + seg * 16 + q4); float* op = WSF(WS_HLRU) + base;
#pragma unroll
        for (int t = 0; t < 16; ++t) *(f32x4*)(op + (size_t)t * BR) = gv[t] + av[t] * cin;
        __syncthreads();
    }
}
constexpr int AT_KSTR = 400, AT_VSTR = 320, AT_KBYTES = 64 * AT_KSTR, AT_BUF = AT_KBYTES + 64 * AT_VSTR;
__device__ __forceinline__ float bflo(unsigned w) { return __uint_as_float(w << 16); }
__device__ __forceinline__ float bfhi(unsigned w) { return __uint_as_float(w & 0xffff0000u); }
__device__ __forceinline__ void attn_phase(Frame& F) {
    PHASE_IDS();
    const int hh = lane >> 5, r32 = lane & 31;
    LAS unsigned char* L = F.lds + RING_OFF;
    const bf16* Qb = (const bf16*)(AP->ws + WS_Q); const bf16* KNb = (const bf16*)(AP->ws + WS_KN); const bf16* Vb = (const bf16*)(AP->ws + WS_V); const bf16* KRb = (const bf16*)(AP->ws + WS_KR);
    const float SC = 0.07216878364870322f * 1.4426950408889634f;
    const int half = wave >> 2, w4 = wave & 3;
    const int skey = tid >> 4, sc = tid & 15, rkey = tid >> 3, rc = tid & 7;
    for (int u = F.vcu; u < 256; u += F.G) {
        const int b = u >> 6, h = (u >> 3) & 7, i = u & 7;
        const int qblk = half ? i : 15 - i;
        const int qrow0 = qblk * 128 + w4 * 32, qrow = qrow0 + r32;
        const int ntile = 2 * (16 - i), tlast = (qrow0 + 31) >> 6;
        const size_t mrow = (size_t)b * SEQ + qrow;
        bf16x8_t qf[12];
        { const u32x4_t* qp = (const u32x4_t*)(Qb + mrow * 1536 + h * DQK + 8 * hh);
          u32x4_t raw[12];
#pragma unroll
          for (int ks = 0; ks < 12; ++ks) raw[ks] = qp[2 * ks];
#pragma unroll
          for (int ks = 0; ks < 8; ++ks) { u32x4_t o;
#pragma unroll
              for (int w = 0; w < 4; ++w) o[w] = cvtpk_s(bflo(raw[ks][w]) * SC, bfhi(raw[ks][w]) * SC);
              qf[ks] = __builtin_bit_cast(bf16x8_t, o); }
          const float* rt = WSF(WS_ROPE) + mrow * 64;
#pragma unroll
          for (int ks = 8; ks < 10; ++ks) { const int i0 = 16 * (ks - 8) + 8 * hh; u32x4_t o1, o2;
              const f32x4 c0 = *(const f32x4*)(rt + i0), c1 = *(const f32x4*)(rt + i0 + 4), s0 = *(const f32x4*)(rt + 32 + i0), s1 = *(const f32x4*)(rt + 32 + i0 + 4);
              const float cc[8] = {c0.x, c0.y, c0.z, c0.w, c1.x, c1.y, c1.z, c1.w}, ss[8] = {s0.x, s0.y, s0.z, s0.w, s1.x, s1.y, s1.z, s1.w};
#pragma unroll
              for (int w = 0; w < 4; ++w) { const float a0 = bflo(raw[ks][w]), a1 = bfhi(raw[ks][w]), b0 = bflo(raw[ks + 2][w]), b1 = bfhi(raw[ks + 2][w]);
                  o1[w] = cvtpk_s((a0 * cc[2 * w] - b0 * ss[2 * w]) * SC, (a1 * cc[2 * w + 1] - b1 * ss[2 * w + 1]) * SC);
                  o2[w] = cvtpk_s((b0 * cc[2 * w] + a0 * ss[2 * w]) * SC, (b1 * cc[2 * w + 1] + a1 * ss[2 * w + 1]) * SC); }
              qf[ks] = __builtin_bit_cast(bf16x8_t, o1); qf[ks + 2] = __builtin_bit_cast(bf16x8_t, o2); } }
        f32x16_t O[4];
#pragma unroll
        for (int d = 0; d < 4; ++d)
#pragma unroll
            for (int r = 0; r < 16; ++r) O[d][r] = 0.f;
        float m_run = -1e30f, l_run = 0.f;
        const bf16* knb = KNb + (size_t)b * SEQ * BR + h * 128;
        const bf16* vbb = Vb + (size_t)b * SEQ * BR + h * 128;
        const bf16* krb = KRb + (size_t)b * SEQ * 64;
        const unsigned ko0 = (unsigned)(skey * BR + sc * 8), kro = (unsigned)(rkey * 64 + rc * 8);
        u32x4_t gk0, gk1, gkr, gv0, gv1;
#define AT_LOAD(t) do { const bf16* kt = knb + (size_t)(t) * 64 * BR; const bf16* vt = vbb + (size_t)(t) * 64 * BR; gk0 = *(const u32x4_t*)(kt + ko0); gk1 = *(const u32x4_t*)(kt + 32 * BR + ko0); \
        gv0 = *(const u32x4_t*)(vt + ko0); gv1 = *(const u32x4_t*)(vt + 32 * BR + ko0); gkr = *(const u32x4_t*)(krb + (size_t)(t) * 64 * 64 + kro); } while (0)
#define AT_STORE(p) do { LAS unsigned char* Bp = L + (p) * AT_BUF; \
        *(LAS u32x4_t*)(Bp + skey * AT_KSTR + sc * 16) = gk0; *(LAS u32x4_t*)(Bp + (skey + 32) * AT_KSTR + sc * 16) = gk1; \
        *(LAS u32x4_t*)(Bp + rkey * AT_KSTR + 256 + rc * 16) = gkr; \
        *(LAS u32x4_t*)(Bp + AT_KBYTES + skey * AT_VSTR + sc * 16) = gv0; *(LAS u32x4_t*)(Bp + AT_KBYTES + (skey + 32) * AT_VSTR + sc * 16) = gv1; } while (0)
        __syncthreads();
        AT_LOAD(0); AT_STORE(0);
        __syncthreads();
        for (int t = 0; t < ntile; ++t) {
            if (t + 1 < ntile) AT_LOAD(t + 1);
            if (t <= tlast) {
                LAS unsigned char* Kb = L + (t & 1) * AT_BUF; LAS unsigned char* Vbs = Kb + AT_KBYTES;
                f32x16_t S0, S1;
#pragma unroll
                for (int r = 0; r < 16; ++r) { S0[r] = 0.f; S1[r] = 0.f; }
                const LAS unsigned char* ka = Kb + r32 * AT_KSTR + hh * 16;
                const LAS unsigned char* va = Vbs + (4 * hh + ((lane & 15) >> 2)) * AT_VSTR + (((lane >> 4) & 1) * 16 + (lane & 3) * 4) * 2;
#define AT_SB() __builtin_amdgcn_sched_barrier(0)
#define AT_KF(ks, w) (*(const LAS bf16x8_t*)(ka + (w) * 32 * AT_KSTR + (ks) * 32))
#define AT_VF(f) tr_frag(va + (32 * (((f) >> 1) & 1) + 16 * ((f) & 1)) * AT_VSTR + ((f) >> 2) * 64, 8 * AT_VSTR)
                bf16x8_t xa0 = AT_KF(0, 0), xb0 = AT_KF(0, 1), xa1 = AT_KF(1, 0), xb1 = AT_KF(1, 1), xa2 = AT_KF(2, 0), xb2 = AT_KF(2, 1);
                AT_SB();
#define AT_KSTEP(ks, A, B) do { S0 = __builtin_amdgcn_mfma_f32_32x32x16_bf16(A, qf[ks], S0, 0, 0, 0); S1 = __builtin_amdgcn_mfma_f32_32x32x16_bf16(B, qf[ks], S1, 0, 0, 0); \
                    if ((ks) + 3 < 12) { A = AT_KF(((ks) + 3 < 12 ? (ks) + 3 : 0), 0); B = AT_KF(((ks) + 3 < 12 ? (ks) + 3 : 0), 1); } AT_SB(); } while (0)
                AT_KSTEP(0, xa0, xb0); AT_KSTEP(1, xa1, xb1); AT_KSTEP(2, xa2, xb2); AT_KSTEP(3, xa0, xb0); AT_KSTEP(4, xa1, xb1); AT_KSTEP(5, xa2, xb2);
                AT_KSTEP(6, xa0, xb0); AT_KSTEP(7, xa1, xb1); AT_KSTEP(8, xa2, xb2); AT_KSTEP(9, xa0, xb0); AT_KSTEP(10, xa1, xb1); AT_KSTEP(11, xa2, xb2);
                bf16x8_t y0 = AT_VF(0), y1 = AT_VF(1), y2 = AT_VF(2), y3 = AT_VF(3);
                AT_SB();
                if (64 * t + 63 > qrow0) {
                    const int kb = 64 * t + 4 * hh;
#pragma unroll
                    for (int r = 0; r < 16; ++r) { const int key = kb + (r & 3) + 8 * (r >> 2); if (key > qrow) S0[r] = -1e30f; if (key + 32 > qrow) S1[r] = -1e30f; }
                }
                float mx = fmaxf(S0[0], S1[0]);
#pragma unroll
                for (int r = 1; r < 16; ++r) mx = fmaxf(mx, fmaxf(S0[r], S1[r]));
                mx = fmaxf(mx, __shfl_xor(mx, 32));
                if (__any(mx > m_run + 6.f))   { const float mn = fmaxf(m_run, mx); const float al = __builtin_amdgcn_exp2f(m_run - mn); m_run = mn; l_run *= al;
#pragma unroll
                    for (int d = 0; d < 4; ++d)
#pragma unroll
                        for (int r = 0; r < 16; ++r) O[d][r] *= al; }
                float ls = 0.f;
#pragma unroll
                for (int r = 0; r < 16; ++r) { S0[r] = __builtin_amdgcn_exp2f(S0[r] - m_run); S1[r] = __builtin_amdgcn_exp2f(S1[r] - m_run); ls += S0[r] + S1[r]; }
                l_run += ls;
                bf16x8_t pf[2][2];
#pragma unroll
                for (int s2 = 0; s2 < 2; ++s2) { u32x4_t a, c;
#pragma unroll
                    for (int w = 0; w < 4; ++w) { a[w] = cvtpk_s(S0[8 * s2 + 2 * w], S0[8 * s2 + 2 * w + 1]); c[w] = cvtpk_s(S1[8 * s2 + 2 * w], S1[8 * s2 + 2 * w + 1]); }
                    pf[0][s2] = __builtin_bit_cast(bf16x8_t, a); pf[1][s2] = __builtin_bit_cast(bf16x8_t, c); }
                AT_SB();
#define AT_VSTEP(f, Y) do { O[(f) >> 2] = __builtin_amdgcn_mfma_f32_32x32x16_bf16(Y, pf[((f) >> 1) & 1][(f) & 1], O[(f) >> 2], 0, 0, 0); if ((f) + 4 < 16) Y = AT_VF(((f) + 4 < 16 ? (f) + 4 : 0)); AT_SB(); } while (0)
                AT_VSTEP(0, y0); AT_VSTEP(1, y1); AT_VSTEP(2, y2); AT_VSTEP(3, y3); AT_VSTEP(4, y0); AT_VSTEP(5, y1); AT_VSTEP(6, y2); AT_VSTEP(7, y3);
                AT_VSTEP(8, y0); AT_VSTEP(9, y1); AT_VSTEP(10, y2); AT_VSTEP(11, y3); AT_VSTEP(12, y0); AT_VSTEP(13, y1); AT_VSTEP(14, y2); AT_VSTEP(15, y3);
#undef AT_SB
#undef AT_KF
#undef AT_VF
#undef AT_KSTEP
#undef AT_VSTEP
            }
            if (t + 1 < ntile) AT_STORE((t + 1) & 1);
            __syncthreads();
        }
#undef AT_LOAD
#undef AT_STORE
        l_run += __shfl_xor(l_run, 32);
        const float inv = 1.f / l_run;
        float* op = WSF(WS_OMLA) + mrow * BR + h * 128 + 4 * hh;
#pragma unroll
        for (int d = 0; d < 4; ++d)
#pragma unroll
            for (int c = 0; c < 4; ++c) *(f32x4*)(op + 32 * d + 8 * c) = (f32x4){O[d][4 * c] * inv, O[d][4 * c + 1] * inv, O[d][4 * c + 2] * inv, O[d][4 * c + 3] * inv};
    }
    __syncthreads();
}
__device__ __forceinline__ void p5_norms(Frame& F, int l) {
    PHASE_IDS();
    const int gw = F.vcu * NWAVES + wave, NGW = F.G * NWAVES;
    const bf16* z = (const bf16*)(AP->ws + WS_Z); bf16* yb = (bf16*)(AP->ws + WS_HB);
    f32x4 g4[3][4];
#pragma unroll
    for (int q = 0; q < 3; ++q)
#pragma unroll
        for (int j = 0; j < 4; ++j) g4[q][j] = *(const f32x4*)((q == 0 ? IN_F(14) : q == 1 ? IN_F(20) : IN_F(31)) + l * BR + 256 * j + 4 * lane);
    for (int m = gw; m < T; m += NGW) {
        asm volatile("" ::: "memory");
        f32x4 v[3][4]; unsigned long long gt[3][4];
#pragma unroll
        for (int q = 0; q < 3; ++q)
#pragma unroll
            for (int j = 0; j < 4; ++j) { v[q][j] = *(const f32x4*)((q == 0 ? WSF(WS_S5O) : q == 1 ? WSF(WS_OMLA) : WSF(WS_HLRU)) + (size_t)m * BR + 256 * j + 4 * lane);
                gt[q][j] = *(const unsigned long long*)(z + (size_t)m * ZC + (q == 0 ? Z_S5G : q == 1 ? Z_MG : Z_LG) + 256 * j + 4 * lane); }
#pragma unroll
        for (int q = 0; q < 3; ++q) { float s = 0.f;
#pragma unroll
            for (int j = 0; j < 4; ++j) s += (v[q][j].x * v[q][j].x + v[q][j].y * v[q][j].y) + (v[q][j].z * v[q][j].z + v[q][j].w * v[q][j].w);
            const float rs = 1.0f / sqrtf(wave_sum(s) * (1.f / 1024.f) + EPS); const int br = q == 2 ? 3 : q;
#pragma unroll
            for (int j = 0; j < 4; ++j) { const unsigned a = (unsigned)gt[q][j], b2 = (unsigned)(gt[q][j] >> 32);
                const float o0 = v[q][j].x * rs * g4[q][j].x * siluf_(__uint_as_float(a << 16)), o1 = v[q][j].y * rs * g4[q][j].y * siluf_(__uint_as_float(a & 0xffff0000u));
                const float o2 = v[q][j].z * rs * g4[q][j].z * siluf_(__uint_as_float(b2 << 16)), o3 = v[q][j].w * rs * g4[q][j].w * siluf_(__uint_as_float(b2 & 0xffff0000u));
                *(unsigned long long*)(yb + blk4k((size_t)m, br * BR + 256 * j + 4 * lane)) = (unsigned long long)pk2(o0, o1) | ((unsigned long long)pk2(o2, o3) << 32); } }
    }
}
template <bool TOBF, int ND>
__device__ __forceinline__ void rms_row_res(const float* xrow, const bf16* d0, const bf16* d1, const float* g, void* orow, int lane, size_t mrow) {
    const f32x4* xr = (const f32x4*)xrow + lane; const f32x4* gr = (const f32x4*)g + lane;
    f32x4 v[16]; float s = 0.f;
#pragma unroll
    for (int j = 0; j < 16; ++j) { v[j] = xr[64 * j] + z4(d0 + 4 * (lane + 64 * j)); if (ND > 1) v[j] = v[j] + z4(d1 + 4 * (lane + 64 * j));
        s += (v[j].x * v[j].x + v[j].y * v[j].y) + (v[j].z * v[j].z + v[j].w * v[j].w); }
    f32x4 gv[16];
#pragma unroll
    for (int j = 0; j < 16; ++j) gv[j] = gr[64 * j];
    const float rs = 1.0f / sqrtf(wave_sum(s) * (1.f / DM) + EPS);
#pragma unroll
    for (int j = 0; j < 16; ++j) { const f32x4 gg = gv[j]; const f32x4 o = v[j] * rs * gg;
        if (TOBF) *(unsigned long long*)((bf16*)orow + blk4k(mrow, 4 * lane) + ((size_t)j << 16)) = (unsigned long long)pk2(o.x, o.y) | ((unsigned long long)pk2(o.z, o.w) << 32);
        else ((f32x4*)orow)[lane + 64 * j] = o; }
}
__device__ __forceinline__ void p7_norm(Frame& F, int l) {
    PHASE_IDS();
    const int gw = F.vcu * NWAVES + wave, NGW = F.G * NWAVES;
    const bf16* D0 = (const bf16*)(AP->ws + WS_XB); const bf16* D1 = D0 + (size_t)T * DM;
    for (int m = gw; m < T; m += NGW) {
        asm volatile("" ::: "memory");
        if (l + 1 < DEPTH) rms_row_res<true, 1>(IN_F(0) + (size_t)m * DM, D0 + (size_t)m * DM, D1 + (size_t)m * DM, IN_F(2) + (l + 1) * DM, (bf16*)(AP->ws + WS_HB), lane, (size_t)m);
        else rms_row_res<false, 2>(IN_F(0) + (size_t)m * DM, D0 + (size_t)m * DM, D1 + (size_t)m * DM, IN_F(33), AP->out + (size_t)m * DM, lane, (size_t)m);
    }
}

constexpr int PH_PER_LAYER = 7, N_PHASES = 1 + DEPTH * PH_PER_LAYER;
__global__ void __launch_bounds__(NWAVES * 64, 2) hybrid_fwd(Args args) {
    extern __shared__ __attribute__((aligned(16))) unsigned char lds[];
    Frame F;
    F.lds = (LAS unsigned char*)lds; F.ldsg = lds;
    F.wv = __builtin_amdgcn_readfirstlane((int)(threadIdx.x >> 6));
    F.G = gridDim.x; { const int bx = blockIdx.x; F.vcu = (F.G % 8 == 0) ? (bx % 8) * (F.G / 8) + bx / 8 : bx; }
    volatile LAS unsigned* MISC = (volatile LAS unsigned*)(F.lds + MISC_OFF);
    for (int u = threadIdx.x; u < (LDS_BYTES - LDSCTL_OFF) / 4; u += NWAVES * 64) ((LAS unsigned*)(F.lds + LDSCTL_OFF))[u] = 0u;
    __syncthreads();
    ArgsP AP0 = (ArgsP)__builtin_amdgcn_kernarg_segment_ptr();
    const bool multi = (args.ph_hi - args.ph_lo) > 1;
    XcdBarrier bar; bar.bar = (unsigned*)(AP0->ws + WS_CTL) + 4096; bar.x = 0; bar.st = nullptr;
    if (multi) bar = xcd_barrier_post((unsigned*)(AP0->ws + WS_CTL) + 4096, MISC + 8, F.wv == 0 && lane_id() == 0);
    const int lo = args.ph_lo, hi = args.ph_hi;
#define IN(k) (lo <= (k) && (k) < hi)
#ifndef DUP_PH
#define DUP_PH -1
#endif
#define REP(k) for (int rep_ = 0; rep_ < ((DUP_PH) == (k) ? 2 : 1); ++rep_)
#if defined(PROBE_I)
#define STAMP(k) do { if (blockIdx.x == 0 && F.wv == 0 && lane_id() == 0) ((volatile LAS unsigned long long*)(F.lds + LDSCTL_OFF))[k] = __builtin_amdgcn_s_memrealtime(); } while (0)
#else
#define STAMP(k) do {} while (0)
#endif
#define SEAM(k) do { if (IN(k) && IN((k) + 1)) { if ((k) >= 1 && (k) <= PH_PER_LAYER) bg_seam(F, (k), (k) == PH_PER_LAYER); xcd_barrier(bar, F.wv == 0 && lane_id() == 0); } } while (0)
    STAMP(0);
    if (IN(0)) REP(0) {
#ifndef SK_P0
 p0_prologue(F);
#endif
 } SEAM(0);
    for (int ll = 0; ll < DEPTH; ++ll) {
        int l = ll; asm volatile("" : "+s"(l) :: "memory");
        const int pb = 1 + l * PH_PER_LAYER;
        STAMP(pb);
        if (IN(pb + 0)) REP(pb + 0) {
            ArgsP AP = (ArgsP)__builtin_amdgcn_kernarg_segment_ptr(); asm volatile("" : "+s"(AP));
            pg8::Gemm g{(const bf16*)(AP->ws + WS_HB), (const bf16*)(AP->ws + WS_WTIN) + (size_t)l * ZC * KS, T, ZC, DM, KS, KS, 0}; pg8::StaticOrderT S; S.init(T, ZC, F.G, (int)blockIdx.x);
            pg8::EpiBf16P E{(bf16*)(AP->ws + WS_Z), ZC};
            pg8::gemm_phase<pg8::EpiBf16P, pg8::StaticOrderT, true, true, true>(F.lds + RING_OFF, g, S, E, F.wv);
            if ((int)blockIdx.x >= 192) s5_prep(F, l, (int)blockIdx.x - 192);
        } SEAM(pb + 0);
        STAMP(pb + 1);
        if (IN(pb + 1)) REP(pb + 1) {
#ifndef SK_P2R
 p2_rows(F, l);
#endif
#ifndef SK_P2S
 s5_stage(F);
#endif
 } SEAM(pb + 1);
        STAMP(pb + 2);
        if (IN(pb + 2)) REP(pb + 2) {
#ifndef SK_P3G
 gla_g1(F, l);
#endif
            { ArgsP AP = (ArgsP)__builtin_amdgcn_kernarg_segment_ptr(); asm volatile("" : "+s"(AP));
              { const int gs5 = F.vcu < 64 ? F.vcu : -1;
                { pg8::Gemm g{(const bf16*)(AP->ws + WS_S5A), (const bf16*)(AP->ws + WS_S5B1), 64 * 256, 64 * 256, 512, 640, 640, 0}; pg8::S5Order S{gs5, 1};
                  pg8::EpiS5Loc E{WSF(WS_S5L)}; pg8::gemm_phase<pg8::EpiS5Loc, pg8::S5Order, true, true>(F.lds + RING_OFF, g, S, E, F.wv); }
                if (gs5 >= 0) s5_scan(F, gs5);
                { pg8::Gemm g{(const bf16*)(AP->ws + WS_S5A), (const bf16*)(AP->ws + WS_S5B2), 64 * 256, 64 * 512, 640, 640, 640, 0}; pg8::S5Order S{gs5, 2};
                  pg8::EpiS5Y E{(bf16*)(AP->ws + WS_YS5B)}; pg8::gemm_phase<pg8::EpiS5Y, pg8::S5Order, true, true>(F.lds + RING_OFF, g, S, E, F.wv); } }
              { pg8::Gemm g{(const bf16*)(AP->ws + WS_CQB), (const bf16*)(AP->ws + WS_WTUQ), T, 2048, BR, BR, BR, 0};
                const int rr = F.vcu >= 64 ? F.vcu - 64 : -1;
                pg8::P3Order S{(const char*)(AP->ws + WS_CQB), (const char*)((const bf16*)(AP->ws + WS_WTUQ) + (size_t)l * 1536 * BR), (const char*)(AP->ws + WS_CKVB), (const char*)((const bf16*)(AP->ws + WS_WTUKV) + (size_t)l * 2048 * BR),
                               (const char*)(AP->ws + WS_XCB), (const char*)((const bf16*)(AP->ws + WS_WTLRU) + (size_t)l * 8 * 256 * 1024), rr, rr < 0 ? -1 : (rr + 128) % 192, rr < 0 ? -1 : (rr + 64) % 192};
                pg8::EpiP3 E{pg8::EpiBf16Split{(bf16*)(AP->ws + WS_Q), (bf16*)(AP->ws + WS_Q), 1536, 1000}, pg8::EpiBf16Split{(bf16*)(AP->ws + WS_KN), (bf16*)(AP->ws + WS_V), BR, 4},
                             pg8::EpiLru{(const bf16*)(AP->ws + WS_XCB), IN_F(27) + l * BR, IN_F(29) + l * BR, WSF(WS_SPL) + l * BR, WSF(WS_RPRE), WSF(WS_IPRE)}};
                pg8::gemm_phase<pg8::EpiP3, pg8::P3Order, true, true>(F.lds + RING_OFF, g, S, E, F.wv); }
            }
 } SEAM(pb + 2);
        STAMP(pb + 3);
        if (IN(pb + 3)) REP(pb + 3) {
#ifndef SK_P4L
 p4_lru(F, l);
 gla_g2(F);
#endif
            { ArgsP AP = (ArgsP)__builtin_amdgcn_kernarg_segment_ptr(); asm volatile("" : "+s"(AP));
              { pg8::Gemm g{(const bf16*)(AP->ws + WS_YS5B), (const bf16*)(AP->ws + WS_WTGLU) + (size_t)l * BR * BR, T, BR, BR, BR, BR, 0}; pg8::StaticOrder S; S.init(T, BR, F.G, (int)blockIdx.x);
                pg8::EpiGlu E{(const bf16*)(AP->ws + WS_YS5B), IN_F(13) + l * BR, WSF(WS_S5O), BR}; pg8::gemm_phase<pg8::EpiGlu, pg8::StaticOrder, true, true>(F.lds + RING_OFF, g, S, E, F.wv); }
            }

#ifndef SK_P4A
 attn_phase(F);
#endif
 } SEAM(pb + 3);
        STAMP(pb + 4);
        if (IN(pb + 4)) REP(pb + 4) {
#ifndef SK_P5
 p5_norms(F, l);
 gla_g3(F, l);
#endif
 } SEAM(pb + 4);
        STAMP(pb + 5);
        if (IN(pb + 5)) REP(pb + 5) {
            ArgsP AP = (ArgsP)__builtin_amdgcn_kernarg_segment_ptr(); asm volatile("" : "+s"(AP));
            pg8::Gemm g{(const bf16*)(AP->ws + WS_HB), (const bf16*)(AP->ws + WS_WTOUT) + (size_t)l * DM * KS, T, DM, DM, KS, KS, 0}; pg8::StaticOrder S; S.init(T, DM, F.G, (int)blockIdx.x);
            pg8::EpiBf16P E{(bf16*)(AP->ws + WS_XB) + (size_t)l * T * DM, DM};
            pg8::gemm_phase<pg8::EpiBf16P, pg8::StaticOrder, true, true, true>(F.lds + RING_OFF, g, S, E, F.wv);
        } SEAM(pb + 5);
        STAMP(pb + 6);
        if (IN(pb + 6)) REP(pb + 6) {
#ifndef SK_P7
 p7_norm(F, l);
#endif
 } SEAM(pb + 6);
    }
#if defined(PROBE_I)
    STAMP(N_PHASES);
    xcd_barrier(bar, F.wv == 0 && lane_id() == 0);
    if (blockIdx.x == 0) { ArgsP AP = (ArgsP)__builtin_amdgcn_kernarg_segment_ptr();
        volatile LAS unsigned long long* ts = (volatile LAS unsigned long long*)(F.lds + LDSCTL_OFF);
        const float ti = (float)(ts[PROBE_I + 1] - ts[PROBE_I]) * 0.01f, tj = (float)(ts[PROBE_J + 1] - ts[PROBE_J]) * 0.01f;
        const float sc = 1.f + tj * 0.001f;
        for (int e = threadIdx.x; e < 512 * DM; e += 512) AP->out[e] *= sc;
        __syncthreads();
        if (threadIdx.x == 0) AP->out[0] += ti; }
#endif
#undef IN
#undef SEAM
}

#ifndef N_LAUNCHES
#define N_LAUNCHES 1
#endif
extern "C" void kernel_launch(void* const* d_in, const int* in_sizes, int n_in, void* d_out, int out_size, void* d_ws, size_t ws_size, hipStream_t stream) {
    static int grid = 0;
    if (grid == 0) {
        if (n_in != 34 || out_size != T * DM || ws_size < WS_END) { fprintf(stderr, "kernel_launch: unexpected problem: n_in %d out %d ws %zu (need %zu)\n", n_in, out_size, ws_size, (size_t)WS_END); grid = -1; return; }
        int dev = 0, cus = 0;
        if (hipGetDevice(&dev) != hipSuccess || hipDeviceGetAttribute(&cus, hipDeviceAttributeMultiprocessorCount, dev) != hipSuccess) { grid = -1; return; }
        if (hipFuncSetAttribute((const void*)hybrid_fwd, hipFuncAttributeMaxDynamicSharedMemorySize, LDS_BYTES) != hipSuccess) { fprintf(stderr, "kernel_launch: hipFuncSetAttribute failed\n"); grid = -1; return; }
        int per_cu = 0;
        if (hipOccupancyMaxActiveBlocksPerMultiprocessor(&per_cu, (const void*)hybrid_fwd, NWAVES * 64, LDS_BYTES) != hipSuccess || per_cu < 1) fprintf(stderr, "kernel_launch: occupancy query says %d blocks/CU\n", per_cu);
        (void)hipGetLastError();
        grid = cus;
    }
    if (grid < 0) return;
    (void)hipMemsetAsync((char*)d_ws + WS_CTL, 0, CTL_ZERO_BYTES, stream);
    Args a{};
    for (int i = 0; i < 34; ++i) a.in[i] = d_in[i];
    a.out = (float*)d_out; a.ws = (unsigned char*)d_ws;
    if (N_LAUNCHES == 1) { a.ph_lo = 0; a.ph_hi = N_PHASES; hipLaunchKernelGGL(hybrid_fwd, dim3(grid), dim3(NWAVES * 64), LDS_BYTES, stream, a); }
    else for (int p = 0; p < N_PHASES; ++p) { a.ph_lo = p; a.ph_hi = p + 1; hipLaunchKernelGGL(hybrid_fwd, dim3(grid), dim3(NWAVES * 64), LDS_BYTES, stream, a); }
}
```

```cpp
#include <hip/hip_runtime.h>
#include <cstdio>
#include <cstdint>

__device__ __forceinline__ int lane_id() { int l; asm volatile("v_mbcnt_lo_u32_b32 %0, -1, 0\n\tv_mbcnt_hi_u32_b32 %0, -1, %0" : "=v"(l)); return l; }
__device__ __forceinline__ float xl_swz16(float v) { return __int_as_float(__builtin_amdgcn_ds_swizzle(__float_as_int(v), 0x401F)); }
__device__ __forceinline__ float xl_x32(float v, int ln) { return __int_as_float(__builtin_amdgcn_ds_bpermute((ln ^ 32) << 2, __float_as_int(v))); }
__device__ __forceinline__ float xl_q1(float v) { return __int_as_float(__builtin_amdgcn_update_dpp(0, __float_as_int(v), 0xB1, 0xF, 0xF, true)); }
__device__ __forceinline__ float xl_q2(float v) { return __int_as_float(__builtin_amdgcn_update_dpp(0, __float_as_int(v), 0x4E, 0xF, 0xF, true)); }
namespace pg8 {
#define PG8_LAS __attribute__((address_space(3)))
typedef unsigned short bf16_t;
typedef short bf16x8 __attribute__((ext_vector_type(8)));
typedef float f32x4 __attribute__((ext_vector_type(4)));
typedef unsigned u32x4 __attribute__((ext_vector_type(4)));
constexpr int BM = 256, BK = 64, HALF = 128, HTB = HALF * BK * 2, STAGE_BYTES = 8 * HTB, NXCD = 8, WGM = 8;
constexpr int SSQ_LD = 8192;
constexpr int FAC_LDS_OFF = 131072 + 2048;

__host__ __device__ __forceinline__ int lds_byte(int r, int c) { const int st = (r >> 4) * 2 + (c >> 5), rr = r & 15, cc = c & 31, ob = rr * 64 + cc * 2; return st * 1024 + (ob ^ (((ob >> 9) & 1) << 5)); }
__host__ __device__ __forceinline__ void stage_rc(int b, int& R, int& C) { const int st = b / 1024, sb = b % 1024, swz = sb ^ (((sb >> 9) & 1) << 5); R = (st >> 1) * 16 + swz / 64; C = (st & 1) * 32 + (swz % 64) / 2; }
__host__ __device__ __forceinline__ int perm32(int rho) { const int n = rho >> 4, i = rho & 15; return 8 * (i >> 2) + 4 * n + (i & 3); }

struct Unit { int pm, pn; const char* a; const char* b; int nt, kind; };
struct Gemm { const bf16_t* A; const bf16_t* Bt; int M, N, K; int lda, ldb; int a_colstep; };

struct StaticOrder {
    static constexpr bool MULTI = false;
    int nM, nN, nwg, G, c;
    __host__ __device__ void init(int M, int N, int G_, int c_) { nM = M / BM; nN = N / BM; nwg = nM * nN; G = G_; c = c_; }
    __host__ __device__ bool next(int i, Unit& u) const {
        const long L = (long)i * G + c; if (L >= nwg) return false;
        int wgid = (int)L; { const int q = nwg / NXCD, r = nwg % NXCD, xcd = wgid % NXCD, off = wgid / NXCD; wgid = (xcd < r ? xcd * (q + 1) : r * (q + 1) + (xcd - r) * q) + off; }
        const int nig = WGM * nN, gid = wgid / nig, fm = gid * WGM, gsz = (nM - fm) < WGM ? (nM - fm) : WGM;
        u.pm = fm + ((wgid % nig) % gsz); u.pn = (wgid % nig) / gsz; return true;
    }
    __device__ __forceinline__ void a_ready(const Unit&) const {}
    __device__ __forceinline__ void done(const Unit&) const {}
};

struct EpiF32 {
    static constexpr bool PERM = false, AFTER_DRAIN = false;
    float* C; int ldc;
    __device__ __forceinline__ void operator()(const f32x4 (&acc)[2][2][4][2], const Unit& u, int wr, int wc, int fr, int fq) const {
        const int row0 = u.pm * BM + wr * 64 + fr, col0 = u.pn * BM + wc * 32 + 4 * fq;
#pragma unroll
        for (int ai = 0; ai < 2; ++ai)
#pragma unroll
            for (int m = 0; m < 4; ++m) { float* rowp = C + (size_t)(row0 + ai * HALF + m * 16) * ldc + col0;
#pragma unroll
                for (int bj = 0; bj < 2; ++bj)
#pragma unroll
                    for (int n = 0; n < 2; ++n) *(f32x4*)(rowp + bj * HALF + n * 16) = acc[ai][bj][m][n]; }
    }
};
struct EpiRes {
    static constexpr bool PERM = false, AFTER_DRAIN = false;
    const float* base; float* O; int ldc;
    __device__ __forceinline__ void operator()(const f32x4 (&acc)[2][2][4][2], const Unit& u, int wr, int wc, int fr, int fq) const {
        const int row0 = u.pm * BM + wr * 64 + fr, col0 = u.pn * BM + wc * 32 + 4 * fq;
#pragma unroll
        for (int ai = 0; ai < 2; ++ai)
#pragma unroll
            for (int m = 0; m < 4; ++m) { const size_t off = (size_t)(row0 + ai * HALF + m * 16) * ldc + col0;
#pragma unroll
                for (int bj = 0; bj < 2; ++bj)
#pragma unroll
                    for (int n = 0; n < 2; ++n) { const f32x4 b = *(const f32x4*)(base + off + bj * HALF + n * 16); *(f32x4*)(O + off + bj * HALF + n * 16) = b + acc[ai][bj][m][n]; } }
    }
};

struct EpiF32Split {
    static constexpr bool PERM = false, AFTER_DRAIN = false;
    float* C0; float* C1; int ldc; int split;
    __device__ __forceinline__ void operator()(const f32x4 (&acc)[2][2][4][2], const Unit& u, int wr, int wc, int fr, int fq) const {
        float* C = u.pn < split ? C0 : C1; const int pn = u.pn < split ? u.pn : u.pn - split;
        const int row0 = u.pm * BM + wr * 64 + fr, col0 = pn * BM + wc * 32 + 4 * fq;
#pragma unroll
        for (int ai = 0; ai < 2; ++ai)
#pragma unroll
            for (int m = 0; m < 4; ++m) { float* rowp = C + (size_t)(row0 + ai * HALF + m * 16) * ldc + col0;
#pragma unroll
                for (int bj = 0; bj < 2; ++bj)
#pragma unroll
                    for (int n = 0; n < 2; ++n) *(f32x4*)(rowp + bj * HALF + n * 16) = acc[ai][bj][m][n]; }
    }
};__device__ __forceinline__ unsigned cvt_pk_bf16(float lo, float hi) { unsigned r; asm volatile("v_cvt_pk_bf16_f32 %0, %1, %2" : "=v"(r) : "v"(lo), "v"(hi)); return r; }
struct EpiBf16Split {
    static constexpr bool PERM = false, AFTER_DRAIN = false;
    bf16_t* O0; bf16_t* O1; int ldc; int split;
    __device__ __forceinline__ void operator()(const f32x4 (&acc)[2][2][4][2], const Unit& u, int wr, int wc, int fr, int fq) const {
        bf16_t* O = u.pn < split ? O0 : O1; const int pn = u.pn < split ? u.pn : u.pn - split;
        const int row0 = u.pm * BM + wr * 64 + fr, col0 = pn * BM + wc * 32 + 4 * fq;
#pragma unroll
        for (int ai = 0; ai < 2; ++ai)
#pragma unroll
            for (int m = 0; m < 4; ++m) { bf16_t* rowp = O + (size_t)(row0 + ai * HALF + m * 16) * ldc + col0;
#pragma unroll
                for (int bj = 0; bj < 2; ++bj)
#pragma unroll
                    for (int n = 0; n < 2; ++n) { const f32x4 v = acc[ai][bj][m][n];
                        *(unsigned long long*)(rowp + bj * HALF + n * 16) = (unsigned long long)cvt_pk_bf16(v[0], v[1]) | ((unsigned long long)cvt_pk_bf16(v[2], v[3]) << 32); } }
    }
};

struct EpiBf16P {
    static constexpr bool PERM = true, AFTER_DRAIN = false;
    bf16_t* O; int ldc;
    __device__ __forceinline__ void operator()(const f32x4 (&acc)[2][2][4][2], const Unit& u, int wr, int wc, int fr, int fq) const {
        const int row0 = u.pm * BM + wr * 64 + fr, col0 = u.pn * BM + wc * 32 + 8 * fq;
#pragma unroll
        for (int ai = 0; ai < 2; ++ai)
#pragma unroll
            for (int m = 0; m < 4; ++m) { bf16_t* rowp = O + (size_t)(row0 + ai * HALF + m * 16) * ldc + col0;
#pragma unroll
                for (int bj = 0; bj < 2; ++bj) { const f32x4 v0 = acc[ai][bj][m][0], v1 = acc[ai][bj][m][1]; u32x4 w; w.x = cvt_pk_bf16(v0[0], v0[1]); w.y = cvt_pk_bf16(v0[2], v0[3]); w.z = cvt_pk_bf16(v1[0], v1[1]); w.w = cvt_pk_bf16(v1[2], v1[3]);
                    *(u32x4*)(rowp + bj * HALF) = w; } }
    }
};
struct EpiBf16PZ {
    static constexpr bool PERM = true, AFTER_DRAIN = false;
    bf16_t* O; int ldc; bf16_t* LG;
    __device__ __forceinline__ void operator()(const f32x4 (&acc)[2][2][4][2], const Unit& u, int wr, int wc, int fr, int fq) const {
        const int row0 = u.pm * BM + wr * 64 + fr, col0 = u.pn * BM + wc * 32 + 8 * fq; const bool lg = u.pn >= 33 && u.pn < 37;
#pragma unroll
        for (int ai = 0; ai < 2; ++ai)
#pragma unroll
            for (int m = 0; m < 4; ++m) { const int mr = row0 + ai * HALF + m * 16;
#pragma unroll
                for (int bj = 0; bj < 2; ++bj) { const f32x4 v0 = acc[ai][bj][m][0], v1 = acc[ai][bj][m][1]; u32x4 w; w.x = cvt_pk_bf16(v0[0], v0[1]); w.y = cvt_pk_bf16(v0[2], v0[3]); w.z = cvt_pk_bf16(v1[0], v1[1]); w.w = cvt_pk_bf16(v1[2], v1[3]);
                    const int cc = col0 + bj * HALF - 33 * BM;
                    bf16_t* p = lg ? LG + (((size_t)((mr >> 11) * 64 + (cc >> 4)) << 15) + (size_t)(((mr & 2047) << 4) + (cc & 15))) : O + (size_t)mr * ldc + col0 + bj * HALF;
                    *(u32x4*)p = w; } }
    }
};
struct EpiBf16PR : EpiBf16P {
    static constexpr bool RESC = true;
    const float* ssq;
    __device__ __forceinline__ f32x4 facs(int row) const {
        const float* p = ssq + row; float a[24];
#pragma unroll
        for (int i = 0; i < 24; ++i) a[i] = p[(size_t)i * SSQ_LD];
        float s0 = 0.f, s1 = 0.f, s3 = 0.f;
#pragma unroll
        for (int i = 0; i < 16; ++i) s0 += a[i];
#pragma unroll
        for (int i = 16; i < 24; ++i) s1 += a[i];
        asm volatile("" ::: "memory");
#pragma unroll
        for (int h2 = 0; h2 < 2; ++h2) {
            float b[32];
#pragma unroll
            for (int i = 0; i < 32; ++i) b[i] = p[(size_t)(24 + 32 * h2 + i) * SSQ_LD];
#pragma unroll
            for (int i = 0; i < 32; ++i) s3 += b[i];
            asm volatile("" ::: "memory"); }
        const float r0 = 1.0f / sqrtf(s0 * (1.f / 1024.f) + 1e-6f), r1 = 1.0f / sqrtf(s1 * (1.f / 1024.f) + 1e-6f), r3 = 1.0f / sqrtf(s3 * (1.f / 1024.f) + 1e-6f);
        return (f32x4){r0 / r1, r1, 1.0f / r3, r3};
    }
};
template <class E, class = void> struct epi_resc { static constexpr bool v = false; };
template <class E> struct epi_resc<E, decltype((void)E::RESC)> { static constexpr bool v = E::RESC; };
struct EpiResP {
    static constexpr bool PERM = true, AFTER_DRAIN = false;
    const float* base; float* O; int ldc;
    __device__ __forceinline__ void operator()(const f32x4 (&acc)[2][2][4][2], const Unit& u, int wr, int wc, int fr, int fq) const {
        const int row0 = u.pm * BM + wr * 64 + fr, col0 = u.pn * BM + wc * 32 + 8 * fq;
#pragma unroll
        for (int ai = 0; ai < 2; ++ai)
#pragma unroll
            for (int m = 0; m < 4; ++m) { const size_t off = (size_t)(row0 + ai * HALF + m * 16) * ldc + col0;
#pragma unroll
                for (int bj = 0; bj < 2; ++bj) { const f32x4 b0 = *(const f32x4*)(base + off + bj * HALF), b1 = *(const f32x4*)(base + off + bj * HALF + 4);
                    *(f32x4*)(O + off + bj * HALF) = b0 + acc[ai][bj][m][0]; *(f32x4*)(O + off + bj * HALF + 4) = b1 + acc[ai][bj][m][1]; } }
    }
};

__device__ __forceinline__ float sigm(float x) { return __builtin_amdgcn_rcpf(1.0f + __expf(-x)); }
struct EpiGlu {
    static constexpr bool PERM = false, AFTER_DRAIN = false;
    const bf16_t* Y; const float* bias; float* O; int ldc;
    __device__ __forceinline__ void operator()(const f32x4 (&acc)[2][2][4][2], const Unit& u, int wr, int wc, int fr, int fq) const {
        const int row0 = u.pm * BM + wr * 64 + fr, col0 = u.pn * BM + wc * 32 + 4 * fq;
        unsigned long long yv[2][4][2][2]; f32x4 bv[2][2];
#pragma unroll
        for (int bj = 0; bj < 2; ++bj)
#pragma unroll
            for (int n = 0; n < 2; ++n) { bv[bj][n] = *(const f32x4*)(bias + col0 + bj * HALF + n * 16);
#pragma unroll
                for (int ai = 0; ai < 2; ++ai)
#pragma unroll
                    for (int m = 0; m < 4; ++m) yv[ai][m][bj][n] = *(const unsigned long long*)(Y + (size_t)(row0 + ai * HALF + m * 16) * ldc + col0 + bj * HALF + n * 16); }
#pragma unroll
        for (int ai = 0; ai < 2; ++ai)
#pragma unroll
            for (int m = 0; m < 4; ++m)
#pragma unroll
                for (int bj = 0; bj < 2; ++bj)
#pragma unroll
                    for (int n = 0; n < 2; ++n) { const size_t off = (size_t)(row0 + ai * HALF + m * 16) * ldc + col0 + bj * HALF + n * 16;
                        const unsigned y01 = (unsigned)yv[ai][m][bj][n], y23 = (unsigned)(yv[ai][m][bj][n] >> 32);
                        const f32x4 v = acc[ai][bj][m][n] + bv[bj][n]; f32x4 o;
                        o.x = __uint_as_float(y01 << 16) * sigm(v.x); o.y = __uint_as_float(y01 & 0xffff0000u) * sigm(v.y); o.z = __uint_as_float(y23 << 16) * sigm(v.z); o.w = __uint_as_float(y23 & 0xffff0000u) * sigm(v.w);
                        *(f32x4*)(O + off) = o; }
    }
};
struct EpiGluU {
    static constexpr bool PERM = false, AFTER_DRAIN = false;
    const bf16_t* Y; const float* bias; const float* gain; const bf16_t* Gt; int ldc, ldg; bf16_t* U; float* ssq;
    __device__ __forceinline__ void operator()(const f32x4 (&acc)[2][2][4][2], const Unit& u, int wr, int wc, int fr, int fq) const {
        const int rl0 = wr * 64 + fr, col0 = u.pn * BM + wc * 32 + 4 * fq;
        f32x4 bv[2][2], gn[2][2];
#pragma unroll
        for (int bj = 0; bj < 2; ++bj)
#pragma unroll
            for (int n = 0; n < 2; ++n) { bv[bj][n] = *(const f32x4*)(bias + col0 + bj * HALF + n * 16); gn[bj][n] = *(const f32x4*)(gain + col0 + bj * HALF + n * 16); }
#pragma unroll
        for (int am = 0; am < 4; ++am) {
            unsigned long long yv[2][2][2], gt[2][2][2];
#pragma unroll
            for (int mm = 0; mm < 2; ++mm)
#pragma unroll
                for (int bj = 0; bj < 2; ++bj)
#pragma unroll
                    for (int n = 0; n < 2; ++n) { const size_t row = (size_t)(u.pm * BM + rl0 + (am >> 1) * HALF + ((am & 1) * 2 + mm) * 16); const int col = col0 + bj * HALF + n * 16;
                        yv[mm][bj][n] = *(const unsigned long long*)(Y + row * ldc + col); gt[mm][bj][n] = *(const unsigned long long*)(Gt + row * ldg + col); }
#pragma unroll
            for (int mm = 0; mm < 2; ++mm) { float sq = 0.f; const int ai = am >> 1, m = (am & 1) * 2 + mm, rl = rl0 + ai * HALF + m * 16;
#pragma unroll
                for (int bj = 0; bj < 2; ++bj)
#pragma unroll
                    for (int n = 0; n < 2; ++n) { const int col = col0 + bj * HALF + n * 16;
                        const unsigned y01 = (unsigned)yv[mm][bj][n], y23 = (unsigned)(yv[mm][bj][n] >> 32), g01 = (unsigned)gt[mm][bj][n], g23 = (unsigned)(gt[mm][bj][n] >> 32);
                        const f32x4 v = acc[ai][bj][m][n] + bv[bj][n]; f32x4 o;
                        o.x = __uint_as_float(y01 << 16) * sigm(v.x); o.y = __uint_as_float(y01 & 0xffff0000u) * sigm(v.y); o.z = __uint_as_float(y23 << 16) * sigm(v.z); o.w = __uint_as_float(y23 & 0xffff0000u) * sigm(v.w);
                        sq += (o.x * o.x + o.y * o.y) + (o.z * o.z + o.w * o.w);
                        const float g0 = __uint_as_float(g01 << 16), g1 = __uint_as_float(g01 & 0xffff0000u), g2 = __uint_as_float(g23 << 16), g3 = __uint_as_float(g23 & 0xffff0000u);
                        const f32x4 w = gn[bj][n];
                        const unsigned lo = cvt_pk_bf16(o.x * w.x * (g0 * sigm(g0)), o.y * w.y * (g1 * sigm(g1))), hi = cvt_pk_bf16(o.z * w.z * (g2 * sigm(g2)), o.w * w.w * (g3 * sigm(g3)));
                        *(unsigned long long*)(U + ((((size_t)u.pm * 64 + (col >> 6)) << 14) + (rl << 6) + (col & 63))) = (unsigned long long)lo | ((unsigned long long)hi << 32); }
                sq += xl_swz16(sq); sq += xl_x32(sq, fq * 16 + fr);
                if (fq == 0) ssq[(size_t)(u.pn * 4 + wc) * SSQ_LD + u.pm * BM + rl] = sq; }
            __builtin_amdgcn_sched_barrier(0); asm volatile("" ::: "memory");
        }
    }
};
struct EpiLru {
    static constexpr bool PERM = false, AFTER_DRAIN = false;
    const bf16_t* XC; const float* ba; const float* bx; const float* spl; float* Aout; float* Gout;
    __device__ __forceinline__ void operator()(const f32x4 (&acc)[2][2][4][2], const Unit& u, int wr, int wc, int fr, int fq) const {
        const int row0 = u.pm * BM + wr * 64 + fr, ch0 = u.pn * 128 + wc * 32 + 4 * fq;
        unsigned long long xw[2][4][2]; f32x4 va[2], vx[2], sp[2];
#pragma unroll
        for (int n = 0; n < 2; ++n) { va[n] = *(const f32x4*)(ba + ch0 + n * 16); vx[n] = *(const f32x4*)(bx + ch0 + n * 16); sp[n] = *(const f32x4*)(spl + ch0 + n * 16);
#pragma unroll
            for (int ai = 0; ai < 2; ++ai)
#pragma unroll
                for (int m = 0; m < 4; ++m) xw[ai][m][n] = *(const unsigned long long*)(XC + (size_t)(row0 + ai * HALF + m * 16) * 1024 + ch0 + n * 16); }
#pragma unroll
        for (int n = 0; n < 2; ++n)
#pragma unroll
        for (int ai = 0; ai < 2; ++ai)
#pragma unroll
            for (int m = 0; m < 4; ++m) { const int mr = row0 + ai * HALF + m * 16, cc = ch0 + n * 16;
                const size_t off = ((size_t)((mr >> 11) * 64 + (cc >> 4)) << 15) + (size_t)(((mr & 2047) << 4) + (cc & 15));
                const unsigned a0 = (unsigned)xw[ai][m][n], a1 = (unsigned)(xw[ai][m][n] >> 32);
                const f32x4 xc = (f32x4){__uint_as_float(a0 << 16), __uint_as_float(a0 & 0xffff0000u), __uint_as_float(a1 << 16), __uint_as_float(a1 & 0xffff0000u)}; f32x4 oa, og;
#pragma unroll
                for (int e = 0; e < 4; ++e) { const float r = sigm(acc[ai][0][m][n][e] + va[n][e]), ig = sigm(acc[ai][1][m][n][e] + vx[n][e]);
                    const float la = -8.f * r * sp[n][e]; const float a = __expf(la); const float x = 2.f * la;
                    const float ser = -x * (1.f + x * (0.5f + x * (0.16666667f + x * (0.041666668f + x * (0.0083333338f + x * 0.0013888889f)))));
                    const float em = x > -0.5f ? ser : 1.f - a * a;
                    oa[e] = a; og[e] = __builtin_amdgcn_sqrtf(em) * (ig * xc[e]); }
                *(f32x4*)(Aout + off) = oa; *(f32x4*)(Gout + off) = og; }
    }
};
struct EpiS5Loc {
    static constexpr bool PERM = false, AFTER_DRAIN = false;
    float* SL;
    __device__ __forceinline__ void operator()(const f32x4 (&acc)[2][2][4][2], const Unit& u, int wr, int wc, int fr, int fq) const {
        float* base = SL + ((size_t)u.pm * 256 + wr * 64 + fr) * 128 + wc * 32 + 4 * fq;
#pragma unroll
        for (int ai = 0; ai < 2; ++ai)
#pragma unroll
            for (int m = 0; m < 4; ++m)
#pragma unroll
                for (int n = 0; n < 2; ++n) *(f32x4*)(base + (size_t)(ai * HALF + m * 16) * 128 + n * 16) = acc[ai][0][m][n];
    }
};
__device__ __forceinline__ float gelu_t(float x) { const float uu = 0.7978845608028654f * (x + 0.044715f * x * x * x); const float e = __expf(2.f * uu); return 0.5f * x * (2.f - 2.f * __builtin_amdgcn_rcpf(e + 1.f)); }
struct EpiS5Y {
    static constexpr bool PERM = false, AFTER_DRAIN = false;
    bf16_t* Y;
    __device__ __forceinline__ void operator()(const f32x4 (&acc)[2][2][4][2], const Unit& u, int wr, int wc, int fr, int fq) const {
        const int g = u.pm, half = u.pn & 1;
#pragma unroll
        for (int ai = 0; ai < 2; ++ai)
#pragma unroll
            for (int m = 0; m < 4; ++m) { const int r = ai * HALF + wr * 64 + m * 16 + fr; const size_t mrow = (size_t)(r >> 6) * 2048 + (size_t)(r & 63) * 32;
#pragma unroll
                for (int bj = 0; bj < 2; ++bj)
#pragma unroll
                    for (int n = 0; n < 2; ++n) { const int t = 16 * half + 8 * bj + 2 * wc + n; const f32x4 v = acc[ai][bj][m][n];
                        *(unsigned long long*)(Y + (mrow + t) * 1024 + g * 16 + 4 * fq) = (unsigned long long)cvt_pk_bf16(gelu_t(v[0]), gelu_t(v[1])) | ((unsigned long long)cvt_pk_bf16(gelu_t(v[2]), gelu_t(v[3])) << 32); } }
    }
};
struct StaticOrderT {
    static constexpr bool MULTI = false;
    int nM, nN, nwg, G, c;
    __host__ __device__ void init(int M, int N, int G_, int c_) { nM = M / BM; nN = N / BM; nwg = nM * nN; G = G_; c = c_; }
    __host__ __device__ bool next(int i, Unit& u) const {
        const long L = (long)i * G + c; if (L >= nwg) return false;
        int wgid = (int)L; { const int q = nwg / NXCD, r = nwg % NXCD, xcd = wgid % NXCD, off = wgid / NXCD; wgid = (xcd < r ? xcd * (q + 1) : r * (q + 1) + (xcd - r) * q) + off; }
        const int nig = WGM * nM, gid = wgid / nig, fn = gid * WGM, gsz = (nN - fn) < WGM ? (nN - fn) : WGM;
        u.pn = fn + ((wgid % nig) % gsz); u.pm = (wgid % nig) / gsz; return true;
    }
    __device__ __forceinline__ void a_ready(const Unit&) const {}
    __device__ __forceinline__ void done(const Unit&) const {}
};
struct RankOrder {
    static constexpr bool MULTI = false;
    int nunits, nN, r, nw;
    __device__ __forceinline__ bool next(int i, Unit& u) const { const int L = i * nw + r; if (r < 0 || L >= nunits) return false; u.pm = L / nN; u.pn = L - u.pm * nN; return true; }
    __device__ __forceinline__ void a_ready(const Unit&) const {}
    __device__ __forceinline__ void done(const Unit&) const {}
};
struct S5Order {
    static constexpr bool MULTI = false;
    int g, mode;
    __device__ __forceinline__ bool next(int i, Unit& u) const { if (g < 0 || i >= mode) return false; u.pm = g; u.pn = (mode == 1) ? g : 2 * g + i; return true; }
    __device__ __forceinline__ void a_ready(const Unit&) const {}
    __device__ __forceinline__ void done(const Unit&) const {}
};

struct P3Order {
    static constexpr bool MULTI = true;
    const char *qa, *qb, *ka, *kb, *la, *lb; int r0, r1, r2;
    __device__ __forceinline__ bool next(int i, Unit& u) const {
        const int n0 = r0 < 0 ? 0 : 1, n1 = r1 < 0 ? 0 : (r1 < 64 ? 2 : 1), n2 = r2 < 0 ? 0 : (r2 < 64 ? 2 : 1);
        if (i < n0) { const int L = r0; u.pm = L / 6; u.pn = L - u.pm * 6; u.a = qa + (size_t)u.pm * 524288; u.b = qb + (size_t)u.pn * 524288; u.nt = 12; u.kind = 0; return true; }
        i -= n0;
        if (i < n1) { const int L = i * 192 + r1; u.pm = L >> 3; u.pn = L & 7; u.a = ka + (size_t)u.pm * 524288; u.b = kb + (size_t)u.pn * 524288; u.nt = 8; u.kind = 1; return true; }
        i -= n1;
        if (i < n2) { const int L = i * 192 + r2; u.pm = L >> 3; u.pn = L & 7; u.a = la + (size_t)u.pm * 524288 + (size_t)u.pn * 256; u.b = lb + (size_t)u.pn * 524288; u.nt = 2; u.kind = 2; return true; }
        return false;
    }
    __device__ __forceinline__ void a_ready(const Unit&) const {}
    __device__ __forceinline__ void done(const Unit&) const {}
};
struct EpiP3 {
    static constexpr bool PERM = false, AFTER_DRAIN = false;
    EpiBf16Split q, kv; EpiLru lru;
    __device__ __forceinline__ void operator()(const f32x4 (&acc)[2][2][4][2], const Unit& u, int wr, int wc, int fr, int fq) const {
        if (u.kind == 0) q(acc, u, wr, wc, fr, fq); else if (u.kind == 1) kv(acc, u, wr, wc, fr, fq); else lru(acc, u, wr, wc, fr, fq);
    }
};

template <class Epi, class Sched, bool ALIGN_EPI = false, bool SP2 = false, bool BLK = false>
__device__ __forceinline__ void gemm_phase(PG8_LAS unsigned char* lds, const Gemm g, const Sched& S, const Epi& E, const int wv) {
    int lane = lane_id(); asm volatile("" : "+v"(lane));
    int wid = wv; asm volatile("" : "+s"(wid));
    const int tid = wid * 64 + lane, wr = wid >> 2, wc = wid & 3, fr = lane & 15, fq = lane >> 4;
    int K = g.K; asm volatile("" : "+s"(K));
    int nt = K / BK;
    unsigned voffA[2], voffB[2];
#pragma unroll
    for (int i = 0; i < 2; ++i) { int R, C; stage_rc(tid * 16 + i * 8192, R, C); const int Rb = Epi::PERM ? ((R & ~31) + perm32(R & 31)) : R;
        voffA[i] = (unsigned)(R * (BLK ? BK : g.lda) + C) * 2u; voffB[i] = (unsigned)(Rb * (BLK ? BK : g.ldb) + C) * 2u; }
    const size_t kstep = BLK ? (size_t)(BM * BK * 2) : (size_t)(BK * 2);
    const size_t hA = BLK ? (size_t)(HALF * BK * 2) : (size_t)HALF * g.lda * 2, hB = BLK ? (size_t)(HALF * BK * 2) : (size_t)HALF * g.ldb * 2;
    const size_t tA = BLK ? (size_t)nt * (BM * BK * 2) : 2 * hA, tB = BLK ? (size_t)nt * (BM * BK * 2) : 2 * hB; const size_t acs = (size_t)g.a_colstep;
    const unsigned ldsw = (unsigned)wid * 1024u;
    const int aoff = lds_byte(wr * 64 + fr, fq * 8), boff = lds_byte(wc * 32 + fr, fq * 8);
#define PG8_SA(b, h) (((b) * 2 + (h)) * HTB)
#define PG8_SB(b, h) ((4 + (b) * 2 + (h)) * HTB)
#define PG8_STAGE(bufoff, gbase, voff) do { _Pragma("unroll") for (int _i = 0; _i < 2; ++_i) \
        __builtin_amdgcn_global_load_lds((const unsigned*)((const char*)(gbase) + (voff)[_i]), (PG8_LAS unsigned*)(lds + (bufoff) + ldsw + _i * 8192), 16, 0, 0); } while (0)
#define PG8_LDA(dst, b, h) do { _Pragma("unroll") for (int m = 0; m < 4; ++m) _Pragma("unroll") for (int k = 0; k < 2; ++k) dst[m][k] = *(const PG8_LAS bf16x8*)(lds + PG8_SA(b, h) + aoff + m * 2048 + k * 1024); } while (0)
#define PG8_LDB(dst, b, h) do { _Pragma("unroll") for (int n = 0; n < 2; ++n) _Pragma("unroll") for (int k = 0; k < 2; ++k) dst[n][k] = *(const PG8_LAS bf16x8*)(lds + PG8_SB(b, h) + boff + n * 2048 + k * 1024); } while (0)
#define PG8_MMA(ai, bj, At, Bt) do { __builtin_amdgcn_s_setprio(1); _Pragma("unroll") for (int m = 0; m < 4; ++m) _Pragma("unroll") for (int n = 0; n < 2; ++n) _Pragma("unroll") for (int k = 0; k < 2; ++k) \
        acc[ai][bj][m][n] = __builtin_amdgcn_mfma_f32_16x16x32_bf16(Bt[n][k], At[m][k], acc[ai][bj][m][n], 0, 0, 0); __builtin_amdgcn_s_setprio(0); } while (0)
#define PG8_WAIT_V(n) asm volatile("s_waitcnt vmcnt(" #n ")" ::: "memory")
#define PG8_WAIT_L(n) asm volatile("s_waitcnt lgkmcnt(" #n ")" ::: "memory")
#define PG8_BAR __builtin_amdgcn_s_barrier()
#define PG8_SCHED __builtin_amdgcn_sched_barrier(0)
    Unit cur, nxt; int ui = 0;
    if (!S.next(0, cur)) return;
    constexpr bool RESC = epi_resc<Epi>::v;
    PG8_LAS float* const ftab = (PG8_LAS float*)(lds + FAC_LDS_OFF);
    f32x4 acc[2][2][4][2];
#pragma unroll
    for (int a = 0; a < 2; ++a)
#pragma unroll
        for (int b = 0; b < 2; ++b)
#pragma unroll
            for (int m = 0; m < 4; ++m)
#pragma unroll
                for (int n = 0; n < 2; ++n) acc[a][b][m][n] = (f32x4){0.f, 0.f, 0.f, 0.f};
    bf16x8 At[4][2], B0[2][2], B1[2][2];
    const char* cA = Sched::MULTI ? cur.a : (const char*)g.A + (size_t)cur.pm * tA + (size_t)cur.pn * acs; const char* cB = Sched::MULTI ? cur.b : (const char*)g.Bt + (size_t)cur.pn * tB;
    if constexpr (Sched::MULTI) nt = cur.nt;
    S.a_ready(cur);
    if constexpr (SP2) {
        PG8_STAGE(PG8_SB(0, 0), cB, voffB); PG8_STAGE(PG8_SB(0, 1), cB + hB, voffB); PG8_STAGE(PG8_SA(0, 0), cA, voffA); PG8_STAGE(PG8_SA(0, 1), cA + hA, voffA);
        if (wr == 1) PG8_BAR;
        PG8_WAIT_V(2); PG8_BAR;
        PG8_STAGE(PG8_SB(1, 0), cB + kstep, voffB); PG8_STAGE(PG8_SA(1, 0), cA + kstep, voffA); PG8_STAGE(PG8_SB(1, 1), cB + hB + kstep, voffB);
        PG8_WAIT_V(6); PG8_BAR;
    } else {
        PG8_STAGE(PG8_SB(0, 0), cB, voffB); PG8_STAGE(PG8_SA(0, 0), cA, voffA); PG8_STAGE(PG8_SB(0, 1), cB + hB, voffB); PG8_STAGE(PG8_SA(0, 1), cA + hA, voffA);
        if (wr == 1) PG8_BAR;
        PG8_WAIT_V(4); PG8_BAR;
        PG8_STAGE(PG8_SB(1, 0), cB + kstep, voffB); PG8_STAGE(PG8_SA(1, 0), cA + kstep, voffA); PG8_STAGE(PG8_SB(1, 1), cB + hB + kstep, voffB);
        PG8_WAIT_V(6); PG8_BAR;
    }
    if constexpr (RESC) { Unit u1; const bool two = S.next(1, u1);
        if (wid < 4) *(PG8_LAS f32x4*)(ftab + tid * 4) = E.facs(cur.pm * BM + tid);
        else if (two) *(PG8_LAS f32x4*)(ftab + 1024 + (tid - 256) * 4) = E.facs(u1.pm * BM + tid - 256); }
    for (;;) {
        const bool has_next = S.next(ui + 1, nxt);
        const char* nA = has_next ? (Sched::MULTI ? nxt.a : (const char*)g.A + (size_t)nxt.pm * tA + (size_t)nxt.pn * acs) : cA; const char* nB = has_next ? (Sched::MULTI ? nxt.b : (const char*)g.Bt + (size_t)nxt.pn * tB) : cB;
        for (int t = 0; t < nt; t += 2) {
            const bool last = (t == nt - 2);
            const char* a1 = cA + (size_t)(t + 1) * kstep;
            const char* a2 = last ? nA : cA + (size_t)(t + 2) * kstep; const char* b2 = last ? nB : cB + (size_t)(t + 2) * kstep;
            const char* a3 = a2 + kstep; const char* b3 = b2 + kstep;
            if (last && has_next) S.a_ready(nxt);
            if constexpr (RESC) { if (t != 0 && (t & 15) == 0) {
                const PG8_LAS float* fp = ftab + (ui & 1) * 1024 + (wr * 64 + (lane_id() & 15)) * 4 + ((t >> 4) - 1);
#pragma unroll
                for (int ai = 0; ai < 2; ++ai)
#pragma unroll
                    for (int m = 0; m < 4; ++m) { const float f = fp[(ai * HALF + m * 16) * 4];
#pragma unroll
                        for (int bj = 0; bj < 2; ++bj)
#pragma unroll
                            for (int n = 0; n < 2; ++n) acc[ai][bj][m][n] *= f; } } }
            if constexpr (SP2) {
            PG8_LDB(B0, 0, 0); PG8_LDB(B1, 0, 1); PG8_SCHED; PG8_LDA(At, 0, 0); PG8_STAGE(PG8_SA(1, 1), a1 + hA, voffA);
            PG8_WAIT_V(8); PG8_WAIT_L(0); PG8_BAR; PG8_MMA(0, 0, At, B0); PG8_MMA(0, 1, At, B1); PG8_BAR; PG8_SCHED;
            PG8_LDA(At, 0, 1); PG8_STAGE(PG8_SB(0, 0), b2, voffB); PG8_STAGE(PG8_SB(0, 1), b2 + hB, voffB); PG8_STAGE(PG8_SA(0, 0), a2, voffA);
            PG8_WAIT_V(8); PG8_WAIT_L(0); PG8_BAR; PG8_MMA(1, 0, At, B0); PG8_MMA(1, 1, At, B1); PG8_BAR; PG8_SCHED;
            PG8_LDB(B0, 1, 0); PG8_LDB(B1, 1, 1); PG8_SCHED; PG8_LDA(At, 1, 0); PG8_STAGE(PG8_SA(0, 1), a2 + hA, voffA);
            PG8_WAIT_V(8); PG8_WAIT_L(0); PG8_BAR; PG8_MMA(0, 0, At, B0); PG8_MMA(0, 1, At, B1); PG8_BAR; PG8_SCHED;
            PG8_LDA(At, 1, 1); PG8_STAGE(PG8_SB(1, 0), b3, voffB); PG8_STAGE(PG8_SB(1, 1), b3 + hB, voffB); PG8_STAGE(PG8_SA(1, 0), a3, voffA);
            PG8_WAIT_V(8); PG8_WAIT_L(0); PG8_BAR; PG8_MMA(1, 0, At, B0); PG8_MMA(1, 1, At, B1); PG8_BAR; PG8_SCHED;
            } else {
            PG8_LDB(B0, 0, 0); PG8_SCHED; PG8_LDA(At, 0, 0); PG8_STAGE(PG8_SA(1, 1), a1 + hA, voffA);
            PG8_WAIT_L(8); PG8_BAR; PG8_WAIT_L(0); PG8_MMA(0, 0, At, B0); PG8_BAR; PG8_SCHED;
            PG8_LDB(B1, 0, 1); PG8_STAGE(PG8_SB(0, 0), b2, voffB);
            PG8_BAR; PG8_WAIT_L(0); PG8_MMA(0, 1, At, B1); PG8_BAR;
            PG8_LDA(At, 0, 1); PG8_STAGE(PG8_SA(0, 0), a2, voffA);
            PG8_BAR; PG8_WAIT_L(0); PG8_MMA(1, 0, At, B0); PG8_BAR; PG8_SCHED;
            PG8_STAGE(PG8_SB(0, 1), b2 + hB, voffB);
            PG8_WAIT_V(6); PG8_BAR; PG8_MMA(1, 1, At, B1); PG8_BAR;
            PG8_LDB(B0, 1, 0); PG8_SCHED; PG8_LDA(At, 1, 0); PG8_STAGE(PG8_SA(0, 1), a2 + hA, voffA);
            PG8_WAIT_L(8); PG8_BAR; PG8_WAIT_L(0); PG8_MMA(0, 0, At, B0); PG8_BAR; PG8_SCHED;
            PG8_LDB(B1, 1, 1); PG8_STAGE(PG8_SB(1, 0), b3, voffB);
            PG8_BAR; PG8_WAIT_L(0); PG8_MMA(0, 1, At, B1); PG8_BAR;
            PG8_LDA(At, 1, 1); PG8_STAGE(PG8_SA(1, 0), a3, voffA);
            PG8_BAR; PG8_WAIT_L(0); PG8_MMA(1, 0, At, B0); PG8_BAR; PG8_SCHED;
            PG8_STAGE(PG8_SB(1, 1), b3 + hB, voffB);
            PG8_WAIT_V(6); PG8_BAR; PG8_MMA(1, 1, At, B1); PG8_BAR;
            }
        }
        if constexpr (ALIGN_EPI) { if (wr == 0) PG8_BAR; }
        PG8_SCHED; asm volatile("" ::: "memory");
        if constexpr (RESC) {
            const PG8_LAS float* fp = ftab + (ui & 1) * 1024 + (wr * 64 + (lane_id() & 15)) * 4 + 3;
#pragma unroll
            for (int ai = 0; ai < 2; ++ai)
#pragma unroll
                for (int m = 0; m < 4; ++m) { const float f = fp[(ai * HALF + m * 16) * 4];
#pragma unroll
                    for (int bj = 0; bj < 2; ++bj)
#pragma unroll
                        for (int n = 0; n < 2; ++n) acc[ai][bj][m][n] *= f; } }
        if constexpr (!Epi::AFTER_DRAIN) { int fr2 = fr, fq2 = fq; if constexpr (RESC) { const int l2 = lane_id(); fr2 = l2 & 15; fq2 = l2 >> 4; } asm volatile("" : "+v"(fr2), "+v"(fq2));
            E(acc, cur, wr, wc, fr2, fq2); S.done(cur); }
        if constexpr (RESC) { if (has_next && ui >= 1 && wid < 4) *(PG8_LAS f32x4*)(ftab + ((ui + 1) & 1) * 1024 + tid * 4) = E.facs(nxt.pm * BM + tid); }
        PG8_SCHED;
        if (!has_next) break;
#pragma unroll
        for (int a = 0; a < 2; ++a)
#pragma unroll
            for (int b = 0; b < 2; ++b)
#pragma unroll
                for (int m = 0; m < 4; ++m)
#pragma unroll
                    for (int n = 0; n < 2; ++n) acc[a][b][m][n] = (f32x4){0.f, 0.f, 0.f, 0.f};
        cur = nxt; cA = nA; cB = nB; ++ui; if constexpr (Sched::MULTI) nt = cur.nt;
        if constexpr (ALIGN_EPI) { if (wr == 1) PG8_BAR; }
    }
    PG8_WAIT_V(0);
    if constexpr (!ALIGN_EPI) { if (wr == 0) PG8_BAR; }
    PG8_BAR;
#undef PG8_SA
#undef PG8_SB
#undef PG8_STAGE
#undef PG8_LDA
#undef PG8_LDB
#undef PG8_MMA
#undef PG8_WAIT_V
#undef PG8_WAIT_L
#undef PG8_BAR
#undef PG8_SCHED
}
}

constexpr int NWAVES = 8;
constexpr int NB = 4, SEQ = 2048, T = NB * SEQ, DM = 4096, BR = 1024, DEPTH = 2;
constexpr int KS = DM + 64;
constexpr int INC = 9552;
constexpr int ZC = 9728;
constexpr int Z_S5U = 0, Z_S5G = 1024, Z_CQ = 2048, Z_CKV = 2816, Z_MG = 3328, Z_GQ = 4352, Z_GK = 4864, Z_GV = 5376, Z_GG = 6400, Z_LU = 7424, Z_LG = 8448, Z_KR = 9472, Z_GLR = 9536;
constexpr int QR = 768, KVR = 512, NH = 8, DQK = 192, DNOPE = 128, DROPE = 64, DV = 128;
constexpr int S5G = 64, S5H = 16, S5P = 64;
constexpr int GH = 4, GDK = 128, GDV = 256;
constexpr float EPS = 1e-6f;

constexpr size_t al256(size_t x) { return (x + 255) & ~(size_t)255; }
constexpr size_t WS_CTL = 0, CTL_ZERO_BYTES = 1u << 16;
constexpr size_t WS_WTIN = CTL_ZERO_BYTES;
constexpr size_t WS_WTOUT = WS_WTIN + (size_t)2 * ZC * KS * 2;
constexpr size_t WS_HB = WS_WTOUT + (size_t)2 * DM * KS * 2;
constexpr size_t WS_Z = WS_HB + (size_t)T * KS * 2;
constexpr size_t WS_XB = WS_Z + (size_t)T * ZC * 2;
constexpr size_t WS_CQB = WS_XB + (size_t)T * DM * 4;
constexpr size_t WS_CKVB = WS_CQB + (size_t)T * BR * 2;
constexpr size_t WS_XCB = WS_CKVB + (size_t)T * BR * 2;
constexpr size_t WS_YS5B = WS_XCB + (size_t)T * BR * 2;
constexpr size_t WS_WTUQ = WS_YS5B + (size_t)T * BR * 2;
constexpr size_t WS_WTUKV = WS_WTUQ + (size_t)2 * 1536 * BR * 2;
constexpr size_t WS_WTGLU = WS_WTUKV + (size_t)2 * 2048 * BR * 2;
constexpr size_t WS_WTLRU = WS_WTGLU + (size_t)2 * BR * BR * 2;
constexpr size_t WS_KR = WS_WTLRU + (size_t)2 * 8 * 256 * 1024 * 2;
constexpr size_t WS_Q = WS_KR + (size_t)T * DROPE * 2;
constexpr size_t WS_KN = WS_Q + (size_t)T * NH * DQK * 2;
constexpr size_t WS_V = WS_KN + (size_t)T * BR * 2;
constexpr size_t WS_KVT = WS_V + (size_t)T * BR * 2;
constexpr size_t WS_ST = WS_KVT + (size_t)512 * 256 * 128 * 4;
constexpr size_t WS_QDEC = WS_ST + (size_t)512 * 256 * 128 * 2;
constexpr size_t WS_DEC = WS_QDEC + (size_t)T * 512 * 2;
constexpr size_t WS_XC = WS_DEC + (size_t)512 * 128 * 4;
constexpr size_t WS_SSQ = WS_XC;
constexpr size_t WS_LGB = WS_XC + (4u << 20);
constexpr size_t WS_RPRE = WS_XC + (size_t)T * BR * 4;
constexpr size_t WS_IPRE = WS_RPRE + (size_t)T * BR * 4;
constexpr size_t WS_HLRU = WS_IPRE + (size_t)T * BR * 4;
constexpr size_t WS_S5O = WS_HLRU + (size_t)T * BR * 4;
constexpr size_t WS_OGLA = WS_S5O + (size_t)T * BR * 4;
constexpr size_t WS_OMLA = WS_OGLA + (size_t)T * BR * 4;
constexpr size_t WS_ROPE = WS_OMLA + (size_t)T * BR * 4;
constexpr size_t WS_LAMB = WS_ROPE + (size_t)T * 64 * 4;
constexpr size_t WS_BBAR = WS_LAMB + (size_t)2 * 64 * 64 * 2 * 4;
constexpr size_t WS_SPL = WS_BBAR + (size_t)2 * 64 * 64 * 16 * 2 * 4;
constexpr size_t WS_S5A = WS_SPL + (size_t)2 * 1024 * 4;
constexpr size_t WS_S5B1 = WS_S5A + (size_t)64 * 256 * 640 * 2;
constexpr size_t WS_S5B2 = WS_S5B1 + (size_t)64 * 256 * 640 * 2;
constexpr size_t WS_S5L = WS_S5B2 + (size_t)64 * 512 * 640 * 2;
constexpr size_t WS_L32 = WS_S5L + (size_t)64 * 256 * 128 * 4;
constexpr size_t WS_WG2T = WS_L32 + (size_t)64 * 64 * 2 * 4;
constexpr size_t WS_END = WS_WG2T + (size_t)2 * 512 * 16 * 2;
static_assert(Z_LG == 33 * 256 && (size_t)T * 96 * 4 <= (4u << 20) && (4u << 20) + (size_t)T * BR * 2 <= (size_t)T * BR * 4, "XC region carve-up");
static_assert(WS_END <= 1251999744ull, "d_ws map exceeds the guaranteed workspace");

constexpr int RING_OFF = 0, RING_BYTES = 131072;
constexpr int LDSCTL_OFF = RING_BYTES, MISC_OFF = LDSCTL_OFF + 320;
constexpr int LDS_BYTES = 147456;

#define GAS __attribute__((address_space(1)))
#define LAS __attribute__((address_space(3)))
typedef unsigned short bf16;
typedef unsigned v4u __attribute__((ext_vector_type(4)));
typedef float f32x4 __attribute__((ext_vector_type(4)));
typedef GAS unsigned gu32;
#define RLX_AGENT __ATOMIC_RELAXED, __HIP_MEMORY_SCOPE_AGENT
#define LDS_WAIT() asm volatile("s_waitcnt lgkmcnt(0)" ::: "memory")
__device__ __forceinline__ unsigned f2bf(float f) { unsigned u = __builtin_bit_cast(unsigned, f); return (u + 0x7fffu + ((u >> 16) & 1u)) >> 16; }
__device__ __forceinline__ unsigned pk2(float lo, float hi) { return f2bf(lo) | (f2bf(hi) << 16); }
__device__ __forceinline__ float bf2f(bf16 v) { return __uint_as_float((unsigned)v << 16); }
__device__ __forceinline__ size_t blk4k(size_t r, int k) { return (((r >> 8) * 64 + (size_t)(k >> 6)) << 14) + ((r & 255) << 6) + (size_t)(k & 63); }
__device__ __forceinline__ f32x4 z4(const bf16* p) { const unsigned long long w = *(const unsigned long long*)p; const unsigned a = (unsigned)w, b = (unsigned)(w >> 32); return (f32x4){__uint_as_float(a << 16), __uint_as_float(a & 0xffff0000u), __uint_as_float(b << 16), __uint_as_float(b & 0xffff0000u)}; }

#define XB_TMO      128
#define XB_XCNT(j)  (256  + 64 * (j))
#define XB_XSUB(j)  (1280 + 64 * (j))
#define XB_XGEN(j)  (2304 + 64 * (j))
#define XB_TOP      3328
#define XB_TOPGEN   3392
#define XCD_BAR_WORDS 3456
#define XB_SPIN_CAP (1u << 23)
__device__ __forceinline__ unsigned xb_ld(unsigned* p)              { return __hip_atomic_load(p, __ATOMIC_RELAXED, __HIP_MEMORY_SCOPE_AGENT); }
__device__ __forceinline__ unsigned xb_add(unsigned* p, unsigned v) { return __hip_atomic_fetch_add(p, v, __ATOMIC_RELAXED, __HIP_MEMORY_SCOPE_AGENT); }
__device__ __forceinline__ unsigned xb_xcc_id() { return (unsigned)__builtin_amdgcn_s_getreg((3 << 11) | 20) & 0xFu; }
#define XB_SPIN(cond, bar) do { unsigned _sp = 0; while (cond) { __builtin_amdgcn_s_sleep(1); \
    if ((++_sp & 255u) == 0u) { if (xb_ld(&(bar)[XB_TMO])) break; if (_sp > XB_SPIN_CAP) { atomicAdd(&(bar)[XB_TMO], 1u); break; } } } } while (0)
struct XcdBarrier { unsigned* bar; unsigned x; volatile LAS unsigned* st; };
__device__ __forceinline__ XcdBarrier xcd_barrier_post(unsigned* bar, volatile LAS unsigned* st, const bool t0) {
    XcdBarrier b; b.bar = bar; b.x = xb_xcc_id(); b.st = st;
    if (t0) (void)xb_add(&bar[XB_XCNT(b.x)], 1u);
    return b;
}
__device__ __forceinline__ void xcd_barrier_complete(unsigned* bar, unsigned x, unsigned& nloc, unsigned& nx) {
    const unsigned G = gridDim.x * gridDim.y * gridDim.z;
    unsigned sum, cnt, mine, sp = 0u;
    for (;;) {
        sum = 0u; cnt = 0u; mine = 0u;
#pragma unroll
        for (unsigned j = 0; j < 16; ++j) { const unsigned c = xb_ld(&bar[XB_XCNT(j)]); sum += c; cnt += (c > 0u) ? 1u : 0u; mine = (j == x) ? c : mine; }
        if (sum == G) break;
        __builtin_amdgcn_s_sleep(1);
        if ((++sp & 255u) == 0u) { if (xb_ld(&bar[XB_TMO])) break; if (sp > XB_SPIN_CAP) { atomicAdd(&bar[XB_TMO], 1u); break; } }
    }
    nloc = mine > 0u ? mine : 1u; nx = cnt > 0u ? cnt : 1u;
}
__device__ __forceinline__ void xcd_barrier(const XcdBarrier& b, const bool t0) {
    asm volatile("s_waitcnt vmcnt(0)" ::: "memory");
    __syncthreads();
    if (t0) {
        unsigned* bar = b.bar; unsigned bx = b.x; asm volatile("" : "+s"(bar), "+s"(bx));
        __builtin_amdgcn_s_waitcnt(0);
        unsigned nloc = b.st[0], nx = b.st[1];
        if (nloc == 0u) { xcd_barrier_complete(bar, bx, nloc, nx); b.st[0] = nloc; b.st[1] = nx; }
        const unsigned old = xb_add(&bar[XB_XSUB(bx)], 1u);
        const unsigned gen = old / nloc;
        if (old + 1u == (gen + 1u) * nloc) {
            __builtin_amdgcn_fence(__ATOMIC_RELEASE, "agent");
            asm volatile("s_waitcnt vmcnt(0)" ::: "memory");
            const unsigned og = xb_add(&bar[XB_TOP], 1u);
            const unsigned tg = og / nx;
            if (og + 1u == (tg + 1u) * nx) xb_add(&bar[XB_TOPGEN], 1u);
            else XB_SPIN(xb_ld(&bar[XB_TOPGEN]) == tg, bar);
            __builtin_amdgcn_fence(__ATOMIC_ACQUIRE, "agent");
            xb_add(&bar[XB_XGEN(bx)], 1u);
            asm volatile("s_waitcnt vmcnt(0)" ::: "memory");
        } else {
            XB_SPIN(xb_ld(&bar[XB_XGEN(bx)]) == gen, bar);
            __builtin_amdgcn_fence(__ATOMIC_ACQUIRE, "agent");
            asm volatile("s_waitcnt vmcnt(0)" ::: "memory");
        }
    }
    __syncthreads();
}

struct Args { const void* in[34]; float* out; unsigned char* ws; int ph_lo, ph_hi; };
struct Frame {
    LAS unsigned char* lds;
    unsigned char* ldsg;
    int vcu, G, wv;
};
typedef const __attribute__((address_space(4))) Args* ArgsP;
#define IN_F(i) ((const float*)AP->in[i])
#define PHASE_IDS() int lane = lane_id(); asm volatile("" : "+v"(lane)); const int wave = F.wv; const int tid = wave * 64 + lane; (void)tid; \
    ArgsP AP = (ArgsP)__builtin_amdgcn_kernarg_segment_ptr(); asm volatile("" : "+s"(AP))
#define WSF(off) ((float*)(AP->ws + (off)))

__device__ __forceinline__ float xl_get(float v, int src) { return __int_as_float(__builtin_amdgcn_ds_bpermute(src << 2, __float_as_int(v))); }
__device__ __forceinline__ float xl_xor(float v, int m) { return xl_get(v, lane_id() ^ m); }
__device__ __forceinline__ float wave_sum(float v) {
    const int ln = lane_id();
#pragma unroll
    for (int o = 1; o < 64; o <<= 1) v += xl_get(v, ln ^ o);
    return v;
}
__device__ __forceinline__ float wave_max(float v) {
    const int ln = lane_id();
#pragma unroll
    for (int o = 1; o < 64; o <<= 1) v = fmaxf(v, xl_get(v, ln ^ o));
    return v;
}
__device__ __forceinline__ float sigmoidf_(float x) { return __builtin_amdgcn_rcpf(1.0f + __expf(-x)); }
__device__ __forceinline__ float siluf_(float x) { return x * sigmoidf_(x); }
__device__ __forceinline__ float softplusf_(float x) { return fmaxf(x, 0.f) + log1pf(__expf(-fabsf(x))); }
__device__ __forceinline__ float gelu_tanh(float x) { const float u = 0.7978845608028654f * (x + 0.044715f * x * x * x); const float e = __expf(2.f * u); const float th = 1.f - 2.f / (e + 1.f); return 0.5f * x * (1.f + th); }

__device__ __forceinline__ int zc_src(int n) {
    if (n < 3328) return n; if (n < 6400) return n + 64; if (n < 9472) return n + 80; if (n < 9536) return n - 9472 + 3328; if (n < 9552) return n - 9536 + 6464; return -1;
}
template <bool MAPPED>
__device__ __forceinline__ void p0_transpose_item(const float* W, int K, int Nsrc, int Ndst, bf16* WT, LAS float* scr, int item, int lane, int ldw = 0) {
    if (ldw == 0) ldw = K;
    const int nblk = Ndst / 32, kb = item / nblk, nb = item % nblk, k0 = 64 * kb, n0 = 32 * nb;
    const int nd = n0 + (lane & 31); const int ns = MAPPED ? zc_src(nd) : nd;
    float tv[32];
#pragma unroll
    for (int i = 0; i < 32; ++i) { const int kk = 2 * i + (lane >> 5); tv[i] = ns >= 0 ? W[(size_t)(k0 + kk) * Nsrc + ns] : 0.f; }
#pragma unroll
    for (int i = 0; i < 32; ++i) { const int kk = 2 * i + (lane >> 5); scr[kk * 33 + (lane & 31)] = tv[i]; }
    LDS_WAIT(); asm volatile("" ::: "memory");
    const int c = lane & 7;
#pragma unroll
    for (int j = 0; j < 4; ++j) { const int n = (lane >> 3) + 8 * j; const LAS float* s = scr + (8 * c) * 33 + n;
        v4u o; o.x = pk2(s[0 * 33], s[1 * 33]); o.y = pk2(s[2 * 33], s[3 * 33]); o.z = pk2(s[4 * 33], s[5 * 33]); o.w = pk2(s[6 * 33], s[7 * 33]);
        *(GAS v4u*)(WT + (size_t)(n0 + n) * ldw + k0 + 8 * c) = o; }
    LDS_WAIT(); asm volatile("" ::: "memory");
}
template <bool TOBF>
__device__ __forceinline__ void rms_row(const float* xrow, const float* g, void* orow, int lane, size_t mrow = 0) {
    const f32x4* xr = (const f32x4*)xrow + lane; const f32x4* gr = (const f32x4*)g + lane;
    f32x4 v[16], gv[16]; float s = 0.f;
#pragma unroll
    for (int j = 0; j < 16; ++j) { v[j] = xr[64 * j]; gv[j] = gr[64 * j]; s += (v[j].x * v[j].x + v[j].y * v[j].y) + (v[j].z * v[j].z + v[j].w * v[j].w); }
    const float rs = 1.0f / sqrtf(wave_sum(s) * (1.f / DM) + EPS);
    bf16* ob = (bf16*)orow + blk4k(mrow, 4 * lane);
#pragma unroll
    for (int j = 0; j < 16; ++j) { const f32x4 o = v[j] * rs * gv[j];
        if (TOBF) *(unsigned long long*)(ob + ((size_t)j << 16)) = (unsigned long long)pk2(o.x, o.y) | ((unsigned long long)pk2(o.z, o.w) << 32);
        else ((f32x4*)orow)[lane + 64 * j] = o; }
}

constexpr int TP_I_IN = (DM / 64) * (ZC / 32), TP_I_OUT = (DM / 64) * (DM / 32);
constexpr int TP_I_UQ = (QR / 64) * (1536 / 32), TP_I_UK = (KVR / 64) * (BR / 32), TP_I_GLU = (BR / 64) * (BR / 32), TP_I_LRU = 2 * 4;
constexpr int TP_SM = TP_I_UQ + 2 * TP_I_UK + TP_I_GLU + 16 * TP_I_LRU;
constexpr int TP_NL = TP_SM + TP_I_IN + TP_I_OUT;
struct TpD { const float* src; bf16* dst; int nsrc; int ldw; bool ok; };
__device__ __forceinline__ int tp_item_l0(int j) { if (j < TP_SM) return j; j -= TP_SM; if (j < TP_I_IN) return 2 * TP_SM + j; j -= TP_I_IN; return 2 * TP_SM + 2 * TP_I_IN + j; }
__device__ __forceinline__ int tp_item_l1(int j) { if (j < TP_I_IN) return 2 * TP_SM + TP_I_IN + j; j -= TP_I_IN; if (j < TP_SM) return TP_SM + j; j -= TP_SM; return 2 * TP_SM + 2 * TP_I_IN + TP_I_OUT + j; }
__device__ __forceinline__ TpD tp_decode(ArgsP AP, int lane, int it) {
    int r = it; const float* W; int Nsrc, Ndst, ldw; bf16* WT; bool mapped = false;
    if (r < 2 * TP_SM) { const int l = r / TP_SM; r -= l * TP_SM;
        if (r < TP_I_UQ) { W = IN_F(17) + (size_t)l * QR * 1536; Nsrc = 1536; Ndst = 1536; WT = (bf16*)(AP->ws + WS_WTUQ) + (size_t)l * 1536 * BR; ldw = BR; }
        else if ((r -= TP_I_UQ) < TP_I_UK) { W = IN_F(18) + (size_t)l * KVR * BR; Nsrc = BR; Ndst = BR; WT = (bf16*)(AP->ws + WS_WTUKV) + (size_t)l * 2048 * BR; ldw = BR; }
        else if ((r -= TP_I_UK) < TP_I_UK) { W = IN_F(19) + (size_t)l * KVR * BR; Nsrc = BR; Ndst = BR; WT = (bf16*)(AP->ws + WS_WTUKV) + ((size_t)l * 2048 + 1024) * BR; ldw = BR; }
        else if ((r -= TP_I_UK) < TP_I_GLU) { W = IN_F(12) + (size_t)l * BR * BR; Nsrc = BR; Ndst = BR; WT = (bf16*)(AP->ws + WS_WTGLU) + (size_t)l * BR * BR; ldw = BR; }
        else { r -= TP_I_GLU; const int jj = r / TP_I_LRU, gate = jj & 1, j = jj >> 1; r -= jj * TP_I_LRU;
            W = IN_F(gate ? 28 : 26) + (size_t)(l * 8 + j) * 128 * 128; Nsrc = 128; Ndst = 128; WT = (bf16*)(AP->ws + WS_WTLRU) + ((size_t)(l * 8 + j) * 256 + gate * 128) * 1024; ldw = 1024; }
    } else if ((r -= 2 * TP_SM) < 2 * TP_I_IN) { const int l = r / TP_I_IN; r -= l * TP_I_IN; W = IN_F(3) + (size_t)l * DM * INC; Nsrc = INC; Ndst = ZC; WT = (bf16*)(AP->ws + WS_WTIN) + (size_t)l * ZC * KS; ldw = -1; mapped = true; }
    else { r -= 2 * TP_I_IN; const int l = r / TP_I_OUT; r -= l * TP_I_OUT; W = IN_F(32) + (size_t)l * DM * DM; Nsrc = DM; Ndst = DM; WT = (bf16*)(AP->ws + WS_WTOUT) + (size_t)l * DM * KS; ldw = -1; }
    const int nblk = Ndst / 32, kb = r / nblk, nb = r - kb * nblk, k0 = 64 * kb, n0 = 32 * nb;
    const int nd = n0 + 4 * (lane & 7); const int ns = mapped ? zc_src(nd) : nd;
    TpD d; d.ok = ns >= 0; d.nsrc = Nsrc; d.ldw = ldw; d.src = W + (size_t)(k0 + (lane >> 3)) * Nsrc + (ns >= 0 ? ns : 0); if (ldw < 0) { d.ldw = 64; d.dst = WT + blk4k((size_t)n0, k0); } else d.dst = WT + (size_t)n0 * ldw + k0;
    return d;
}
__device__ __forceinline__ void tp_finish(const TpD& d, const float (&tv)[32], LAS float* scr, int lane) {
#pragma unroll
    for (int i = 0; i < 32; ++i) { const int kk = 8 * (i >> 2) + (lane >> 3); scr[kk * 33 + 4 * (lane & 7) + (i & 3)] = tv[i]; }
    LDS_WAIT(); asm volatile("" ::: "memory");
    const int c = lane & 7;
#pragma unroll
    for (int j = 0; j < 4; ++j) { const int n = (lane >> 3) + 8 * j; const LAS float* sp = scr + (8 * c) * 33 + n;
        v4u o; o.x = pk2(sp[0 * 33], sp[1 * 33]); o.y = pk2(sp[2 * 33], sp[3 * 33]); o.z = pk2(sp[4 * 33], sp[5 * 33]); o.w = pk2(sp[6 * 33], sp[7 * 33]);
        *(GAS v4u*)(d.dst + (size_t)n * d.ldw + 8 * c) = o; }
    LDS_WAIT(); asm volatile("" ::: "memory");
}
constexpr int CW_G2 = 6144;
constexpr int CW_QH = 8192, CW_HC = 8192 + 64;
__device__ __forceinline__ void bg_seam(Frame& F, int k, bool drain) {
    PHASE_IDS();
    LAS float* scr = (LAS float*)(F.lds + RING_OFF + wave * 16384);
    volatile LAS unsigned* bw = (volatile LAS unsigned*)(F.lds + MISC_OFF) + 16;
    unsigned* ctl = (unsigned*)(AP->ws + WS_CTL);
    __syncthreads();
    if (tid == 0) (void)__hip_atomic_fetch_add(ctl + CW_HC + 64 * k, 1u, __ATOMIC_RELAXED, __HIP_MEMORY_SCOPE_AGENT);
    for (;;) {
        if (tid == 0) { unsigned head = 0xffffffffu;
            if (drain || __hip_atomic_load(ctl + CW_HC + 64 * k, __ATOMIC_RELAXED, __HIP_MEMORY_SCOPE_AGENT) < (unsigned)F.G) head = __hip_atomic_fetch_add(ctl + CW_QH, (unsigned)NWAVES, __ATOMIC_RELAXED, __HIP_MEMORY_SCOPE_AGENT);
            bw[0] = head; }
        __syncthreads();
        const unsigned head = bw[0];
        __syncthreads();
        if (head >= (unsigned)TP_NL) break;
        const int j = (int)head + wave;
        if (j < TP_NL) { const TpD d = tp_decode(AP, lane, tp_item_l1(j)); float tv[32];
#pragma unroll
            for (int i = 0; i < 8; ++i) { const f32x4 v = d.ok ? *(const f32x4*)(d.src + (size_t)(8 * i) * d.nsrc) : (f32x4){0.f, 0.f, 0.f, 0.f}; tv[4 * i] = v.x; tv[4 * i + 1] = v.y; tv[4 * i + 2] = v.z; tv[4 * i + 3] = v.w; }
            tp_finish(d, tv, scr, lane); }
    }
}
__device__ __forceinline__ void p0_prologue(Frame& F) {
    PHASE_IDS();
    LAS float* scr = (LAS float*)(F.lds + RING_OFF + wave * 16384);
    const int gw = F.vcu * NWAVES + wave, NGW = F.G * NWAVES;
    float tv[32]; TpD d0 = tp_decode(AP, lane, tp_item_l0(gw < TP_NL ? gw : 0));
    if (gw < TP_NL) {
#pragma unroll
        for (int i = 0; i < 8; ++i) { const f32x4 v = d0.ok ? *(const f32x4*)(d0.src + (size_t)(8 * i) * d0.nsrc) : (f32x4){0.f, 0.f, 0.f, 0.f}; tv[4 * i] = v.x; tv[4 * i + 1] = v.y; tv[4 * i + 2] = v.z; tv[4 * i + 3] = v.w; } }
    for (int it = gw; it < TP_NL; it += NGW) {
        const int itn = it + NGW; const bool more = itn < TP_NL; const TpD d1 = tp_decode(AP, lane, tp_item_l0(more ? itn : it)); float tn[32];
        if (more) {
#pragma unroll
            for (int i = 0; i < 8; ++i) { const f32x4 v = d1.ok ? *(const f32x4*)(d1.src + (size_t)(8 * i) * d1.nsrc) : (f32x4){0.f, 0.f, 0.f, 0.f}; tn[4 * i] = v.x; tn[4 * i + 1] = v.y; tn[4 * i + 2] = v.z; tn[4 * i + 3] = v.w; } }
        tp_finish(d0, tv, scr, lane);
        d0 = d1;
        if (more) {
#pragma unroll
            for (int i = 0; i < 32; ++i) tv[i] = tn[i]; }
    }
    { const int* pos = (const int*)AP->in[1]; float* rt = WSF(WS_ROPE);
      for (int e = blockIdx.x * 512 + tid; e < T * 32; e += F.G * 512) { const int m = e >> 5, i = e & 31;
          const double invf = exp(-(double)i * (9.210340371976184 / 32.0));
          double ang = (double)pos[m] * invf; const double k = rint(ang * 0.15915494309189535); ang -= k * 6.283185307179586;
          const float a = (float)ang; rt[m * 64 + i] = cosf(a); rt[m * 64 + 32 + i] = sinf(a); } }
    { float* lb = WSF(WS_LAMB); float* bb = WSF(WS_BBAR);
      for (int e = blockIdx.x * 512 + tid; e < 2 * 64 * 64; e += F.G * 512) { const int l = e >> 12, g = (e >> 6) & 63;
          const float lre = IN_F(4)[e], lim = IN_F(5)[e]; const float dt = expf(IN_F(11)[l * 64 + g]);
          const float mag = expf(lre * dt); float sn, cs; sincosf(lim * dt, &sn, &cs);
          const float bre = mag * cs, bim = mag * sn; lb[2 * e] = bre; lb[2 * e + 1] = bim;
          const float nre = bre - 1.f, nim = bim, den = 1.f / (lre * lre + lim * lim);
          const float fre = (nre * lre + nim * lim) * den, fim = (nim * lre - nre * lim) * den;
          float brv[16], biv[16];
#pragma unroll
          for (int h = 0; h < 16; ++h) { brv[h] = IN_F(6)[e * 16 + h]; biv[h] = IN_F(7)[e * 16 + h]; }
#pragma unroll
          for (int h = 0; h < 16; ++h) { bb[(e * 16 + h) * 2] = fre * brv[h] - fim * biv[h]; bb[(e * 16 + h) * 2 + 1] = fre * biv[h] + fim * brv[h]; } } }
    for (int e = blockIdx.x * 512 + tid; e < 2 * BR; e += F.G * 512) WSF(WS_SPL)[e] = softplusf_(-IN_F(30)[e]);
    for (int e = blockIdx.x * 512 + tid; e < 2 * 512 * 16; e += F.G * 512) { const int l = e >> 13, col = (e >> 4) & 511, r = e & 15; ((bf16*)(AP->ws + WS_WG2T))[e] = (bf16)f2bf(IN_F(21)[(size_t)(l * 16 + r) * 512 + col]); }
    for (int m = gw; m < T; m += NGW) { asm volatile("" ::: "memory");  rms_row<true>(IN_F(0) + (size_t)m * DM, IN_F(2), (bf16*)(AP->ws + WS_HB), lane, (size_t)m); }
}

__device__ __forceinline__ void up8(const v4u w, float (&f)[8]) {
#pragma unroll
    for (int i = 0; i < 4; ++i) { f[2 * i] = __uint_as_float(w[i] << 16); f[2 * i + 1] = __uint_as_float(w[i] & 0xffff0000u); } }
__device__ __forceinline__ v4u pk8(const float (&f)[8]) { return (v4u){pk2(f[0], f[1]), pk2(f[2], f[3]), pk2(f[4], f[5]), pk2(f[6], f[7])}; }
__device__ __forceinline__ void p2_rows(Frame& F, int l) {
    PHASE_IDS();
    const int gw = F.vcu * NWAVES + wave, NGW = F.G * NWAVES;
    const bf16* z = (const bf16*)(AP->ws + WS_Z);
    const v4u zero = (v4u){0u, 0u, 0u, 0u};
    const f32x4 gq0 = *(const f32x4*)(IN_F(15) + l * QR + 8 * lane), gq1 = *(const f32x4*)(IN_F(15) + l * QR + 8 * lane + 4);
    const f32x4 hq0 = lane < 32 ? *(const f32x4*)(IN_F(15) + l * QR + 512 + 8 * lane) : (f32x4){0.f, 0.f, 0.f, 0.f}, hq1 = lane < 32 ? *(const f32x4*)(IN_F(15) + l * QR + 512 + 8 * lane + 4) : (f32x4){0.f, 0.f, 0.f, 0.f};
    const f32x4 gk0 = *(const f32x4*)(IN_F(16) + l * KVR + 8 * lane), gk1 = *(const f32x4*)(IN_F(16) + l * KVR + 8 * lane + 4);
    f32x4 cb0[2], cb1[2], cw0[2][4], cw1[2][4];
#pragma unroll
    for (int j = 0; j < 2; ++j) { const int c0 = 8 * (lane + 64 * j); cb0[j] = *(const f32x4*)(IN_F(25) + l * BR + c0); cb1[j] = *(const f32x4*)(IN_F(25) + l * BR + c0 + 4);
#pragma unroll
        for (int w = 0; w < 4; ++w) { cw0[j][w] = *(const f32x4*)(IN_F(24) + (l * 4 + w) * BR + c0); cw1[j][w] = *(const f32x4*)(IN_F(24) + (l * 4 + w) * BR + c0 + 4); } }
    for (int m = gw; m < T; m += NGW) {
        asm volatile("" ::: "memory");
        const bf16* zr = z + (size_t)m * ZC; const int t = m & (SEQ - 1);
        const v4u cq0 = *(const v4u*)(zr + Z_CQ + 8 * lane), cq1 = lane < 32 ? *(const v4u*)(zr + Z_CQ + 512 + 8 * lane) : zero, ckv = *(const v4u*)(zr + Z_CKV + 8 * lane);
        v4u lu[2][4];
#pragma unroll
        for (int j = 0; j < 2; ++j)
#pragma unroll
            for (int w = 0; w < 4; ++w) lu[j][w] = (t - 3 + w >= 0) ? *(const v4u*)(z + (size_t)(m - 3 + w) * ZC + Z_LU + 8 * (lane + 64 * j)) : zero;
        const int l5 = lane & 31;
        const float kx1 = bf2f(zr[Z_KR + l5]), kx2 = bf2f(zr[Z_KR + 32 + l5]), kc = WSF(WS_ROPE)[m * 64 + l5], ksn = WSF(WS_ROPE)[m * 64 + 32 + l5];
        { float a[8], b[8]; up8(cq0, a); up8(cq1, b); float s = 0.f;
#pragma unroll
          for (int e = 0; e < 8; ++e) s += a[e] * a[e] + b[e] * b[e];
          const float rs = 1.0f / sqrtf(wave_sum(s) * (1.f / QR) + EPS);
          const float gg[8] = {gq0.x, gq0.y, gq0.z, gq0.w, gq1.x, gq1.y, gq1.z, gq1.w}, hg[8] = {hq0.x, hq0.y, hq0.z, hq0.w, hq1.x, hq1.y, hq1.z, hq1.w};
#pragma unroll
          for (int e = 0; e < 8; ++e) { a[e] *= rs * gg[e]; b[e] *= rs * hg[e]; }
          *(v4u*)((bf16*)(AP->ws + WS_CQB) + (size_t)m * BR + 8 * lane) = pk8(a);
          if (lane < 32) *(v4u*)((bf16*)(AP->ws + WS_CQB) + (size_t)m * BR + 512 + 8 * lane) = pk8(b); }
        { float a[8]; up8(ckv, a); float s = 0.f;
#pragma unroll
          for (int e = 0; e < 8; ++e) s += a[e] * a[e];
          const float rs = 1.0f / sqrtf(wave_sum(s) * (1.f / KVR) + EPS);
          const float gg[8] = {gk0.x, gk0.y, gk0.z, gk0.w, gk1.x, gk1.y, gk1.z, gk1.w};
#pragma unroll
          for (int e = 0; e < 8; ++e) a[e] *= rs * gg[e];
          *(v4u*)((bf16*)(AP->ws + WS_CKVB) + (size_t)m * BR + 8 * lane) = pk8(a); }
        if (lane < 32) { ((bf16*)(AP->ws + WS_KR))[m * 64 + lane] = (bf16)f2bf(kx1 * kc - kx2 * ksn); ((bf16*)(AP->ws + WS_KR))[m * 64 + 32 + lane] = (bf16)f2bf(kx2 * kc + kx1 * ksn); }
#pragma unroll
        for (int j = 0; j < 2; ++j) { const int c0 = 8 * (lane + 64 * j); float o[8] = {cb0[j].x, cb0[j].y, cb0[j].z, cb0[j].w, cb1[j].x, cb1[j].y, cb1[j].z, cb1[j].w};
#pragma unroll
            for (int w = 0; w < 4; ++w) { float xv[8]; up8(lu[j][w], xv); const f32x4 w0 = cw0[j][w], w1 = cw1[j][w];
                o[0] += w0.x * xv[0]; o[1] += w0.y * xv[1]; o[2] += w0.z * xv[2]; o[3] += w0.w * xv[3]; o[4] += w1.x * xv[4]; o[5] += w1.y * xv[5]; o[6] += w1.z * xv[6]; o[7] += w1.w * xv[7]; }
            *(v4u*)((bf16*)(AP->ws + WS_XCB) + (size_t)m * BR + c0) = pk8(o); }
    }
}
__device__ __forceinline__ void s5_prep(Frame& F, int l, int g) {
    PHASE_IDS();
    LAS unsigned char* L = F.lds + RING_OFF;
    LAS float* PW = (LAS float*)L;
    LAS float* BB = PW + 33 * 128;
    LAS float* CC = BB + 2048;
    LAS float* KK = CC + 16 * 130;
    const int lg = l * 64 + g;
    __syncthreads();
    for (int idx = tid; idx < 33 * 64; idx += 512) { const int tau = idx >> 6, p = idx & 63;
        const float lre = IN_F(4)[lg * 64 + p], lim = IN_F(5)[lg * 64 + p], dt = expf(IN_F(11)[lg]);
        const float mag = expf((float)tau * lre * dt); float sn, cs; sincosf((float)tau * lim * dt, &sn, &cs);
        PW[idx * 2] = mag * cs; PW[idx * 2 + 1] = mag * sn;
        if (tau == 32) { WSF(WS_L32)[(g * 64 + p) * 2] = mag * cs; WSF(WS_L32)[(g * 64 + p) * 2 + 1] = mag * sn; } }
    for (int idx = tid; idx < 1024; idx += 512) { BB[idx * 2] = WSF(WS_BBAR)[((size_t)lg * 1024 + idx) * 2]; BB[idx * 2 + 1] = WSF(WS_BBAR)[((size_t)lg * 1024 + idx) * 2 + 1];
        CC[(idx >> 6) * 130 + (idx & 63) * 2] = IN_F(8)[(size_t)lg * 1024 + idx]; CC[(idx >> 6) * 130 + (idx & 63) * 2 + 1] = IN_F(9)[(size_t)lg * 1024 + idx]; }
    __syncthreads();
    {
      const int tau = tid >> 4, h = tid & 15; float acc[16];
#pragma unroll
      for (int j = 0; j < 16; ++j) acc[j] = 0.f;
      for (int p = 0; p < 64; ++p) { const float cr = CC[h * 130 + p * 2], ci = CC[h * 130 + p * 2 + 1], pr = PW[(tau * 64 + p) * 2], pi = PW[(tau * 64 + p) * 2 + 1];
          const float xr = cr * pr - ci * pi, xi = cr * pi + ci * pr;
#pragma unroll
          for (int j = 0; j < 16; ++j) acc[j] += xr * BB[(p * 16 + j) * 2] - xi * BB[(p * 16 + j) * 2 + 1]; }
      if (tau == 0) acc[h] += IN_F(10)[lg * 16 + h];
#pragma unroll
      for (int j = 0; j < 16; ++j) KK[tau * 257 + h * 16 + j] = acc[j]; }
    __syncthreads();
    bf16* B2 = (bf16*)(AP->ws + WS_S5B2) + (size_t)g * 512 * 640; bf16* B1 = (bf16*)(AP->ws + WS_S5B1) + (size_t)g * 256 * 640;
    for (int idx = tid; idx < 512 * 80; idx += 512) { const int R = idx / 80, ch = idx - R * 80, t = R >> 4, h = R & 15; float v[8];
        if (ch < 64) { const int sidx = ch >> 1, h0 = (ch & 1) * 8;
#pragma unroll
            for (int j = 0; j < 8; ++j) v[j] = (t >= sidx) ? KK[(t - sidx) * 257 + h * 16 + h0 + j] : 0.f; }
        else { const int q = ch - 64;
#pragma unroll
            for (int j = 0; j < 8; j += 2) { const int p = 4 * q + (j >> 1); const float cr = CC[h * 130 + p * 2], ci = CC[h * 130 + p * 2 + 1], pr = PW[((t + 1) * 64 + p) * 2], pi = PW[((t + 1) * 64 + p) * 2 + 1];
                v[j] = cr * pr - ci * pi; v[j + 1] = -(cr * pi + ci * pr); } }
        *(v4u*)(B2 + (size_t)R * 640 + ch * 8) = (v4u){pk2(v[0], v[1]), pk2(v[2], v[3]), pk2(v[4], v[5]), pk2(v[6], v[7])}; }
    for (int idx = tid; idx < 128 * 64; idx += 512) { const int R = idx >> 6, ch = idx & 63, p = R >> 1, ri = R & 1, sidx = ch >> 1, h0 = (ch & 1) * 8; float v[8];
        const float pr = PW[((31 - sidx) * 64 + p) * 2], pi = PW[((31 - sidx) * 64 + p) * 2 + 1];
#pragma unroll
        for (int j = 0; j < 8; ++j) { const float br = BB[(p * 16 + h0 + j) * 2], bi = BB[(p * 16 + h0 + j) * 2 + 1]; v[j] = ri ? (pr * bi + pi * br) : (pr * br - pi * bi); }
        *(v4u*)(B1 + (size_t)R * 640 + ch * 8) = (v4u){pk2(v[0], v[1]), pk2(v[2], v[3]), pk2(v[4], v[5]), pk2(v[6], v[7])}; }
    __syncthreads();
}
__device__ __forceinline__ void s5_stage(Frame& F) {
    PHASE_IDS();
    const int gw = F.vcu * NWAVES + wave, NGW = F.G * NWAVES;
    const bf16* z = (const bf16*)(AP->ws + WS_Z); bf16* A = (bf16*)(AP->ws + WS_S5A);
    const int sidx = lane >> 1, hf = lane & 1;
    for (int it0 = gw; it0 < 64 * 256; it0 += 8 * NGW) {
        v4u v[8];
#pragma unroll
        for (int q = 0; q < 8; ++q) { const int it = it0 + q * NGW; if (it < 64 * 256) { const int g = it & 63, r = it >> 6; const size_t m = (size_t)(r >> 6) * 2048 + (size_t)(r & 63) * 32 + sidx;
                v[q] = *(const v4u*)(z + m * ZC + Z_S5U + g * 16 + hf * 8); } }
#pragma unroll
        for (int q = 0; q < 8; ++q) { const int it = it0 + q * NGW; if (it < 64 * 256) { const int g = it & 63, r = it >> 6;
                *(v4u*)(A + ((size_t)g * 256 + r) * 640 + sidx * 16 + hf * 8) = v[q]; } }
    }
}
__device__ __forceinline__ void s5_scan(Frame& F, int g) {
    PHASE_IDS();
    asm volatile("s_waitcnt vmcnt(0)" ::: "memory"); __syncthreads();
    if (tid < 256) { const int b = tid >> 6, p = tid & 63; const float lr = WSF(WS_L32)[(g * 64 + p) * 2], li = WSF(WS_L32)[(g * 64 + p) * 2 + 1];
        const float* sl = WSF(WS_S5L) + ((size_t)g * 256 + b * 64) * 128 + 2 * p; bf16* A = (bf16*)(AP->ws + WS_S5A) + ((size_t)g * 256 + b * 64) * 640 + 512 + 2 * p;
        float xr = 0.f, xi = 0.f; float sre[64], sim[64];
#pragma unroll
        for (int c = 0; c < 64; ++c) { sre[c] = sl[(size_t)c * 128]; sim[c] = sl[(size_t)c * 128 + 1]; }
#pragma unroll
        for (int c = 0; c < 64; ++c) { *(unsigned*)(A + (size_t)c * 640) = pk2(xr, xi);
            const float nr = lr * xr - li * xi + sre[c], ni = lr * xi + li * xr + sim[c]; xr = nr; xi = ni; } }
    asm volatile("s_waitcnt vmcnt(0)" ::: "memory"); __syncthreads();
}
typedef short bf16x8_t __attribute__((ext_vector_type(8)));
typedef float f32x16_t __attribute__((ext_vector_type(16)));
typedef short s16x4_t __attribute__((ext_vector_type(4)));
typedef unsigned u32x4_t __attribute__((ext_vector_type(4)));
__device__ __forceinline__ unsigned cvtpk_s(float lo, float hi) { typedef float f2 __attribute__((ext_vector_type(2))); typedef __bf16 b2 __attribute__((ext_vector_type(2))); f2 v = {lo, hi}; b2 b = __builtin_convertvector(v, b2); return __builtin_bit_cast(unsigned, b); }
constexpr int G1_LA = 0, G1_QD = 32768, G1_QSTR = 272, G1_KI = G1_QD + 64 * G1_QSTR, G1_KD = G1_KI + 64 * G1_QSTR, G1_KDSTR = 320, G1_V = G1_KD + 64 * G1_KDSTR, G1_VSTR = 576, G1_GL = G1_V + 64 * G1_VSTR;
static_assert(G1_GL + 4096 <= RING_BYTES, "GLA LDS map");
__device__ __forceinline__ bf16x8_t tr_frag(const LAS unsigned char* p, int hi_off) {
    const s16x4_t lo = __builtin_bit_cast(s16x4_t, __builtin_amdgcn_ds_read_tr16_b64_v4i16((LAS s16x4_t*)p));
    const s16x4_t hi = __builtin_bit_cast(s16x4_t, __builtin_amdgcn_ds_read_tr16_b64_v4i16((LAS s16x4_t*)(p + hi_off)));
    return (bf16x8_t){lo[0], lo[1], lo[2], lo[3], hi[0], hi[1], hi[2], hi[3]};
}
__device__ __forceinline__ void gla_g1(Frame& F, int l) {
    PHASE_IDS();
    const int hh = lane >> 5, r32 = lane & 31;
    LAS unsigned char* L = F.lds + RING_OFF;
    LAS float* LA = (LAS float*)(L + G1_LA); LAS float* GL = (LAS float*)(L + G1_GL);
    const bf16* z = (const bf16*)(AP->ws + WS_Z);
    for (int k = 0; k < 3; ++k) {
        const int u = F.vcu < 64 ? (k == 0 ? F.vcu : -1) : 64 + (F.vcu - 64) + 192 * k;
        if (u < 0 || u >= 512) break;
        const int bh = u >> 5, n = u & 31, b = bh >> 2, h = bh & 3;
        const size_t m0 = (size_t)b * SEQ + 64 * n;
        __syncthreads();
#pragma unroll
        for (int r = 0; r < 8; ++r) { const int idx = tid + 512 * r, row = idx >> 6, c4 = (idx & 63) * 4;
            *(LAS unsigned long long*)(L + G1_V + row * G1_VSTR + c4 * 2) = *(const unsigned long long*)(z + (m0 + row) * ZC + Z_GV + h * 256 + c4); }
        const int c = tid >> 3, d0 = (tid & 7) * 16;
        {
          const int cbk = wave & 1, dbk = wave >> 1;
          const bf16x8_t af = *(const bf16x8_t*)(z + (m0 + 32 * cbk + r32) * ZC + Z_GLR + 8 * hh);
          const bf16x8_t wf = *(const bf16x8_t*)((const bf16*)(AP->ws + WS_WG2T) + ((size_t)(l * 512 + h * 128 + 32 * dbk + r32)) * 16 + 8 * hh);
          const float bias = IN_F(22)[l * 512 + h * 128 + 32 * dbk + r32];
          f32x16_t D;
#pragma unroll
          for (int r = 0; r < 16; ++r) D[r] = 0.f;
          D = __builtin_amdgcn_mfma_f32_32x32x16_bf16(af, wf, D, 0, 0, 0);
#pragma unroll
          for (int r = 0; r < 16; ++r) { const float x = -(D[r] + bias); const float la = -(fmaxf(x, 0.f) + __logf(1.f + __expf(-fabsf(x)))) * (1.f / 16.f);
              LA[(32 * cbk + (r & 3) + 8 * (r >> 2) + 4 * hh) * 128 + 32 * dbk + r32] = la; } }
        __syncthreads();
        {
          const int col = tid & 127, seg = tid >> 7; float v[16]; float run = 0.f;
#pragma unroll
          for (int i = 0; i < 16; ++i) { run += LA[(16 * seg + i) * 128 + col]; v[i] = run; }
          GL[seg * 128 + col] = run;
          __syncthreads();
          float pre = 0.f;
#pragma unroll
          for (int s2 = 0; s2 < 3; ++s2) pre += (s2 < seg) ? GL[s2 * 128 + col] : 0.f;
#pragma unroll
          for (int i = 0; i < 16; ++i) LA[(16 * seg + i) * 128 + col] = v[i] + pre; }
        __syncthreads();
        {
          const bf16* qp = z + (m0 + c) * ZC + Z_GQ + h * 128 + d0; const bf16* kp = z + (m0 + c) * ZC + Z_GK + h * 128 + d0;
          bf16* qg = (bf16*)(AP->ws + WS_QDEC) + (m0 + c) * 512 + h * 128 + d0;
          f32x4 qv[4], kv4[4];
#pragma unroll
          for (int e4 = 0; e4 < 4; ++e4) { qv[e4] = z4(qp + 4 * e4); kv4[e4] = z4(kp + 4 * e4); }
#pragma unroll
          for (int e4 = 0; e4 < 4; ++e4) { const f32x4 q4 = qv[e4], k4 = kv4[e4]; const f32x4 cu = *(const LAS f32x4*)(LA + c * 128 + d0 + 4 * e4), to = *(const LAS f32x4*)(LA + 63 * 128 + d0 + 4 * e4);
              float qd[4], ki[4], kd[4];
#pragma unroll
              for (int e = 0; e < 4; ++e) { const float ec = __expf(cu[e]), ei = __builtin_amdgcn_rcpf(ec), et = __expf(to[e]); qd[e] = q4[e] * 0.08838834764831845f * ec; ki[e] = k4[e] * ei; kd[e] = ki[e] * et; }
              const unsigned long long qw = (unsigned long long)cvtpk_s(qd[0], qd[1]) | ((unsigned long long)cvtpk_s(qd[2], qd[3]) << 32);
              *(LAS unsigned long long*)(L + G1_QD + c * G1_QSTR + (d0 + 4 * e4) * 2) = qw; *(unsigned long long*)(qg + 4 * e4) = qw;
              *(LAS unsigned long long*)(L + G1_KI + c * G1_QSTR + (d0 + 4 * e4) * 2) = (unsigned long long)cvtpk_s(ki[0], ki[1]) | ((unsigned long long)cvtpk_s(ki[2], ki[3]) << 32);
              *(LAS unsigned long long*)(L + G1_KD + c * G1_KDSTR + (d0 + 4 * e4) * 2) = (unsigned long long)cvtpk_s(kd[0], kd[1]) | ((unsigned long long)cvtpk_s(kd[2], kd[3]) << 32); }
          if (tid < 128) WSF(WS_DEC)[u * 128 + tid] = __expf(LA[63 * 128 + tid]); }
        __syncthreads();
        { const int cb = wave & 1, dvg = wave >> 1;
          f32x16_t S0, S1;
#pragma unroll
          for (int r = 0; r < 16; ++r) { S0[r] = 0.f; S1[r] = 0.f; }
          const LAS unsigned char* qa = L + G1_QD + (32 * cb + r32) * G1_QSTR + hh * 16; const LAS unsigned char* ka = L + G1_KI + r32 * G1_QSTR + hh * 16;
          bf16x8_t qf[8], kf0[8], kf1[8];
#pragma unroll
          for (int ks = 0; ks < 8; ++ks) { qf[ks] = *(const LAS bf16x8_t*)(qa + ks * 32); kf0[ks] = *(const LAS bf16x8_t*)(ka + ks * 32); kf1[ks] = *(const LAS bf16x8_t*)(ka + 32 * G1_QSTR + ks * 32); }
          __builtin_amdgcn_sched_barrier(0);
#pragma unroll
          for (int ks = 0; ks < 8; ++ks) { S0 = __builtin_amdgcn_mfma_f32_32x32x16_bf16(kf0[ks], qf[ks], S0, 0, 0, 0);
              if (cb) S1 = __builtin_amdgcn_mfma_f32_32x32x16_bf16(kf1[ks], qf[ks], S1, 0, 0, 0); }
          const LAS unsigned char* va = L + G1_V + (4 * hh + ((lane & 15) >> 2)) * G1_VSTR + (64 * dvg + ((lane >> 4) & 1) * 16 + (lane & 3) * 4) * 2;
          bf16x8_t vf[2][4];
#pragma unroll
          for (int dvb = 0; dvb < 2; ++dvb)
#pragma unroll
              for (int f = 0; f < 4; ++f) vf[dvb][f] = tr_frag(va + (32 * (f >> 1) + 16 * (f & 1)) * G1_VSTR + dvb * 64, 8 * G1_VSTR);
          __builtin_amdgcn_sched_barrier(0);
#pragma unroll
          for (int r = 0; r < 16; ++r) { const int sl = (r & 3) + 8 * (r >> 2) + 4 * hh; if (sl > r32) { if (cb) S1[r] = 0.f; else S0[r] = 0.f; } }
          bf16x8_t pf[2][2];
#pragma unroll
          for (int s2 = 0; s2 < 2; ++s2) { u32x4_t a, c2;
#pragma unroll
              for (int w = 0; w < 4; ++w) { a[w] = cvtpk_s(S0[8 * s2 + 2 * w], S0[8 * s2 + 2 * w + 1]); c2[w] = cvtpk_s(S1[8 * s2 + 2 * w], S1[8 * s2 + 2 * w + 1]); }
              pf[0][s2] = __builtin_bit_cast(bf16x8_t, a); pf[1][s2] = __builtin_bit_cast(bf16x8_t, c2); }
          float* op = WSF(WS_OGLA) + (m0 + 32 * cb + r32) * BR + h * 256 + 64 * dvg + 4 * hh;
#pragma unroll
          for (int dvb = 0; dvb < 2; ++dvb) { f32x16_t O;
#pragma unroll
              for (int r = 0; r < 16; ++r) O[r] = 0.f;
#pragma unroll
              for (int s2 = 0; s2 < 2; ++s2) { O = __builtin_amdgcn_mfma_f32_32x32x16_bf16(vf[dvb][s2], pf[0][s2], O, 0, 0, 0);
                  if (cb) O = __builtin_amdgcn_mfma_f32_32x32x16_bf16(vf[dvb][2 + s2], pf[1][s2], O, 0, 0, 0); }
#pragma unroll
              for (int cq = 0; cq < 4; ++cq) *(f32x4*)(op + 32 * dvb + 8 * cq) = (f32x4){O[4 * cq], O[4 * cq + 1], O[4 * cq + 2], O[4 * cq + 3]}; } }
        { f32x16_t KV[4];
#pragma unroll
          for (int j = 0; j < 4; ++j)
#pragma unroll
              for (int r = 0; r < 16; ++r) KV[j][r] = 0.f;
          const int rowl = 8 * hh + ((lane & 15) >> 2), coll = ((lane >> 4) & 1) * 16 + (lane & 3) * 4;
          const LAS unsigned char* va = L + G1_V + rowl * G1_VSTR + (32 * wave + coll) * 2; const LAS unsigned char* ka = L + G1_KD + rowl * G1_KDSTR + coll * 2;
          bf16x8_t vfr[4], kfr[4][4];
#pragma unroll
          for (int ks = 0; ks < 4; ++ks) { vfr[ks] = tr_frag(va + 16 * ks * G1_VSTR, 4 * G1_VSTR);
#pragma unroll
              for (int j = 0; j < 4; ++j) kfr[ks][j] = tr_frag(ka + 16 * ks * G1_KDSTR + j * 64, 4 * G1_KDSTR); }
          __builtin_amdgcn_sched_barrier(0);
#pragma unroll
          for (int ks = 0; ks < 4; ++ks)
#pragma unroll
              for (int j = 0; j < 4; ++j) KV[j] = __builtin_amdgcn_mfma_f32_32x32x16_bf16(kfr[ks][j], vfr[ks], KV[j], 0, 0, 0);
          bf16* kp = (bf16*)(AP->ws + WS_KVT) + ((size_t)u * 256 + 32 * wave + r32) * 128 + 4 * hh;
#pragma unroll
          for (int j = 0; j < 4; ++j)
#pragma unroll
              for (int cq = 0; cq < 4; ++cq) *(unsigned long long*)(kp + 32 * j + 8 * cq) = (unsigned long long)cvtpk_s(KV[j][4 * cq], KV[j][4 * cq + 1]) | ((unsigned long long)cvtpk_s(KV[j][4 * cq + 2], KV[j][4 * cq + 3]) << 32); }
    }
    __syncthreads();
}
__device__ __forceinline__ void gla_g2(Frame& F) {
    PHASE_IDS();
    const bf16* kvt = (const bf16*)(AP->ws + WS_KVT); const float* dec = WSF(WS_DEC); bf16* st = (bf16*)(AP->ws + WS_ST);
    constexpr int NG = 16 * 32768 / 4, NA = 65536;
    const int bx = (int)blockIdx.x; const bool clsA = bx < 128;
    for (int e = (clsA ? 0 : NA) + (clsA ? bx : bx - 128) * 512 + tid; e < (clsA ? NA : NG); e += 128 * 512) {
        const int bh = e >> 13, rem = (e & 8191) * 4, dk = rem & 127; f32x4 S = (f32x4){0.f, 0.f, 0.f, 0.f};
#pragma unroll 1
        for (int n0 = 0; n0 < 32; n0 += 16) {
            f32x4 dv[16]; unsigned long long kw[16];
#pragma unroll
            for (int n = 0; n < 16; ++n) { const size_t ch = (size_t)bh * 32 + n0 + n; dv[n] = *(const f32x4*)(dec + ch * 128 + dk); kw[n] = *(const unsigned long long*)(kvt + ch * 32768 + rem); }
#pragma unroll
            for (int n = 0; n < 16; ++n) { const size_t ch = (size_t)bh * 32 + n0 + n;
                *(unsigned long long*)(st + ch * 32768 + rem) = (unsigned long long)pk2(S.x, S.y) | ((unsigned long long)pk2(S.z, S.w) << 32);
                const unsigned a = (unsigned)kw[n], b = (unsigned)(kw[n] >> 32);
                S = dv[n] * S + (f32x4){__uint_as_float(a << 16), __uint_as_float(a & 0xffff0000u), __uint_as_float(b << 16), __uint_as_float(b & 0xffff0000u)}; } }
    }
}
__device__ __forceinline__ void gla_g3(Frame& F, int l) {
    PHASE_IDS();
    const int hh = lane >> 5, r32 = lane & 31;
    LAS float* SS = (LAS float*)(F.lds + RING_OFF);
    const bf16* z = (const bf16*)(AP->ws + WS_Z); bf16* yb = (bf16*)(AP->ws + WS_HB);
    const int bx3 = (int)blockIdx.x; const bool two_class = F.G == 256;
    for (int u = two_class ? bx3 : F.vcu; u < 512; u += two_class ? (bx3 < 128 ? 512 : 128) : F.G) {
        const int bh = u >> 5, n = u & 31, b = bh >> 2, h = bh & 3;
        const size_t m0 = (size_t)b * SEQ + 64 * n;
        const bf16* sp = (const bf16*)(AP->ws + WS_ST) + ((size_t)u * 256 + 32 * wave + r32) * 128 + 8 * hh;
        const int dvb = h * 256 + 32 * wave + 4 * hh;
        bf16x8_t af[8], qf[2][8]; f32x4 oiv[2][4], g4v[4]; unsigned long long gtw[2][4];
#pragma unroll
        for (int ks = 0; ks < 8; ++ks) af[ks] = *(const bf16x8_t*)(sp + 16 * ks);
#pragma unroll
        for (int cb = 0; cb < 2; ++cb) { const size_t m = m0 + 32 * cb + r32; const bf16* qd = (const bf16*)(AP->ws + WS_QDEC) + m * 512 + h * 128 + 8 * hh;
#pragma unroll
            for (int ks = 0; ks < 8; ++ks) qf[cb][ks] = *(const bf16x8_t*)(qd + 16 * ks);
#pragma unroll
            for (int cq = 0; cq < 4; ++cq) { oiv[cb][cq] = *(const f32x4*)(WSF(WS_OGLA) + m * BR + dvb + 8 * cq); gtw[cb][cq] = *(const unsigned long long*)(z + m * ZC + Z_GG + dvb + 8 * cq); } }
#pragma unroll
        for (int cq = 0; cq < 4; ++cq) g4v[cq] = *(const f32x4*)(IN_F(23) + l * BR + dvb + 8 * cq);
        f32x16_t D[2];
#pragma unroll
        for (int cb = 0; cb < 2; ++cb) {
#pragma unroll
            for (int r = 0; r < 16; ++r) D[cb][r] = 0.f;
#pragma unroll
            for (int ks = 0; ks < 8; ++ks) D[cb] = __builtin_amdgcn_mfma_f32_32x32x16_bf16(af[ks], qf[cb][ks], D[cb], 0, 0, 0);
            float q = 0.f;
#pragma unroll
            for (int cq = 0; cq < 4; ++cq)
#pragma unroll
                for (int e = 0; e < 4; ++e) { D[cb][4 * cq + e] += oiv[cb][cq][e]; q += D[cb][4 * cq + e] * D[cb][4 * cq + e]; }
            q += xl_xor(q, 32);
            if (hh == 0) SS[wave * 64 + 32 * cb + r32] = q; }
        __syncthreads();
#pragma unroll
        for (int cb = 0; cb < 2; ++cb) { float tot = 0.f;
#pragma unroll
            for (int w = 0; w < 8; ++w) tot += SS[w * 64 + 32 * cb + r32];
            const float rs = 1.0f / sqrtf(tot * (1.f / 256.f) + EPS); const size_t m = m0 + 32 * cb + r32;
#pragma unroll
            for (int cq = 0; cq < 4; ++cq) { const f32x4 g4 = g4v[cq]; const unsigned a0 = (unsigned)gtw[cb][cq], a1 = (unsigned)(gtw[cb][cq] >> 32);
                const float o0 = D[cb][4 * cq] * rs * g4.x * siluf_(__uint_as_float(a0 << 16)), o1 = D[cb][4 * cq + 1] * rs * g4.y * siluf_(__uint_as_float(a0 & 0xffff0000u));
                const float o2 = D[cb][4 * cq + 2] * rs * g4.z * siluf_(__uint_as_float(a1 << 16)), o3 = D[cb][4 * cq + 3] * rs * g4.w * siluf_(__uint_as_float(a1 & 0xffff0000u));
                *(unsigned long long*)(yb + blk4k(m, 2 * BR + dvb + 8 * cq)) = (unsigned long long)pk2(o0, o1) | ((unsigned long long)pk2(o2, o3) << 32); } }
        __syncthreads();
    }
}
__device__ __forceinline__ void p4_lru(Frame& F, int l) {
    PHASE_IDS();
    LAS float* SA = (LAS float*)(F.lds + RING_OFF); LAS float* SH = SA + 2048; LAS float* CI = SH + 2048;
    const int q4 = (tid & 3) * 4, seg = tid >> 2;
    for (int k = 0; k < 2; ++k) {
        if ((int)blockIdx.x < 128) break;
        const int u = ((int)blockIdx.x - 128) + 128 * k;
        const int b = u >> 6, c0 = (u & 63) * 16;
        const size_t base = ((size_t)b * SEQ + seg * 16) * BR + c0 + q4;
        const size_t ub = ((size_t)u << 15) + (size_t)(seg * 256 + q4);
        const float* ap = WSF(WS_RPRE) + ub; const float* gp = WSF(WS_IPRE) + ub;
        const size_t row0 = (size_t)b * SEQ + seg * 16; const bf16* zg = (const bf16*)(AP->ws + WS_LGB) + ((size_t)u << 15) + (size_t)(seg * 256 + q4);
        f32x4 av[16], gv[16]; unsigned long long gt[16];
#pragma unroll
        for (int t = 0; t < 16; ++t) { av[t] = *(const f32x4*)(ap + t * 16); gv[t] = *(const f32x4*)(gp + t * 16); gt[t] = *(const unsigned long long*)(zg + t * 16); }
        const f32x4 gn = *(const f32x4*)(IN_F(31) + l * BR + c0 + q4);
        f32x4 h = (f32x4){0.f, 0.f, 0.f, 0.f}, P = (f32x4){1.f, 1.f, 1.f, 1.f};
#pragma unroll
        for (int t = 0; t < 16; ++t) { h = av[t] * h + gv[t]; P = P * av[t]; gv[t] = h; av[t] = P; }
        *(LAS f32x4*)(SA + seg * 16 + q4) = P; *(LAS f32x4*)(SH + seg * 16 + q4) = h;
        __syncthreads();
        if (tid < 64) {
            const int chn = tid & 15, part = tid >> 4; float a[32], hv[32];
#pragma unroll
            for (int s2 = 0; s2 < 32; ++s2) { a[s2] = SA[(part * 32 + s2) * 16 + chn]; hv[s2] = SH[(part * 32 + s2) * 16 + chn]; }
            float Pq = 1.f, Hq = 0.f;
#pragma unroll
            for (int s2 = 0; s2 < 32; ++s2) { Hq = a[s2] * Hq + hv[s2]; Pq *= a[s2]; }
            float pre = 0.f;
#pragma unroll
            for (int pp = 0; pp < 3; ++pp) { const float Hs = xl_get(Hq, chn + 16 * pp), Ps = xl_get(Pq, chn + 16 * pp); if (part > pp) pre = Ps * pre + Hs; }
            float c = pre;
#pragma unroll
            for (int s2 = 0; s2 < 32; ++s2) { CI[(part * 32 + s2) * 16 + chn] = c; c = a[s2] * c + hv[s2]; } }
        __syncthreads();
        const f32x4 cin = *(const LAS f32x4*)(CI + seg * 16 + q4); bf16* yb = (bf16*)(AP->ws + WS_HB); float* sp = WSF(WS_SSQ) + (size_t)(24 + (u & 63)) * T + row0;
#pragma unroll
        for (int t = 0; t < 16; ++t) { const f32x4 hv = gv[t] + av[t] * cin;
            float sq = (hv.x * hv.x + hv.y * hv.y) + (hv.z * hv.z + hv.w * hv.w); sq += xl_q1(sq); sq += xl_q2(sq);
            const unsigned a = (unsigned)gt[t], b2 = (unsigned)(gt[t] >> 32);
            const float o0 = hv.x * gn.x * siluf_(__uint_as_float(a << 16)), o1 = hv.y * gn.y * siluf_(__uint_as_float(a & 0xffff0000u));
            const float o2 = hv.z * gn.z * siluf_(__uint_as_float(b2 << 16)), o3 = hv.w * gn.w * siluf_(__uint_as_float(b2 & 0xffff0000u));
            *(unsigned long long*)(yb + blk4k(row0 + t, 3 * BR + c0 + q4)) = (unsigned long long)pk2(o0, o1) | ((unsigned long long)pk2(o2, o3) << 32);
            if ((tid & 3) == 0) sp[t] = sq; }
        __syncthreads();
    }
}
constexpr int AT_KSTR = 400, AT_VSTR = 320, AT_KBYTES = 64 * AT_KSTR, AT_BUF = AT_KBYTES + 64 * AT_VSTR;
__device__ __forceinline__ float bflo(unsigned w) { return __uint_as_float(w << 16); }
__device__ __forceinline__ float bfhi(unsigned w) { return __uint_as_float(w & 0xffff0000u); }
__device__ __forceinline__ void attn_phase(Frame& F, int l) {
    PHASE_IDS();
    const int hh = lane >> 5, r32 = lane & 31;
    LAS unsigned char* L = F.lds + RING_OFF;
    const bf16* Qb = (const bf16*)(AP->ws + WS_Q); const bf16* KNb = (const bf16*)(AP->ws + WS_KN); const bf16* Vb = (const bf16*)(AP->ws + WS_V); const bf16* KRb = (const bf16*)(AP->ws + WS_KR);
    const float SC = 0.07216878364870322f * 1.4426950408889634f;
    const int half = wave >> 2, w4 = wave & 3;
    const int skey = tid >> 4, sc = tid & 15, rkey = tid >> 3, rc = tid & 7;
    if (wave < 4) __builtin_amdgcn_s_setprio(1);
    int u0 = F.vcu; if (F.G == 256) { const int bx = (int)blockIdx.x, x = bx & 7, k = bx >> 3, kk = k & 15; u0 = ((x * 4 + (kk >> 2)) << 3) + (kk & 3) + (k < 16 ? 4 : 0); }
    for (int u = u0; u < 256; u += F.G) {
        const int b = u >> 6, h = (u >> 3) & 7, i = u & 7;
        const int qblk = half ? i : 15 - i;
        const int qrow0 = qblk * 128 + w4 * 32, qrow = qrow0 + r32;
        const int ntile = 2 * (16 - i), tlast = (qrow0 + 31) >> 6;
        const size_t mrow = (size_t)b * SEQ + qrow;
        bf16x8_t qf[12];
        { const u32x4_t* qp = (const u32x4_t*)(Qb + mrow * 1536 + h * DQK + 8 * hh);
          u32x4_t raw[12];
#pragma unroll
          for (int ks = 0; ks < 12; ++ks) raw[ks] = qp[2 * ks];
#pragma unroll
          for (int ks = 0; ks < 8; ++ks) { u32x4_t o;
#pragma unroll
              for (int w = 0; w < 4; ++w) o[w] = cvtpk_s(bflo(raw[ks][w]) * SC, bfhi(raw[ks][w]) * SC);
              qf[ks] = __builtin_bit_cast(bf16x8_t, o); }
          const float* rt = WSF(WS_ROPE) + mrow * 64;
#pragma unroll
          for (int ks = 8; ks < 10; ++ks) { const int i0 = 16 * (ks - 8) + 8 * hh; u32x4_t o1, o2;
              const f32x4 c0 = *(const f32x4*)(rt + i0), c1 = *(const f32x4*)(rt + i0 + 4), s0 = *(const f32x4*)(rt + 32 + i0), s1 = *(const f32x4*)(rt + 32 + i0 + 4);
              const float cc[8] = {c0.x, c0.y, c0.z, c0.w, c1.x, c1.y, c1.z, c1.w}, ss[8] = {s0.x, s0.y, s0.z, s0.w, s1.x, s1.y, s1.z, s1.w};
#pragma unroll
              for (int w = 0; w < 4; ++w) { const float a0 = bflo(raw[ks][w]), a1 = bfhi(raw[ks][w]), b0 = bflo(raw[ks + 2][w]), b1 = bfhi(raw[ks + 2][w]);
                  o1[w] = cvtpk_s((a0 * cc[2 * w] - b0 * ss[2 * w]) * SC, (a1 * cc[2 * w + 1] - b1 * ss[2 * w + 1]) * SC);
                  o2[w] = cvtpk_s((b0 * cc[2 * w] + a0 * ss[2 * w]) * SC, (b1 * cc[2 * w + 1] + a1 * ss[2 * w + 1]) * SC); }
              qf[ks] = __builtin_bit_cast(bf16x8_t, o1); qf[ks + 2] = __builtin_bit_cast(bf16x8_t, o2); } }
        f32x16_t O[4];
#pragma unroll
        for (int d = 0; d < 4; ++d)
#pragma unroll
            for (int r = 0; r < 16; ++r) O[d][r] = 0.f;
        float m_run = -1e30f, l_run = 0.f;
        const bf16* knb = KNb + (size_t)b * SEQ * BR + h * 128;
        const bf16* vbb = Vb + (size_t)b * SEQ * BR + h * 128;
        const bf16* krb = KRb + (size_t)b * SEQ * 64;
        const unsigned ko0 = (unsigned)(skey * BR + sc * 8), kro = (unsigned)(rkey * 64 + rc * 8);
        u32x4_t gk0, gk1, gkr, gv0, gv1;
#define AT_LOAD(t) do { const bf16* kt = knb + (size_t)(t) * 64 * BR; const bf16* vt = vbb + (size_t)(t) * 64 * BR; gk0 = *(const u32x4_t*)(kt + ko0); gk1 = *(const u32x4_t*)(kt + 32 * BR + ko0); \
        gv0 = *(const u32x4_t*)(vt + ko0); gv1 = *(const u32x4_t*)(vt + 32 * BR + ko0); gkr = *(const u32x4_t*)(krb + (size_t)(t) * 64 * 64 + kro); } while (0)
#define AT_STORE(p) do { LAS unsigned char* Bp = L + (p) * AT_BUF; \
        *(LAS u32x4_t*)(Bp + skey * AT_KSTR + sc * 16) = gk0; *(LAS u32x4_t*)(Bp + (skey + 32) * AT_KSTR + sc * 16) = gk1; \
        *(LAS u32x4_t*)(Bp + rkey * AT_KSTR + 256 + rc * 16) = gkr; \
        *(LAS u32x4_t*)(Bp + AT_KBYTES + skey * AT_VSTR + sc * 16) = gv0; *(LAS u32x4_t*)(Bp + AT_KBYTES + (skey + 32) * AT_VSTR + sc * 16) = gv1; } while (0)
        __syncthreads();
        AT_LOAD(0); AT_STORE(0);
        __syncthreads();
        for (int t = 0; t < ntile; ++t) {
            if (t + 1 < ntile) AT_LOAD(t + 1);
            if (t <= tlast) {
                LAS unsigned char* Kb = L + (t & 1) * AT_BUF; LAS unsigned char* Vbs = Kb + AT_KBYTES;
                f32x16_t S0, S1;
#pragma unroll
                for (int r = 0; r < 16; ++r) { S0[r] = 0.f; S1[r] = 0.f; }
                const LAS unsigned char* ka = Kb + r32 * AT_KSTR + hh * 16;
                const LAS unsigned char* va = Vbs + (4 * hh + ((lane & 15) >> 2)) * AT_VSTR + (((lane >> 4) & 1) * 16 + (lane & 3) * 4) * 2;
#define AT_SB() __builtin_amdgcn_sched_barrier(0)
#define AT_KF(ks, w) (*(const LAS bf16x8_t*)(ka + (w) * 32 * AT_KSTR + (ks) * 32))
#define AT_VF(f) tr_frag(va + (32 * (((f) >> 1) & 1) + 16 * ((f) & 1)) * AT_VSTR + ((f) >> 2) * 64, 8 * AT_VSTR)
                bf16x8_t xa0 = AT_KF(0, 0), xb0 = AT_KF(0, 1), xa1 = AT_KF(1, 0), xb1 = AT_KF(1, 1), xa2 = AT_KF(2, 0), xb2 = AT_KF(2, 1);
                AT_SB();
#define AT_KSTEP(ks, A, B) do { S0 = __builtin_amdgcn_mfma_f32_32x32x16_bf16(A, qf[ks], S0, 0, 0, 0); S1 = __builtin_amdgcn_mfma_f32_32x32x16_bf16(B, qf[ks], S1, 0, 0, 0); \
                    if ((ks) + 3 < 12) { A = AT_KF(((ks) + 3 < 12 ? (ks) + 3 : 0), 0); B = AT_KF(((ks) + 3 < 12 ? (ks) + 3 : 0), 1); } AT_SB(); } while (0)
                AT_KSTEP(0, xa0, xb0); AT_KSTEP(1, xa1, xb1); AT_KSTEP(2, xa2, xb2); AT_KSTEP(3, xa0, xb0); AT_KSTEP(4, xa1, xb1); AT_KSTEP(5, xa2, xb2);
                AT_KSTEP(6, xa0, xb0); AT_KSTEP(7, xa1, xb1); AT_KSTEP(8, xa2, xb2); AT_KSTEP(9, xa0, xb0); AT_KSTEP(10, xa1, xb1); AT_KSTEP(11, xa2, xb2);
                bf16x8_t y0 = AT_VF(0), y1 = AT_VF(1), y2 = AT_VF(2), y3 = AT_VF(3);
                AT_SB();
                if (64 * t + 63 > qrow0) {
                    const int kb = 64 * t + 4 * hh;
#pragma unroll
                    for (int r = 0; r < 16; ++r) { const int key = kb + (r & 3) + 8 * (r >> 2); if (key > qrow) S0[r] = -1e30f; if (key + 32 > qrow) S1[r] = -1e30f; }
                }
                float mx = fmaxf(S0[0], S1[0]);
#pragma unroll
                for (int r = 1; r < 16; ++r) mx = fmaxf(mx, fmaxf(S0[r], S1[r]));
                mx = fmaxf(mx, xl_xor(mx, 32));
                if (__any(mx > m_run + 6.f))   { const float mn = fmaxf(m_run, mx); const float al = __builtin_amdgcn_exp2f(m_run - mn); m_run = mn; l_run *= al;
#pragma unroll
                    for (int d = 0; d < 4; ++d)
#pragma unroll
                        for (int r = 0; r < 16; ++r) O[d][r] *= al; }
                float ls = 0.f;
#pragma unroll
                for (int r = 0; r < 16; ++r) { S0[r] = __builtin_amdgcn_exp2f(S0[r] - m_run); S1[r] = __builtin_amdgcn_exp2f(S1[r] - m_run); ls += S0[r] + S1[r]; }
                l_run += ls;
                bf16x8_t pf[2][2];
#pragma unroll
                for (int s2 = 0; s2 < 2; ++s2) { u32x4_t a, c;
#pragma unroll
                    for (int w = 0; w < 4; ++w) { a[w] = cvtpk_s(S0[8 * s2 + 2 * w], S0[8 * s2 + 2 * w + 1]); c[w] = cvtpk_s(S1[8 * s2 + 2 * w], S1[8 * s2 + 2 * w + 1]); }
                    pf[0][s2] = __builtin_bit_cast(bf16x8_t, a); pf[1][s2] = __builtin_bit_cast(bf16x8_t, c); }
                AT_SB();
#define AT_VSTEP(f, Y) do { O[(f) >> 2] = __builtin_amdgcn_mfma_f32_32x32x16_bf16(Y, pf[((f) >> 1) & 1][(f) & 1], O[(f) >> 2], 0, 0, 0); if ((f) + 4 < 16) Y = AT_VF(((f) + 4 < 16 ? (f) + 4 : 0)); AT_SB(); } while (0)
                AT_VSTEP(0, y0); AT_VSTEP(1, y1); AT_VSTEP(2, y2); AT_VSTEP(3, y3); AT_VSTEP(4, y0); AT_VSTEP(5, y1); AT_VSTEP(6, y2); AT_VSTEP(7, y3);
                AT_VSTEP(8, y0); AT_VSTEP(9, y1); AT_VSTEP(10, y2); AT_VSTEP(11, y3); AT_VSTEP(12, y0); AT_VSTEP(13, y1); AT_VSTEP(14, y2); AT_VSTEP(15, y3);
#undef AT_SB
#undef AT_KF
#undef AT_VF
#undef AT_KSTEP
#undef AT_VSTEP
            }
            if (t + 1 < ntile) AT_STORE((t + 1) & 1);
            __syncthreads();
        }
#undef AT_LOAD
#undef AT_STORE
        l_run += xl_xor(l_run, 32);
        const float inv = 1.f / l_run;
        { const bf16* zg = (const bf16*)(AP->ws + WS_Z) + mrow * ZC + Z_MG + h * 128 + 4 * hh; const float* gp = IN_F(20) + l * BR + h * 128 + 4 * hh; bf16* yb = (bf16*)(AP->ws + WS_HB);
          unsigned long long gt[4][4]; f32x4 gn[4][4];
#pragma unroll
          for (int d = 0; d < 4; ++d)
#pragma unroll
              for (int c = 0; c < 4; ++c) { gt[d][c] = *(const unsigned long long*)(zg + 32 * d + 8 * c); gn[d][c] = *(const f32x4*)(gp + 32 * d + 8 * c); }
          float sq = 0.f;
#pragma unroll
          for (int d = 0; d < 4; ++d)
#pragma unroll
              for (int c = 0; c < 4; ++c) { const float x0 = O[d][4 * c] * inv, x1 = O[d][4 * c + 1] * inv, x2 = O[d][4 * c + 2] * inv, x3 = O[d][4 * c + 3] * inv;
                  sq += (x0 * x0 + x1 * x1) + (x2 * x2 + x3 * x3);
                  const unsigned a = (unsigned)gt[d][c], b2 = (unsigned)(gt[d][c] >> 32);
                  const float o0 = x0 * gn[d][c].x * siluf_(__uint_as_float(a << 16)), o1 = x1 * gn[d][c].y * siluf_(__uint_as_float(a & 0xffff0000u));
                  const float o2 = x2 * gn[d][c].z * siluf_(__uint_as_float(b2 << 16)), o3 = x3 * gn[d][c].w * siluf_(__uint_as_float(b2 & 0xffff0000u));
                  *(unsigned long long*)(yb + blk4k(mrow, BR + h * 128 + 32 * d + 8 * c + 4 * hh)) = (unsigned long long)pk2(o0, o1) | ((unsigned long long)pk2(o2, o3) << 32); }
          sq += xl_x32(sq, lane_id());
          if (hh == 0) WSF(WS_SSQ)[(size_t)(16 + h) * T + mrow] = sq; }
    }
    __builtin_amdgcn_s_setprio(0);
    __syncthreads();
}
template <bool TOBF, int ND>
__device__ __forceinline__ void rms_row_res(const float* xrow, const bf16* d0, const bf16* d1, const float* g, void* orow, int lane, size_t mrow) {
    const f32x4* xr = (const f32x4*)xrow + lane; const f32x4* gr = (const f32x4*)g + lane;
    f32x4 v[16]; float s = 0.f;
#pragma unroll
    for (int j = 0; j < 16; ++j) { v[j] = xr[64 * j] + z4(d0 + 4 * (lane + 64 * j)); if (ND > 1) v[j] = v[j] + z4(d1 + 4 * (lane + 64 * j));
        s += (v[j].x * v[j].x + v[j].y * v[j].y) + (v[j].z * v[j].z + v[j].w * v[j].w); }
    f32x4 gv[16];
#pragma unroll
    for (int j = 0; j < 16; ++j) gv[j] = gr[64 * j];
    const float rs = 1.0f / sqrtf(wave_sum(s) * (1.f / DM) + EPS);
#pragma unroll
    for (int j = 0; j < 16; ++j) { const f32x4 gg = gv[j]; const f32x4 o = v[j] * rs * gg;
        if (TOBF) *(unsigned long long*)((bf16*)orow + blk4k(mrow, 4 * lane) + ((size_t)j << 16)) = (unsigned long long)pk2(o.x, o.y) | ((unsigned long long)pk2(o.z, o.w) << 32);
        else ((f32x4*)orow)[lane + 64 * j] = o; }
}
__device__ __forceinline__ void p7_norm(Frame& F, int l) {
    PHASE_IDS();
    const int gw = F.vcu * NWAVES + wave, NGW = F.G * NWAVES;
    const bf16* D0 = (const bf16*)(AP->ws + WS_XB); const bf16* D1 = D0 + (size_t)T * DM;
    for (int m = gw; m < T; m += NGW) {
        asm volatile("" ::: "memory");
        if (l + 1 < DEPTH) rms_row_res<true, 1>(IN_F(0) + (size_t)m * DM, D0 + (size_t)m * DM, D1 + (size_t)m * DM, IN_F(2) + (l + 1) * DM, (bf16*)(AP->ws + WS_HB), lane, (size_t)m);
        else rms_row_res<false, 2>(IN_F(0) + (size_t)m * DM, D0 + (size_t)m * DM, D1 + (size_t)m * DM, IN_F(33), AP->out + (size_t)m * DM, lane, (size_t)m);
    }
}

#ifndef N_LAUNCHES
#define N_LAUNCHES 1
#endif
constexpr int PH_PER_LAYER = 7, N_PHASES = 1 + DEPTH * PH_PER_LAYER;
__global__ void __launch_bounds__(NWAVES * 64, 2) hybrid_fwd(Args args) {
    extern __shared__ __attribute__((aligned(16))) unsigned char lds[];
    Frame F;
    F.lds = (LAS unsigned char*)lds; F.ldsg = lds;
    F.wv = __builtin_amdgcn_readfirstlane((int)(threadIdx.x >> 6));
    F.G = gridDim.x; { const int bx = blockIdx.x; F.vcu = (F.G % 8 == 0) ? (bx % 8) * (F.G / 8) + bx / 8 : bx; }
    volatile LAS unsigned* MISC = (volatile LAS unsigned*)(F.lds + MISC_OFF);
    for (int u = threadIdx.x; u < (LDS_BYTES - LDSCTL_OFF) / 4; u += NWAVES * 64) ((LAS unsigned*)(F.lds + LDSCTL_OFF))[u] = 0u;
    __syncthreads();
    ArgsP AP0 = (ArgsP)__builtin_amdgcn_kernarg_segment_ptr();
    const bool multi = N_LAUNCHES == 1 ? true : (args.ph_hi - args.ph_lo) > 1;
    XcdBarrier bar; bar.bar = (unsigned*)(AP0->ws + WS_CTL) + 4096; bar.x = 0; bar.st = nullptr;
    if (multi) bar = xcd_barrier_post((unsigned*)(AP0->ws + WS_CTL) + 4096, MISC + 8, F.wv == 0 && lane_id() == 0);
    const int lo = args.ph_lo, hi = args.ph_hi;
#define IN(k) (N_LAUNCHES == 1 ? (k) < N_PHASES : (lo <= (k) && (k) < hi))
#ifndef DUP_PH
#define DUP_PH -1
#endif
#define REP(k) for (int rep_ = 0; rep_ < ((DUP_PH) == (k) ? 2 : 1); ++rep_)
#if defined(PROBE_I)
#define STAMP(k) do { if (blockIdx.x == 0 && F.wv == 0 && lane_id() == 0) ((volatile LAS unsigned long long*)(F.lds + LDSCTL_OFF))[k] = __builtin_amdgcn_s_memrealtime(); } while (0)
#else
#define STAMP(k) do {} while (0)
#endif
#define SEAM(k) do { if (IN(k) && IN((k) + 1)) { if ((k) >= 1 && (k) <= PH_PER_LAYER) bg_seam(F, (k), (k) == PH_PER_LAYER); xcd_barrier(bar, F.wv == 0 && lane_id() == 0); } } while (0)
    STAMP(0);
    if (IN(0)) REP(0) {
#ifndef SK_P0
 p0_prologue(F);
#endif
 } SEAM(0);
    for (int ll = 0; ll < DEPTH; ++ll) {
        int l = ll; asm volatile("" : "+s"(l) :: "memory");
        const int pb = 1 + l * PH_PER_LAYER;
        STAMP(pb);
        if (IN(pb + 0)) REP(pb + 0) {
            ArgsP AP = (ArgsP)__builtin_amdgcn_kernarg_segment_ptr(); asm volatile("" : "+s"(AP));
            pg8::Gemm g{(const bf16*)(AP->ws + WS_HB), (const bf16*)(AP->ws + WS_WTIN) + (size_t)l * ZC * KS, T, ZC, DM, KS, KS, 0}; int gg = F.G, bxx = (int)blockIdx.x; asm volatile("" : "+s"(gg), "+s"(bxx)); pg8::StaticOrderT S; S.init(T, ZC, gg, bxx);
            pg8::EpiBf16PZ E{(bf16*)(AP->ws + WS_Z), ZC, (bf16*)(AP->ws + WS_LGB)};
            pg8::gemm_phase<pg8::EpiBf16PZ, pg8::StaticOrderT, true, true, true>(F.lds + RING_OFF, g, S, E, F.wv);
            if ((int)blockIdx.x >= 192) s5_prep(F, l, (int)blockIdx.x - 192);
        } SEAM(pb + 0);
        STAMP(pb + 1);
        if (IN(pb + 1)) REP(pb + 1) {
#ifndef SK_P2R
 p2_rows(F, l);
#endif
#ifndef SK_P2S
 s5_stage(F);
#endif
 } SEAM(pb + 1);
        STAMP(pb + 2);
        if (IN(pb + 2)) REP(pb + 2) {
#ifndef SK_P3G
 gla_g1(F, l);
#endif
            { ArgsP AP = (ArgsP)__builtin_amdgcn_kernarg_segment_ptr(); asm volatile("" : "+s"(AP));
              { const int gs5 = F.vcu < 64 ? F.vcu : -1;
                { pg8::Gemm g{(const bf16*)(AP->ws + WS_S5A), (const bf16*)(AP->ws + WS_S5B1), 64 * 256, 64 * 256, 512, 640, 640, 0}; pg8::S5Order S{gs5, 1};
                  pg8::EpiS5Loc E{WSF(WS_S5L)}; pg8::gemm_phase<pg8::EpiS5Loc, pg8::S5Order, true, true>(F.lds + RING_OFF, g, S, E, F.wv); }
                if (gs5 >= 0) s5_scan(F, gs5);
                { pg8::Gemm g{(const bf16*)(AP->ws + WS_S5A), (const bf16*)(AP->ws + WS_S5B2), 64 * 256, 64 * 512, 640, 640, 640, 0}; pg8::S5Order S{gs5, 2};
                  pg8::EpiS5Y E{(bf16*)(AP->ws + WS_YS5B)}; pg8::gemm_phase<pg8::EpiS5Y, pg8::S5Order, true, true>(F.lds + RING_OFF, g, S, E, F.wv); } }
              { pg8::Gemm g{(const bf16*)(AP->ws + WS_CQB), (const bf16*)(AP->ws + WS_WTUQ), T, 2048, BR, BR, BR, 0};
                const int rr = F.vcu >= 64 ? F.vcu - 64 : -1;
                pg8::P3Order S{(const char*)(AP->ws + WS_CQB), (const char*)((const bf16*)(AP->ws + WS_WTUQ) + (size_t)l * 1536 * BR), (const char*)(AP->ws + WS_CKVB), (const char*)((const bf16*)(AP->ws + WS_WTUKV) + (size_t)l * 2048 * BR),
                               (const char*)(AP->ws + WS_XCB), (const char*)((const bf16*)(AP->ws + WS_WTLRU) + (size_t)l * 8 * 256 * 1024), rr, rr < 0 ? -1 : (rr + 128) % 192, rr < 0 ? -1 : (rr + 64) % 192};
                pg8::EpiP3 E{pg8::EpiBf16Split{(bf16*)(AP->ws + WS_Q), (bf16*)(AP->ws + WS_Q), 1536, 1000}, pg8::EpiBf16Split{(bf16*)(AP->ws + WS_KN), (bf16*)(AP->ws + WS_V), BR, 4},
                             pg8::EpiLru{(const bf16*)(AP->ws + WS_XCB), IN_F(27) + l * BR, IN_F(29) + l * BR, WSF(WS_SPL) + l * BR, WSF(WS_RPRE), WSF(WS_IPRE)}};
                pg8::gemm_phase<pg8::EpiP3, pg8::P3Order, true, true>(F.lds + RING_OFF, g, S, E, F.wv); }
            }
 } SEAM(pb + 2);
        STAMP(pb + 3);
        if (IN(pb + 3)) REP(pb + 3) {
#ifndef SK_P4L
 p4_lru(F, l);
 gla_g2(F);
#endif
            asm volatile("s_waitcnt vmcnt(0)" ::: "memory");
            __syncthreads();
            if (F.wv == 0 && lane_id() == 0) {
                unsigned mo = MISC_OFF + 32; asm volatile("" : "+v"(mo)); const unsigned nloc = *(volatile LAS unsigned*)(F.lds + mo);
                unsigned* cw = bar.bar + CW_G2 + 1024 * l; const unsigned old = xb_add(cw + 64 * xb_xcc_id(), 1u);
                if (old + 1u == nloc) { __builtin_amdgcn_fence(__ATOMIC_RELEASE, "agent"); asm volatile("s_waitcnt vmcnt(0)" ::: "memory"); (void)xb_add(cw + 512, 1u); } }
            { ArgsP AP = (ArgsP)__builtin_amdgcn_kernarg_segment_ptr(); asm volatile("" : "+s"(AP));
              { pg8::Gemm g{(const bf16*)(AP->ws + WS_YS5B), (const bf16*)(AP->ws + WS_WTGLU) + (size_t)l * BR * BR, T, BR, BR, BR, BR, 0}; pg8::StaticOrder S; S.init(T, BR, F.G, (int)blockIdx.x);
                pg8::EpiGluU E{(const bf16*)(AP->ws + WS_YS5B), IN_F(13) + l * BR, IN_F(14) + l * BR, (const bf16*)(AP->ws + WS_Z) + Z_S5G, BR, ZC, (bf16*)(AP->ws + WS_HB), WSF(WS_SSQ)}; pg8::gemm_phase<pg8::EpiGluU, pg8::StaticOrder, true, true>(F.lds + RING_OFF, g, S, E, F.wv); }
            }

#ifndef SK_P4A
 attn_phase(F, l);
#endif
            if (F.wv == 0 && lane_id() == 0) { unsigned mo = MISC_OFF + 36; asm volatile("" : "+v"(mo)); const unsigned nx = *(volatile LAS unsigned*)(F.lds + mo);
                unsigned* cw = bar.bar + CW_G2 + 1024 * l + 512; XB_SPIN(xb_ld(cw) < nx, bar.bar); __builtin_amdgcn_fence(__ATOMIC_ACQUIRE, "agent"); asm volatile("s_waitcnt vmcnt(0)" ::: "memory"); }
            __syncthreads();
 gla_g3(F, l);
 } SEAM(pb + 3);
        STAMP(pb + 5);
        if (IN(pb + 5)) REP(pb + 5) {
            ArgsP AP = (ArgsP)__builtin_amdgcn_kernarg_segment_ptr(); asm volatile("" : "+s"(AP));
            pg8::Gemm g{(const bf16*)(AP->ws + WS_HB), (const bf16*)(AP->ws + WS_WTOUT) + (size_t)l * DM * KS, T, DM, DM, KS, KS, 0}; pg8::StaticOrder S; S.init(T, DM, F.G, (int)blockIdx.x);
            pg8::EpiBf16PR E{{(bf16*)(AP->ws + WS_XB) + (size_t)l * T * DM, DM}, WSF(WS_SSQ)};
            pg8::gemm_phase<pg8::EpiBf16PR, pg8::StaticOrder, true, true, true>(F.lds + RING_OFF, g, S, E, F.wv);
        } SEAM(pb + 5);
        STAMP(pb + 6);
        if (IN(pb + 6)) REP(pb + 6) {
#ifndef SK_P7
 p7_norm(F, l);
#endif
 } SEAM(pb + 6);
    }
#if defined(PROBE_I)
    STAMP(N_PHASES);
    xcd_barrier(bar, F.wv == 0 && lane_id() == 0);
    if (blockIdx.x == 0) { ArgsP AP = (ArgsP)__builtin_amdgcn_kernarg_segment_ptr();
        volatile LAS unsigned long long* ts = (volatile LAS unsigned long long*)(F.lds + LDSCTL_OFF);
        const float ti = (float)(ts[PROBE_I + 1] - ts[PROBE_I]) * 0.01f, tj = (float)(ts[PROBE_J + 1] - ts[PROBE_J]) * 0.01f;
        const float sc = 1.f + tj * 0.001f;
        for (int e = threadIdx.x; e < 512 * DM; e += 512) AP->out[e] *= sc;
        __syncthreads();
        if (threadIdx.x == 0) AP->out[0] += ti; }
#endif
#undef IN
#undef SEAM
}

extern "C" void kernel_launch(void* const* d_in, const int* in_sizes, int n_in, void* d_out, int out_size, void* d_ws, size_t ws_size, hipStream_t stream) {
    static int grid = 0;
    if (grid == 0) {
        if (n_in != 34 || out_size != T * DM || ws_size < WS_END) { fprintf(stderr, "kernel_launch: unexpected problem: n_in %d out %d ws %zu (need %zu)\n", n_in, out_size, ws_size, (size_t)WS_END); grid = -1; return; }
        int dev = 0, cus = 0;
        if (hipGetDevice(&dev) != hipSuccess || hipDeviceGetAttribute(&cus, hipDeviceAttributeMultiprocessorCount, dev) != hipSuccess) { grid = -1; return; }
        if (hipFuncSetAttribute((const void*)hybrid_fwd, hipFuncAttributeMaxDynamicSharedMemorySize, LDS_BYTES) != hipSuccess) { fprintf(stderr, "kernel_launch: hipFuncSetAttribute failed\n"); grid = -1; return; }
        int per_cu = 0;
        if (hipOccupancyMaxActiveBlocksPerMultiprocessor(&per_cu, (const void*)hybrid_fwd, NWAVES * 64, LDS_BYTES) != hipSuccess || per_cu < 1) fprintf(stderr, "kernel_launch: occupancy query says %d blocks/CU\n", per_cu);
        (void)hipGetLastError();
        grid = cus;
    }
    if (grid < 0) return;
    (void)hipMemsetAsync((char*)d_ws + WS_CTL, 0, CTL_ZERO_BYTES, stream);
    Args a{};
    for (int i = 0; i < 34; ++i) a.in[i] = d_in[i];
    a.out = (float*)d_out; a.ws = (unsigned char*)d_ws;
    if (N_LAUNCHES == 1) { a.ph_lo = 0; a.ph_hi = N_PHASES; hipLaunchKernelGGL(hybrid_fwd, dim3(grid), dim3(NWAVES * 64), LDS_BYTES, stream, a); }
    else for (int p = 0; p < N_PHASES; ++p) { a.ph_lo = p; a.ph_hi = p + 1; hipLaunchKernelGGL(hybrid_fwd, dim3(grid), dim3(NWAVES * 64), LDS_BYTES, stream, a); }
}
```
